# Optimizing an MI355X kernel written in HIP

```python
import jax
import jax.numpy as jnp
from jax import lax
import numpy as np

D_MODEL = 1024
BATCH = 8
SEQ = 8192
DEPTH = 1

GRID_W = 64
CTX_LEN = 256
D_MIX = D_MODEL
NA_HEADS = 8
NA_HEAD_DIM = 64
NA_WIN_H = 8
NA_WIN_W = 16
NA_W = NA_HEADS * NA_HEAD_DIM
ML_HEADS = 4
ML_QK_DIM = 64
ML_V_DIM = 128
ML_QK_W = ML_HEADS * ML_QK_DIM
ML_V_W = ML_HEADS * ML_V_DIM
ML_CHUNK = 128
ML_N_GATES = 4 * ML_HEADS
CONV_K = 5
ROPE_BASE = 10000.0
N_EXPERTS = 16
CAPACITY_FACTOR = 2
D_FF = 2816
LN_EPS = 1e-5
DEEPNORM_ALPHA = (2.0 * DEPTH) ** 0.25
DEEPNORM_BETA = (8.0 * DEPTH) ** -0.25
SPLITS = (NA_W, 2 * NA_W, 3 * NA_W, 3 * NA_W + ML_QK_W, 3 * NA_W + 2 * ML_QK_W, 3 * NA_W + 2 * ML_QK_W + ML_V_W, 3 * NA_W + 2 * ML_QK_W + 2 * ML_V_W)
D_IN = 3 * NA_W + 2 * ML_QK_W + 2 * ML_V_W + ML_N_GATES

kernel_name = "hybrid_natten_mlstm_ec_moe_dit_layer"


def _layer_norm(x, g, b):
    xf = x.astype(jnp.float32)
    mu = xf.mean(-1, keepdims=True)
    var = jnp.mean(jnp.square(xf - mu), -1, keepdims=True)
    return ((xf - mu) * lax.rsqrt(var + LN_EPS)).astype(x.dtype) * g + b


def _ada(cvec, w_ada, b_ada):
    m = (jax.nn.silu(cvec) @ w_ada + b_ada)[..., None, :]
    return jnp.split(m, 6, axis=-1)


def _dwconv(x, w):
    k = w.shape[0]
    return lax.conv_general_dilated(x, w[:, None, :], window_strides=(1,), padding=[(k // 2, k // 2)],
                                    dimension_numbers=('NWC', 'WIO', 'NWC'), feature_group_count=x.shape[-1])


def _rope_2d(x, rows, cols):
    dh = x.shape[-1]
    half = dh // 2
    nf = half // 2
    inv = 1.0 / (ROPE_BASE ** (jnp.arange(nf, dtype=jnp.float32) / nf))

    def rot(xa, pos):
        ang = pos.astype(jnp.float32)[:, None] * inv
        cos = jnp.cos(ang)[None, :, None, :].astype(x.dtype)
        sin = jnp.sin(ang)[None, :, None, :].astype(x.dtype)
        x1, x2 = xa[..., :nf], xa[..., nf:]
        return jnp.concatenate([x1 * cos - x2 * sin, x1 * sin + x2 * cos], axis=-1)

    return jnp.concatenate([rot(x[..., :half], rows), rot(x[..., half:], cols)], axis=-1)


def _neighbourhood_attention(q, k, v, k_ctx, v_ctx, bias_table):
    B, T, H, Dh = q.shape
    rows = T // GRID_W
    kh = min(NA_WIN_H, rows)
    qg = (q * Dh ** -0.5).reshape(B, rows, GRID_W, H, Dh)
    kg = k.reshape(B, rows, GRID_W, H, Dh)
    vg = v.reshape(B, rows, GRID_W, H, Dh)
    col_start = np.clip(np.arange(GRID_W) - NA_WIN_W // 2, 0, GRID_W - NA_WIN_W)
    col_idx = col_start[:, None] + np.arange(NA_WIN_W)
    col_off = col_idx - np.arange(GRID_W)[:, None] + (NA_WIN_W - 1)
    bias_cols = bias_table[:, :, col_off]

    def row_block(r):
        rs = jnp.clip(r - kh // 2, 0, rows - kh)
        k_win = lax.dynamic_slice_in_dim(kg, rs, kh, axis=1)[:, :, col_idx]
        v_win = lax.dynamic_slice_in_dim(vg, rs, kh, axis=1)[:, :, col_idx]
        q_r = lax.dynamic_index_in_dim(qg, r, axis=1, keepdims=False)
        row_off = rs + jnp.arange(kh) - r + (NA_WIN_H - 1)
        bias = jnp.transpose(jnp.take(bias_cols, row_off, axis=1), (0, 2, 1, 3))
        s_lat = jnp.einsum('bchd,bicjhd->bhcij', q_r, k_win).astype(jnp.float32) + bias[None].astype(jnp.float32)
        s_ctx = jnp.einsum('bchd,blhd->bhcl', q_r, k_ctx).astype(jnp.float32)
        s = jnp.concatenate([s_lat.reshape(B, H, GRID_W, kh * NA_WIN_W), s_ctx], axis=-1)
        p = jax.nn.softmax(s, axis=-1).astype(v.dtype)
        p_lat = p[..., :kh * NA_WIN_W].reshape(B, H, GRID_W, kh, NA_WIN_W)
        p_ctx = p[..., kh * NA_WIN_W:]
        return (jnp.einsum('bhcij,bicjhd->bchd', p_lat, v_win)
                + jnp.einsum('bhcl,blhd->bchd', p_ctx, v_ctx))

    out = lax.map(row_block, jnp.arange(rows))
    return jnp.moveaxis(out, 0, 1).reshape(B, T, H * Dh)


def _context_attention(q, k, v):
    s = jnp.einsum('bqhd,bkhd->bhqk', q * q.shape[-1] ** -0.5, k).astype(jnp.float32)
    p = jax.nn.softmax(s, axis=-1).astype(v.dtype)
    o = jnp.einsum('bhqk,bkhd->bqhd', p, v)
    return o.reshape(o.shape[0], o.shape[1], -1)


def _mlstm_chunkwise(q, k, v, i_pre, logf, state):
    B, H, T, dk = q.shape
    dv = v.shape[-1]
    L = ML_CHUNK
    nc = T // L
    qc = q.reshape(B, H, nc, L, dk)
    kc = k.reshape(B, H, nc, L, dk)
    vc = v.reshape(B, H, nc, L, dv)
    ic = i_pre.reshape(B, H, nc, L)
    bc = jnp.cumsum(logf.reshape(B, H, nc, L), axis=-1)
    b_last = bc[..., -1]
    a = b_last[..., None] - bc + ic
    m_loc = a.max(-1)
    w = jnp.exp(a - m_loc[..., None])
    c_loc = jnp.einsum('bhnl,bhnlv,bhnlk->bhnvk', w, vc, kc)
    n_loc = jnp.einsum('bhnl,bhnlk->bhnk', w, kc)

    def step(carry, inp):
        c_prev, n_prev, m_prev = carry
        bl, ml, cl, nl = inp
        m_new = jnp.maximum(bl + m_prev, ml)
        s_prev = jnp.exp(bl + m_prev - m_new)
        s_loc = jnp.exp(ml - m_new)
        c_new = s_prev[..., None, None] * c_prev + s_loc[..., None, None] * cl
        n_new = s_prev[..., None] * n_prev + s_loc[..., None] * nl
        return (c_new, n_new, m_new), (c_prev, n_prev, m_prev)

    xs = (jnp.moveaxis(b_last, 2, 0), jnp.moveaxis(m_loc, 2, 0), jnp.moveaxis(c_loc, 2, 0), jnp.moveaxis(n_loc, 2, 0))
    final, (c_in, n_in, m_in) = lax.scan(step, state, xs)
    c_in = jnp.moveaxis(c_in, 0, 2)
    n_in = jnp.moveaxis(n_in, 0, 2)
    m_in = jnp.moveaxis(m_in, 0, 2)

    lower = np.tril(np.ones((L, L), dtype=bool))
    dmat = jnp.where(lower, bc[..., :, None] - bc[..., None, :] + ic[..., None, :], -jnp.inf)
    m_prev_term = bc + m_in[..., None]
    m_t = jnp.maximum(dmat.max(-1), m_prev_term)
    s = jnp.einsum('bhntk,bhnsk->bhnts', qc, kc) * jnp.exp(dmat - m_t[..., None])
    inter = jnp.exp(m_prev_term - m_t)
    num = (jnp.einsum('bhnts,bhnsv->bhntv', s, vc)
           + inter[..., None] * jnp.einsum('bhnvk,bhntk->bhntv', c_in, qc))
    den = s.sum(-1) + inter * jnp.einsum('bhnk,bhntk->bhnt', n_in, qc)
    h = num / jnp.maximum(jnp.abs(den), jnp.exp(-m_t))[..., None]
    return h.reshape(B, H, T, dv), final


def _mlstm_inputs(qm, km, vm, gates, b_gate, conv_w, pos):
    B, T, _ = qm.shape
    qk = jax.nn.silu(_dwconv(jnp.concatenate([qm, km], axis=-1), conv_w))
    q = qk[..., :ML_QK_W].reshape(B, T, ML_HEADS, ML_QK_DIM)
    k = qk[..., ML_QK_W:].reshape(B, T, ML_HEADS, ML_QK_DIM)
    if pos is not None:
        q = _rope_2d(q, pos[0], pos[1])
        k = _rope_2d(k, pos[0], pos[1])
    v = vm.reshape(B, T, ML_HEADS, ML_V_DIM)
    g = (gates + b_gate).astype(jnp.float32).reshape(B, T, 4, ML_HEADS)
    g = jnp.transpose(g, (2, 0, 3, 1))
    tr = lambda a: jnp.transpose(a, (0, 2, 1, 3))
    return tr(q) * ML_QK_DIM ** -0.5, tr(k), tr(v), g


def _mlstm_bidirectional(lat, ctx_in):
    q, k, v, g = lat
    qc, kc, vc, gc = ctx_in
    B, H = q.shape[:2]
    zero = (jnp.zeros((B, H, ML_V_DIM, ML_QK_DIM), jnp.float32), jnp.zeros((B, H, ML_QK_DIM), jnp.float32),
            jnp.zeros((B, H), jnp.float32))
    flip = lambda a: jnp.flip(a, axis=2)
    hc_f, st_f = _mlstm_chunkwise(qc, kc, vc, gc[0], jax.nn.log_sigmoid(gc[1]), zero)
    h_f, _ = _mlstm_chunkwise(q, k, v, g[0], jax.nn.log_sigmoid(g[1]), st_f)
    hc_b, st_b = _mlstm_chunkwise(flip(qc), flip(kc), flip(vc), flip(gc[2]), flip(jax.nn.log_sigmoid(gc[3])), zero)
    h_b, _ = _mlstm_chunkwise(flip(q), flip(k), flip(v), flip(g[2]), flip(jax.nn.log_sigmoid(g[3])), st_b)
    return h_f + flip(h_b), hc_f + flip(hc_b)


def _head_norm(h, g):
    h = jnp.transpose(h, (0, 2, 1, 3)).astype(jnp.float32)
    mu = h.mean(-1, keepdims=True)
    var = jnp.mean(jnp.square(h - mu), -1, keepdims=True)
    hn = (h - mu) * lax.rsqrt(var + LN_EPS)
    return hn.reshape(hn.shape[0], hn.shape[1], -1) * g


def _expert_choice_ffn(h, w_router, w_gate, w_up, w_down):
    B, T, D = h.shape
    cap = CAPACITY_FACTOR * T // N_EXPERTS
    aff = jax.nn.softmax(jnp.einsum('btd,de->bte', h, w_router).astype(jnp.float32), axis=-1)
    g, idx = lax.top_k(jnp.swapaxes(aff, 1, 2), cap)
    g = jnp.moveaxis(g, 1, 0).astype(h.dtype)
    idx = jnp.moveaxis(idx, 1, 0)

    def expert(args):
        idx_e, g_e, wg, wu, wd = args
        xe = jax.vmap(lambda hb, ib: hb[ib])(h, idx_e)
        return ((jax.nn.silu(xe @ wg) * (xe @ wu)) @ wd) * g_e[..., None]

    y = lax.map(expert, (idx, g, w_gate, w_up, w_down))
    return jnp.zeros_like(h).at[jnp.arange(B)[None, :, None], idx].add(y)


def _layer(x, ctx, c, c_ctx, w_ada, b_ada, w_in, b_gate, conv_qk, na_rel_bias, ml_norm_g, w_out,
           ln1_g, ln1_b, w_router, w_expert_gate, w_expert_up, w_expert_down, ln2_g, ln2_b, update_ctx):
    B, T, _ = x.shape
    Lc = ctx.shape[1]
    t = jnp.arange(T)
    pos = (t // GRID_W, t % GRID_W)
    sh1, sc1, g1, sh2, sc2, g2 = _ada(c, w_ada, b_ada)
    csh1, csc1, cg1, csh2, csc2, cg2 = _ada(c_ctx, w_ada, b_ada)

    ux = (x * (1 + sc1) + sh1) @ w_in
    uc = (ctx * (1 + csc1) + csh1) @ w_in
    qa, ka, va, qm, km, vm, om, gt = jnp.split(ux, SPLITS, axis=-1)
    qa_c, ka_c, va_c, qm_c, km_c, vm_c, om_c, gt_c = jnp.split(uc, SPLITS, axis=-1)
    heads = lambda a: a.reshape(a.shape[0], a.shape[1], NA_HEADS, NA_HEAD_DIM)
    ka_c, va_c = heads(ka_c), heads(va_c)

    att = _neighbourhood_attention(heads(qa), heads(ka), heads(va), ka_c, va_c, na_rel_bias)

    h_lat, h_ctx = _mlstm_bidirectional(_mlstm_inputs(qm, km, vm, gt, b_gate, conv_qk, pos),
                                        _mlstm_inputs(qm_c, km_c, vm_c, gt_c, b_gate, conv_qk, None))
    ml = _head_norm(h_lat, ml_norm_g).astype(x.dtype) * jax.nn.sigmoid(om)

    mix = jnp.concatenate([att, ml], axis=-1) @ w_out
    x_new = _layer_norm(DEEPNORM_ALPHA * x + g1 * mix, ln1_g, ln1_b)
    moe = _expert_choice_ffn(x_new * (1 + sc2) + sh2, w_router, w_expert_gate, w_expert_up, w_expert_down)
    x_new = _layer_norm(DEEPNORM_ALPHA * x_new + g2 * moe, ln2_g, ln2_b)

    if update_ctx:
        att_c = _context_attention(heads(qa_c), ka_c, va_c)
        ml_c = _head_norm(h_ctx, ml_norm_g).astype(ctx.dtype) * jax.nn.sigmoid(om_c)
        mix_c = jnp.concatenate([att_c, ml_c], axis=-1) @ w_out
        ctx = _layer_norm(DEEPNORM_ALPHA * ctx + cg1 * mix_c, ln1_g, ln1_b)
        moe_c = _expert_choice_ffn(ctx * (1 + csc2) + csh2, w_router, w_expert_gate, w_expert_up, w_expert_down)
        ctx = _layer_norm(DEEPNORM_ALPHA * ctx + cg2 * moe_c, ln2_g, ln2_b)
    return x_new, ctx


def setup_inputs(seed: int = 0) -> dict:
    key = jax.random.key(seed)
    ks = jax.random.split(key, 20)
    f32 = jnp.float32
    D = D_MODEL
    nrm = lambda k, shape, scale: jax.random.normal(k, shape, f32) * scale
    gate_base = np.concatenate([np.zeros(ML_HEADS), np.linspace(3.0, 6.0, ML_HEADS),
                                np.zeros(ML_HEADS), np.linspace(3.0, 6.0, ML_HEADS)]).astype(np.float32)
    return {
        "x": nrm(ks[0], (BATCH, SEQ, D), 1.0),
        "c": nrm(ks[1], (BATCH, D), 1.0),
        "ctx": nrm(ks[2], (BATCH, CTX_LEN, D), 1.0),
        "c_ctx": nrm(ks[3], (D,), 1.0),
        "w_ada": nrm(ks[4], (DEPTH, D, 6 * D), 0.5 * D ** -0.5),
        "b_ada": nrm(ks[5], (DEPTH, 6 * D), 0.02),
        "w_in": nrm(ks[6], (DEPTH, D, D_IN), D ** -0.5),
        "b_gate": jnp.asarray(gate_base)[None, :] + nrm(ks[7], (DEPTH, ML_N_GATES), 0.1),
        "conv_qk": nrm(ks[8], (DEPTH, CONV_K, 2 * ML_QK_W), CONV_K ** -0.5),
        "na_rel_bias": nrm(ks[9], (DEPTH, NA_HEADS, 2 * NA_WIN_H - 1, 2 * NA_WIN_W - 1), 0.1),
        "ml_norm_g": 1.0 + nrm(ks[10], (DEPTH, ML_V_W), 0.02),
        "w_out": nrm(ks[11], (DEPTH, D_MIX, D), DEEPNORM_BETA * D_MIX ** -0.5),
        "ln1_g": 1.0 + nrm(ks[12], (DEPTH, D), 0.02),
        "ln1_b": nrm(ks[13], (DEPTH, D), 0.02),
        "w_router": nrm(ks[14], (DEPTH, D, N_EXPERTS), D ** -0.5),
        "w_expert_gate": nrm(ks[15], (DEPTH, N_EXPERTS, D, D_FF), D ** -0.5),
        "w_expert_up": nrm(ks[16], (DEPTH, N_EXPERTS, D, D_FF), D ** -0.5),
        "w_expert_down": nrm(ks[17], (DEPTH, N_EXPERTS, D_FF, D), DEEPNORM_BETA * D_FF ** -0.5),
        "ln2_g": 1.0 + nrm(ks[18], (DEPTH, D), 0.02),
        "ln2_b": nrm(ks[19], (DEPTH, D), 0.02),
    }


def reference(x, c, ctx, c_ctx, w_ada, b_ada, w_in, b_gate, conv_qk, na_rel_bias, ml_norm_g, w_out,
              ln1_g, ln1_b, w_router, w_expert_gate, w_expert_up, w_expert_down, ln2_g, ln2_b):
    for layer in range(DEPTH):
        x, ctx = _layer(x, ctx, c, c_ctx, w_ada[layer], b_ada[layer], w_in[layer], b_gate[layer], conv_qk[layer],
                        na_rel_bias[layer], ml_norm_g[layer], w_out[layer], ln1_g[layer], ln1_b[layer],
                        w_router[layer], w_expert_gate[layer], w_expert_up[layer], w_expert_down[layer],
                        ln2_g[layer], ln2_b[layer], update_ctx=layer < DEPTH - 1)
    return x
```

```cpp
#include <hip/hip_runtime.h>
#include <hip/hip_cooperative_groups.h>
#include <cstdio>
#include <cstdint>
namespace cg = cooperative_groups;

typedef unsigned short bf16_t;
typedef float f32x4 __attribute__((ext_vector_type(4)));
typedef unsigned u32x4 __attribute__((ext_vector_type(4)));
typedef unsigned u32x2 __attribute__((ext_vector_type(2)));

constexpr int NB = 8, T_ = 8192, D_ = 1024, LC = 256;
constexpr int NLAT = NB * T_, NCTX = NB * LC, MROWS = NLAT + NCTX;
constexpr int DIN = 3088, DINP = 3328;
constexpr int NE = 16, CAP = 1024, DFF = 2816;
constexpr int C_QA = 0, C_KA = 512, C_VA = 1024, C_QM = 1536, C_KM = 1792, C_VM = 2048, C_OM = 2560, C_GT = 3072;
constexpr int NCH = 66;
constexpr float LN_EPS = 1e-5f;
constexpr float ALPHA = 1.189207115002721f;
constexpr int NGROUPS = 2, EPG = NE / NGROUPS;

constexpr int NTHR = 512, NWAVES = 8;
constexpr int LDS_BYTES = 147456;

constexpr size_t MiB = 1u << 20;
constexpr size_t WS_CTL = 0;
constexpr size_t WS_MOD = 1 * MiB;
constexpr size_t WS_BLAST = 1 * MiB + 512 * 1024;
constexpr size_t WS_MLOC = WS_BLAST + 32 * 1024;
constexpr size_t WS_MIN = WS_MLOC + 32 * 1024;
constexpr size_t WS_NLOC = 2 * MiB;
constexpr size_t WS_IDX = 4 * MiB;
constexpr size_t WS_GSEL = 4 * MiB + 512 * 1024;
constexpr size_t WS_AFF = 5 * MiB;
constexpr size_t WS_INV = 9 * MiB;
constexpr size_t WS_WINT = 16 * MiB;
constexpr size_t WS_WOUTT = 23 * MiB;
constexpr size_t WS_XM = 32 * MiB;
constexpr size_t WS_U = 164 * MiB;
constexpr size_t WS_QP = 593 * MiB;
constexpr size_t WS_KP = 625 * MiB;
constexpr size_t WS_CLOC = 658 * MiB;
constexpr size_t WS_MIX = 790 * MiB;
constexpr size_t WS_HMOD = 16 * MiB;
constexpr size_t WS_WGUT = 144 * MiB;
constexpr size_t WS_WDT = 320 * MiB;
constexpr size_t WS_EO = 408 * MiB;
constexpr size_t WS_ACT = 664 * MiB;
constexpr size_t WS_END = WS_ACT + (size_t)EPG * 8192 * DFF * 2;
static_assert(WS_XM + (size_t)MROWS * D_ * 2 <= WS_U, "map");
static_assert(WS_U + (size_t)MROWS * DINP * 2 <= WS_QP, "map");
static_assert(WS_KP + (size_t)MROWS * 256 * 2 <= WS_CLOC, "map");
static_assert(WS_CLOC + (size_t)64 * NCH * 8192 * 4 <= WS_MIX, "map");
static_assert(WS_MIX + (size_t)NLAT * D_ * 2 <= 1024 * MiB, "map");
static_assert(WS_WGUT + (size_t)NE * 2 * DFF * D_ * 2 <= WS_WDT, "map");
static_assert(WS_WDT + (size_t)NE * D_ * DFF * 2 <= WS_EO, "map");
static_assert(WS_EO + (size_t)NE * 8192 * D_ * 2 <= WS_ACT, "map");
static_assert(WS_END <= 1024 * MiB, "map");

struct Params {
    const float *x, *c, *ctx, *c_ctx, *w_ada, *b_ada, *w_in, *b_gate, *conv_qk, *na_bias, *ml_norm_g, *w_out,
        *ln1_g, *ln1_b, *w_router, *w_eg, *w_eu, *w_ed, *ln2_g, *ln2_b;
    float* out; unsigned char* ws;
    int ph_lo, ph_hi;
};

__device__ __forceinline__ float bf2f(bf16_t v) { return __uint_as_float((unsigned)v << 16); }
__device__ __forceinline__ unsigned f2bf(float f) { unsigned u = __float_as_uint(f); return (u + 0x7fffu + ((u >> 16) & 1u)) >> 16; }
__device__ __forceinline__ unsigned pk2(float lo, float hi) { return f2bf(lo) | (f2bf(hi) << 16); }
__device__ __forceinline__ float bflo(unsigned w) { return __uint_as_float(w << 16); }
__device__ __forceinline__ float bfhi(unsigned w) { return __uint_as_float(w & 0xffff0000u); }
__device__ __forceinline__ float wave_sum(float v) {
#pragma unroll
    for (int o = 1; o < 64; o <<= 1) v += __shfl_xor(v, o);
    return v;
}
__device__ __forceinline__ float wave_max(float v) {
#pragma unroll
    for (int o = 1; o < 64; o <<= 1) v = fmaxf(v, __shfl_xor(v, o));
    return v;
}
__device__ __forceinline__ float siluf(float v) { return v / (1.f + __expf(-v)); }
__device__ __forceinline__ float sigmoidf_(float v) { return 1.f / (1.f + __expf(-v)); }
__device__ __forceinline__ float logsigf(float v) { return fminf(v, 0.f) - log1pf(__expf(-fabsf(v))); }
#define LDS_FENCE() asm volatile("s_waitcnt lgkmcnt(0)" ::: "memory")

__device__ __forceinline__ void ph_ada_item(const Params& p, unsigned char* lds, int item) {
    float* sc = (float*)lds;
    float* red = sc + 9 * 1024;
    const int tid = threadIdx.x;
    float* MOD = (float*)(p.ws + WS_MOD);
    for (int i = tid; i < 9 * 1024; i += NTHR) { const int r = i >> 10, k = i & 1023; const float v = r < 8 ? p.c[r * 1024 + k] : p.c_ctx[k]; sc[i] = v / (1.f + expf(-v)); }
    __syncthreads();
    const int col = item * 64 + (tid & 63), ks = tid >> 6;
    float acc[9];
#pragma unroll
    for (int r = 0; r < 9; ++r) acc[r] = 0.f;
    for (int k = ks * 128; k < ks * 128 + 128; ++k) {
        const float w = p.w_ada[(size_t)k * 6144 + col];
#pragma unroll
        for (int r = 0; r < 9; ++r) acc[r] += sc[r * 1024 + k] * w;
    }
#pragma unroll
    for (int r = 0; r < 9; ++r) red[(ks * 64 + (tid & 63)) * 9 + r] = acc[r];
    __syncthreads();
    if (tid < 64) {
#pragma unroll
        for (int r = 0; r < 9; ++r) { float s = p.b_ada[col]; for (int k2 = 0; k2 < 8; ++k2) s += red[(k2 * 64 + tid) * 9 + r]; MOD[r * 6144 + col] = s; }
    }
    __syncthreads();
}
__device__ __forceinline__ void transpose_item(const float* W, int N, int k0, int n0, int nvalid, bf16_t* WT, size_t orow0, int ldt, float* scr, int lane) {
#pragma unroll 8
    for (int i = 0; i < 32; ++i) { const int kk = 2 * i + (lane >> 5), nn = lane & 31; scr[kk * 33 + nn] = nn < nvalid ? W[(size_t)(k0 + kk) * N + n0 + nn] : 0.f; }
    LDS_FENCE();
    const int c = lane & 7;
#pragma unroll
    for (int j = 0; j < 4; ++j) {
        const int n = (lane >> 3) + 8 * j; const float* s = scr + (8 * c) * 33 + n;
        u32x4 o; o.x = pk2(s[0 * 33], s[1 * 33]); o.y = pk2(s[2 * 33], s[3 * 33]); o.z = pk2(s[4 * 33], s[5 * 33]); o.w = pk2(s[6 * 33], s[7 * 33]);
        *(u32x4*)(WT + (orow0 + n) * ldt + k0 + 8 * c) = o;
    }
    LDS_FENCE();
}
__device__ __forceinline__ void ph0(const Params& p, unsigned char* lds, int bid, int nblk) {
    for (int it = bid; it < 96; it += nblk) ph_ada_item(p, lds, it);
    const int tid = threadIdx.x, lane = tid & 63, wave = tid >> 6;
    float* scr = (float*)lds + wave * (64 * 33);
    bf16_t* WINT = (bf16_t*)(p.ws + WS_WINT); bf16_t* WOUTT = (bf16_t*)(p.ws + WS_WOUTT);
    const int gw = bid * NWAVES + wave, ngw = nblk * NWAVES;
    constexpr int I_IN = 16 * 97, I_OUT = 16 * 32;
    for (int it = gw; it < I_IN + I_OUT; it += ngw) {
        if (it < I_IN) { const int kb = it / 97, nb = it % 97; const int n0 = nb * 32; const int nv = (DIN - n0) < 32 ? (DIN - n0) : 32; transpose_item(p.w_in, DIN, kb * 64, n0, nv, WINT, (size_t)n0, 1024, scr, lane); }
        else { const int r = it - I_IN; const int kb = r / 32, nb = r % 32; transpose_item(p.w_out, 1024, kb * 64, nb * 32, 32, WOUTT, (size_t)nb * 32, 1024, scr, lane); }
    }
    { const size_t n16 = (size_t)(DINP - 3104) * 1024 * 2 / 16; u32x4* z = (u32x4*)(WINT + (size_t)3104 * 1024);
      for (size_t i = (size_t)bid * NTHR + tid; i < n16; i += (size_t)nblk * NTHR) z[i] = (u32x4){0u, 0u, 0u, 0u}; }
}

__device__ __forceinline__ void ph1(const Params& p, int bid, int nblk) {
    const int tid = threadIdx.x, lane = tid & 63, wave = tid >> 6;
    const float* MOD = (const float*)(p.ws + WS_MOD); bf16_t* XM = (bf16_t*)(p.ws + WS_XM);
    for (int m = bid * NWAVES + wave; m < MROWS; m += nblk * NWAVES) {
        const int r = m < NLAT ? (m >> 13) : 8;
        const float* src = m < NLAT ? p.x + (size_t)m * 1024 : p.ctx + (size_t)(m - NLAT) * 1024;
        const float* sh = MOD + r * 6144; const float* scl = sh + 1024;
#pragma unroll
        for (int j = 0; j < 4; ++j) {
            const int k = j * 256 + lane * 4;
            const f32x4 v = *(const f32x4*)(src + k), a = *(const f32x4*)(scl + k), b = *(const f32x4*)(sh + k);
            u32x2 o; o.x = pk2(v.x * (1.f + a.x) + b.x, v.y * (1.f + a.y) + b.y); o.y = pk2(v.z * (1.f + a.z) + b.z, v.w * (1.f + a.w) + b.w);
            *(u32x2*)(XM + (size_t)m * 1024 + k) = o;
        }
    }
}

template <bool DUAL, class RowPtr, class Epi>
__device__ __forceinline__ void gemm_tile_naive(unsigned char* lds, int K, int m0, const bf16_t* Bt0, RowPtr rp, Epi epi) {
    float* As = (float*)lds;
    float* Bs = As + 16 * 132;
    float* Bs2 = Bs + 16 * 132;
    const int tid = threadIdx.x, ty = tid >> 5, tx = tid & 31, lr = tid >> 2, kq = tid & 3;
    const bf16_t* arow = rp(m0 + lr);
    const bf16_t* brow = Bt0 + (size_t)lr * K;
    const bf16_t* brow2 = Bt0 + (size_t)(lr + 128) * K;
    float acc[8][4], acc2[DUAL ? 8 : 1][4];
#pragma unroll
    for (int i = 0; i < 8; ++i)
#pragma unroll
        for (int j = 0; j < 4; ++j) { acc[i][j] = 0.f; if (DUAL) acc2[i][j] = 0.f; }
    for (int k0 = 0; k0 < K; k0 += 16) {
        const u32x2 ra = *(const u32x2*)(arow + k0 + kq * 4), rb = *(const u32x2*)(brow + k0 + kq * 4);
        u32x2 rb2 = (u32x2){0u, 0u}; if (DUAL) rb2 = *(const u32x2*)(brow2 + k0 + kq * 4);
        __syncthreads();
        As[(kq * 4 + 0) * 132 + lr] = bflo(ra.x); As[(kq * 4 + 1) * 132 + lr] = bfhi(ra.x); As[(kq * 4 + 2) * 132 + lr] = bflo(ra.y); As[(kq * 4 + 3) * 132 + lr] = bfhi(ra.y);
        Bs[(kq * 4 + 0) * 132 + lr] = bflo(rb.x); Bs[(kq * 4 + 1) * 132 + lr] = bfhi(rb.x); Bs[(kq * 4 + 2) * 132 + lr] = bflo(rb.y); Bs[(kq * 4 + 3) * 132 + lr] = bfhi(rb.y);
        if (DUAL) { Bs2[(kq * 4 + 0) * 132 + lr] = bflo(rb2.x); Bs2[(kq * 4 + 1) * 132 + lr] = bfhi(rb2.x); Bs2[(kq * 4 + 2) * 132 + lr] = bflo(rb2.y); Bs2[(kq * 4 + 3) * 132 + lr] = bfhi(rb2.y); }
        __syncthreads();
#pragma unroll
        for (int kk = 0; kk < 16; ++kk) {
            const f32x4 a0 = *(const f32x4*)(As + kk * 132 + ty * 8), a1 = *(const f32x4*)(As + kk * 132 + ty * 8 + 4);
            const f32x4 b = *(const f32x4*)(Bs + kk * 132 + tx * 4);
            const float av[8] = {a0.x, a0.y, a0.z, a0.w, a1.x, a1.y, a1.z, a1.w};
#pragma unroll
            for (int i = 0; i < 8; ++i) { acc[i][0] += av[i] * b.x; acc[i][1] += av[i] * b.y; acc[i][2] += av[i] * b.z; acc[i][3] += av[i] * b.w; }
            if (DUAL) {
                const f32x4 b2 = *(const f32x4*)(Bs2 + kk * 132 + tx * 4);
#pragma unroll
                for (int i = 0; i < 8; ++i) { acc2[i][0] += av[i] * b2.x; acc2[i][1] += av[i] * b2.y; acc2[i][2] += av[i] * b2.z; acc2[i][3] += av[i] * b2.w; }
            }
        }
    }
#pragma unroll
    for (int i = 0; i < 8; ++i) {
        const f32x4 v = (f32x4){acc[i][0], acc[i][1], acc[i][2], acc[i][3]};
        const f32x4 v2 = DUAL ? (f32x4){acc2[i][0], acc2[i][1], acc2[i][2], acc2[i][3]} : v;
        epi(m0 + ty * 8 + i, tx * 4, v, v2);
    }
    __syncthreads();
}

__device__ __forceinline__ void ph2(const Params& p, unsigned char* lds, int bid, int nblk) {
    const bf16_t* XM = (const bf16_t*)(p.ws + WS_XM); const bf16_t* WINT = (const bf16_t*)(p.ws + WS_WINT); bf16_t* U = (bf16_t*)(p.ws + WS_U);
    constexpr int NTN = DINP / 128, NTM = MROWS / 128;
    for (int it = bid; it < NTN * NTM; it += nblk) {
        const int pm = it / NTN, pn = it % NTN;
        auto rp = [&](int m) { return XM + (size_t)m * 1024; };
        auto epi = [&](int m, int nl, f32x4 v, f32x4) { u32x2 o; o.x = pk2(v.x, v.y); o.y = pk2(v.z, v.w); *(u32x2*)(U + (size_t)m * DINP + pn * 128 + nl) = o; };
        gemm_tile_naive<false>(lds, 1024, pm * 128, WINT + (size_t)pn * 128 * 1024, rp, epi);
    }
}

__device__ __forceinline__ void na_naive_wave(const Params& p, int witem, int lane, float* qs) {
    const bf16_t* U = (const bf16_t*)(p.ws + WS_U); bf16_t* MIX = (bf16_t*)(p.ws + WS_MIX);
    const int h = witem & 7, m = witem >> 3, b = m >> 13, t = m & 8191, r = t >> 6, c = t & 63;
    const int rs = min(max(r - 4, 0), 120), cs = min(max(c - 8, 0), 48);
    qs[lane] = bf2f(U[(size_t)m * DINP + C_QA + h * 64 + lane]) * 0.125f;
    LDS_FENCE();
    float sc[6];
#pragma unroll
    for (int i = 0; i < 6; ++i) {
        const int kk = i * 64 + lane; size_t krow; float bias = 0.f;
        if (i < 2) { const int ki = kk >> 4, kj = kk & 15; krow = (size_t)b * 8192 + (rs + ki) * 64 + cs + kj; bias = p.na_bias[(h * 15 + (rs + ki - r + 7)) * 31 + (cs + kj - c + 15)]; }
        else krow = (size_t)NLAT + b * 256 + (kk - 128);
        const u32x4* kp = (const u32x4*)(U + krow * DINP + C_KA + h * 64);
        float s = 0.f;
#pragma unroll
        for (int j = 0; j < 8; ++j) { const u32x4 w = kp[j]; const float* q = qs + j * 8;
            s += q[0] * bflo(w.x) + q[1] * bfhi(w.x) + q[2] * bflo(w.y) + q[3] * bfhi(w.y) + q[4] * bflo(w.z) + q[5] * bfhi(w.z) + q[6] * bflo(w.w) + q[7] * bfhi(w.w); }
        sc[i] = s + bias;
    }
    float mx = sc[0];
#pragma unroll
    for (int i = 1; i < 6; ++i) mx = fmaxf(mx, sc[i]);
    mx = wave_max(mx);
    float sum = 0.f;
#pragma unroll
    for (int i = 0; i < 6; ++i) { sc[i] = __expf(sc[i] - mx); sum += sc[i]; }
    sum = wave_sum(sum);
    float o = 0.f;
#pragma unroll
    for (int i = 0; i < 6; ++i) {
        for (int src = 0; src < 64; ++src) {
            const float pj = __shfl(sc[i], src);
            const int kk = i * 64 + src; size_t krow;
            if (i < 2) krow = (size_t)b * 8192 + (rs + (kk >> 4)) * 64 + cs + (kk & 15); else krow = (size_t)NLAT + b * 256 + (kk - 128);
            o += pj * bf2f(U[krow * DINP + C_VA + h * 64 + lane]);
        }
    }
    MIX[(size_t)m * 1024 + h * 64 + lane] = (bf16_t)f2bf(o / sum);
    LDS_FENCE();
}

__device__ __forceinline__ float rope_elem(const float* xr, int d, int t) {
    const int half = d >> 5, dd = d & 31, i = dd & 15;
    const float pos = (float)(half == 0 ? (t >> 6) : (t & 63));
    const float inv = exp2f(-(float)i * (13.287712379549449f / 16.f));
    const float ang = pos * inv;
    float sn, cs_; sincosf(ang, &sn, &cs_);
    const float x1 = xr[half * 32 + i], x2 = xr[half * 32 + 16 + i];
    return dd < 16 ? x1 * cs_ - x2 * sn : x1 * sn + x2 * cs_;
}

__device__ __forceinline__ void ml_stats_item(const Params& p, unsigned char* lds, int item) {
    const bf16_t* U = (const bf16_t*)(p.ws + WS_U); bf16_t* QP = (bf16_t*)(p.ws + WS_QP); bf16_t* KP = (bf16_t*)(p.ws + WS_KP);
    float* CLOC = (float*)(p.ws + WS_CLOC); float* NLOC = (float*)(p.ws + WS_NLOC); float* MLOC = (float*)(p.ws + WS_MLOC); float* BLAST = (float*)(p.ws + WS_BLAST);
    const int tid = threadIdx.x;
    const int ch = item % NCH, bh = item / NCH, h = bh & 3, b = bh >> 2;
    const bool is_ctx = ch >= 64; const int Tseq = is_ctx ? 256 : 8192, cl = is_ctx ? ch - 64 : ch, t0 = cl * 128;
    const size_t rowbase = is_ctx ? (size_t)NLAT + b * 256 : (size_t)b * 8192;
    float* Kf = (float*)lds;
    float* Vf = Kf + 128 * 64;
    float* raw = Vf + 128 * 128;
    float* gl = raw + 132 * 64;
    float* wf = gl + 512;
    float* wb = wf + 128;
    if (!is_ctx) {
        for (int idx = tid; idx < 132 * 64; idx += NTHR) { const int tt = idx >> 6, d = idx & 63, t = t0 - 2 + tt;
            raw[idx] = (t >= 0 && t < Tseq) ? bf2f(U[(rowbase + t) * DINP + C_QM + h * 64 + d]) : 0.f; }
        __syncthreads();
        for (int idx = tid; idx < 128 * 64; idx += NTHR) { const int l = idx >> 6, d = idx & 63; float a = 0.f;
#pragma unroll
            for (int j = 0; j < 5; ++j) a += p.conv_qk[j * 512 + h * 64 + d] * raw[(l + j) * 64 + d];
            Kf[idx] = siluf(a); }
        __syncthreads();
        for (int idx = tid; idx < 128 * 64; idx += NTHR) { const int l = idx >> 6, d = idx & 63;
            const float v = rope_elem(Kf + l * 64, d, t0 + l);
            QP[((size_t)b * 8192 + t0 + l) * 256 + h * 64 + d] = (bf16_t)f2bf(v * 0.125f); }
        __syncthreads();
    }
    for (int idx = tid; idx < 132 * 64; idx += NTHR) { const int tt = idx >> 6, d = idx & 63, t = t0 - 2 + tt;
        raw[idx] = (t >= 0 && t < Tseq) ? bf2f(U[(rowbase + t) * DINP + C_KM + h * 64 + d]) : 0.f; }
    __syncthreads();
    for (int idx = tid; idx < 128 * 64; idx += NTHR) { const int l = idx >> 6, d = idx & 63; float a = 0.f;
#pragma unroll
        for (int j = 0; j < 5; ++j) a += p.conv_qk[j * 512 + 256 + h * 64 + d] * raw[(l + j) * 64 + d];
        Vf[idx] = siluf(a); }
    __syncthreads();
    for (int idx = tid; idx < 128 * 64; idx += NTHR) { const int l = idx >> 6, d = idx & 63;
        const float v = is_ctx ? Vf[idx] : rope_elem(Vf + l * 64, d, t0 + l);
        const unsigned bv = f2bf(v);
        KP[(rowbase + t0 + l) * 256 + h * 64 + d] = (bf16_t)bv; Kf[idx] = __uint_as_float(bv << 16); }
    __syncthreads();
    for (int idx = tid; idx < 128 * 128; idx += NTHR) { const int l = idx >> 7, v = idx & 127; Vf[idx] = bf2f(U[(rowbase + t0 + l) * DINP + C_VM + h * 128 + v]); }
    { const int g = tid >> 7, l = tid & 127; gl[tid] = bf2f(U[(rowbase + t0 + l) * DINP + C_GT + g * 4 + h]) + p.b_gate[g * 4 + h]; }
    __syncthreads();
    if (tid == 0) {
        float run = 0.f; for (int l = 0; l < 128; ++l) { run += logsigf(gl[128 + l]); wf[l] = run; }
        const float blast = run; float m = -INFINITY;
        for (int l = 0; l < 128; ++l) { const float a = blast - wf[l] + gl[l]; wf[l] = a; m = fmaxf(m, a); }
        for (int l = 0; l < 128; ++l) wf[l] = __expf(wf[l] - m);
        BLAST[(0 * 32 + bh) * NCH + ch] = blast; MLOC[(0 * 32 + bh) * NCH + ch] = m;
    }
    if (tid == 64) {
        float run = 0.f; for (int l = 127; l >= 0; --l) { run += logsigf(gl[384 + l]); wb[l] = run; }
        const float blast = run; float m = -INFINITY;
        for (int l = 0; l < 128; ++l) { const float a = blast - wb[l] + gl[256 + l]; wb[l] = a; m = fmaxf(m, a); }
        for (int l = 0; l < 128; ++l) wb[l] = __expf(wb[l] - m);
        BLAST[(1 * 32 + bh) * NCH + ch] = blast; MLOC[(1 * 32 + bh) * NCH + ch] = m;
    }
    __syncthreads();
    { const int k = tid & 63, vg = tid >> 6;
      float af[16], ab[16]; float nf = 0.f, nb = 0.f;
#pragma unroll
      for (int i = 0; i < 16; ++i) { af[i] = 0.f; ab[i] = 0.f; }
      for (int l = 0; l < 128; ++l) {
          const float kv = Kf[l * 64 + k], a = wf[l] * kv, bq = wb[l] * kv; nf += a; nb += bq;
#pragma unroll
          for (int i = 0; i < 16; ++i) { const float vv = Vf[l * 128 + vg * 16 + i]; af[i] += a * vv; ab[i] += bq * vv; }
      }
      float* c0 = CLOC + ((size_t)(0 * 32 + bh) * NCH + ch) * 8192; float* c1 = CLOC + ((size_t)(1 * 32 + bh) * NCH + ch) * 8192;
#pragma unroll
      for (int i = 0; i < 16; ++i) { c0[(vg * 16 + i) * 64 + k] = af[i]; c1[(vg * 16 + i) * 64 + k] = ab[i]; }
      if (vg == 0) { NLOC[((size_t)(0 * 32 + bh) * NCH + ch) * 64 + k] = nf; NLOC[((size_t)(1 * 32 + bh) * NCH + ch) * 64 + k] = nb; }
    }
    __syncthreads();
}
__device__ __forceinline__ void ph3(const Params& p, unsigned char* lds, int bid, int nblk) {
    const int tid = threadIdx.x, lane = tid & 63, wave = tid >> 6;
    for (int it = bid; it < 32 * NCH; it += nblk) ml_stats_item(p, lds, it);
    float* qs = (float*)lds + wave * 64;
    for (int w = bid * NWAVES + wave; w < NLAT * 8; w += nblk * NWAVES) na_naive_wave(p, w, lane, qs);
}

__device__ __forceinline__ void ph4(const Params& p, int bid, int nblk) {
    float* CLOC = (float*)(p.ws + WS_CLOC); float* NLOC = (float*)(p.ws + WS_NLOC); const float* MLOC = (const float*)(p.ws + WS_MLOC);
    const float* BLAST = (const float*)(p.ws + WS_BLAST); float* MIN = (float*)(p.ws + WS_MIN);
    const int tid = threadIdx.x;
    for (int it = bid; it < 64 * 17; it += nblk) {
        const int q = it / 17, seg = it % 17, dir = q >> 5;
        float c_prev = 0.f, m_prev = 0.f;
        if (seg == 16 && tid > 64) continue;
        for (int step = 0; step < NCH; ++step) {
            const int ci = dir == 0 ? (step < 2 ? 64 + step : step - 2) : 65 - step;
            const float bl = BLAST[q * NCH + ci], ml = MLOC[q * NCH + ci];
            const float m_new = fmaxf(bl + m_prev, ml), sp = __expf(bl + m_prev - m_new), sl = __expf(ml - m_new);
            if (seg < 16) { float* cp = CLOC + ((size_t)q * NCH + ci) * 8192 + seg * 512 + tid; const float clv = *cp; *cp = c_prev; c_prev = sp * c_prev + sl * clv; }
            else if (tid < 64) { float* np = NLOC + ((size_t)q * NCH + ci) * 64 + tid; const float nl = *np; *np = c_prev; c_prev = sp * c_prev + sl * nl; }
            else MIN[q * NCH + ci] = m_prev;
            m_prev = m_new;
        }
    }
}

__device__ __forceinline__ void ml_out_item(const Params& p, unsigned char* lds, int item) {
    const bf16_t* U = (const bf16_t*)(p.ws + WS_U); const bf16_t* QP = (const bf16_t*)(p.ws + WS_QP); const bf16_t* KP = (const bf16_t*)(p.ws + WS_KP);
    const float* CLOC = (const float*)(p.ws + WS_CLOC); const float* NLOC = (const float*)(p.ws + WS_NLOC); const float* MIN = (const float*)(p.ws + WS_MIN);
    bf16_t* MIX = (bf16_t*)(p.ws + WS_MIX);
    const int tid = threadIdx.x, lane = tid & 63, wave = tid >> 6;
    const int J = item & 63, bh = item >> 6, h = bh & 3, b = bh >> 2, t0 = J * 128;
    const size_t row0 = (size_t)b * 8192 + t0;
    bf16_t* Qf = (bf16_t*)lds;
    bf16_t* Kf = Qf + 128 * 64;
    bf16_t* Vb = Kf + 128 * 64;
    float* S = (float*)(Vb + 128 * 128);
    float* gl = S + 128 * 128;
    float* bc = gl + 512;
    float* mt = bc + 128;
    float* inter = mt + 128;
    float* dnm = inter + 128;
    float* nin = dnm + 128;
    for (int idx = tid; idx < 128 * 64; idx += NTHR) { const int l = idx >> 6, d = idx & 63;
        Qf[idx] = QP[(row0 + l) * 256 + h * 64 + d]; Kf[idx] = KP[(row0 + l) * 256 + h * 64 + d]; }
    for (int idx = tid; idx < 128 * 128; idx += NTHR) { const int l = idx >> 7, v = idx & 127; Vb[idx] = U[(row0 + l) * DINP + C_VM + h * 128 + v]; }
    { const int g = tid >> 7, l = tid & 127; gl[tid] = bf2f(U[(row0 + l) * DINP + C_GT + g * 4 + h]) + p.b_gate[g * 4 + h]; }
    __syncthreads();
    const int v = tid & 127, tq = tid >> 7;
    float hsum[32];
#pragma unroll
    for (int i = 0; i < 32; ++i) hsum[i] = 0.f;
    for (int dir = 0; dir < 2; ++dir) {
        const size_t sidx = (size_t)(dir * 32 + bh) * NCH + J;
        const float* ig = gl + dir * 256; const float* fg = gl + dir * 256 + 128;
        if (tid == 0) {
            const float m_in = MIN[sidx];
            if (dir == 0) { float run = 0.f, gm = -INFINITY; for (int l = 0; l < 128; ++l) { run += logsigf(fg[l]); bc[l] = run; gm = fmaxf(gm, ig[l] - run); const float mp = run + m_in, m = fmaxf(run + gm, mp); mt[l] = m; inter[l] = __expf(mp - m); } }
            else { float run = 0.f, gm = -INFINITY; for (int l = 127; l >= 0; --l) { run += logsigf(fg[l]); bc[l] = run; gm = fmaxf(gm, ig[l] - run); const float mp = run + m_in, m = fmaxf(run + gm, mp); mt[l] = m; inter[l] = __expf(mp - m); } }
        }
        if (tid >= 64 && tid < 128) nin[tid - 64] = NLOC[sidx * 64 + (tid - 64)];
        __syncthreads();
        for (int idx = tid; idx < 128 * 128; idx += NTHR) {
            const int t = idx >> 7, s = idx & 127; const bool valid = dir == 0 ? (s <= t) : (s >= t);
            float val = 0.f;
            if (valid) { float dot = 0.f;
#pragma unroll 16
                for (int k = 0; k < 64; ++k) dot += bf2f(Qf[t * 64 + k]) * bf2f(Kf[s * 64 + k]);
                val = dot * __expf(bc[t] - bc[s] + ig[s] - mt[t]); }
            S[idx] = val;
        }
        __syncthreads();
        if (tid < 128) { float d = 0.f; for (int s = 0; s < 128; ++s) d += S[tid * 128 + s]; float nq = 0.f; for (int k = 0; k < 64; ++k) nq += nin[k] * bf2f(Qf[tid * 64 + k]);
            d += inter[tid] * nq; dnm[tid] = fmaxf(fabsf(d), __expf(-mt[tid])); }
        float acc[32];
#pragma unroll
        for (int i = 0; i < 32; ++i) acc[i] = 0.f;
        const float* cin = CLOC + sidx * 8192 + (size_t)v * 64;
        for (int k = 0; k < 64; ++k) { const float cv = cin[k];
#pragma unroll
            for (int i = 0; i < 32; ++i) acc[i] += cv * bf2f(Qf[(tq * 32 + i) * 64 + k]); }
#pragma unroll
        for (int i = 0; i < 32; ++i) acc[i] *= inter[tq * 32 + i];
        for (int s = 0; s < 128; ++s) { const float vv = bf2f(Vb[s * 128 + v]);
#pragma unroll
            for (int i = 0; i < 32; ++i) acc[i] += S[(tq * 32 + i) * 128 + s] * vv; }
        __syncthreads();
#pragma unroll
        for (int i = 0; i < 32; ++i) { const int t = tq * 32 + i; hsum[i] += acc[i] / dnm[t]; }
        __syncthreads();
    }
#pragma unroll
    for (int i = 0; i < 32; ++i) S[(tq * 32 + i) * 128 + v] = hsum[i];
    __syncthreads();
    for (int t = wave * 16; t < wave * 16 + 16; ++t) {
        const float a0 = S[t * 128 + lane], a1 = S[t * 128 + 64 + lane];
        const float mu = wave_sum(a0 + a1) * (1.f / 128.f);
        const float d0 = a0 - mu, d1 = a1 - mu;
        const float var = wave_sum(d0 * d0 + d1 * d1) * (1.f / 128.f), rstd = rsqrtf(var + LN_EPS);
        const size_t row = row0 + t;
        const float o0 = d0 * rstd * p.ml_norm_g[h * 128 + lane] * sigmoidf_(bf2f(U[row * DINP + C_OM + h * 128 + lane]));
        const float o1 = d1 * rstd * p.ml_norm_g[h * 128 + 64 + lane] * sigmoidf_(bf2f(U[row * DINP + C_OM + h * 128 + 64 + lane]));
        MIX[row * 1024 + 512 + h * 128 + lane] = (bf16_t)f2bf(o0); MIX[row * 1024 + 512 + h * 128 + 64 + lane] = (bf16_t)f2bf(o1);
    }
    __syncthreads();
}
__device__ __forceinline__ void ph5(const Params& p, unsigned char* lds, int bid, int nblk) { for (int it = bid; it < 32 * 64; it += nblk) ml_out_item(p, lds, it); }

__device__ __forceinline__ void ph6(const Params& p, unsigned char* lds, int bid, int nblk) {
    const bf16_t* MIX = (const bf16_t*)(p.ws + WS_MIX); const bf16_t* WOUTT = (const bf16_t*)(p.ws + WS_WOUTT); const float* MOD = (const float*)(p.ws + WS_MOD);
    for (int it = bid; it < 512 * 8; it += nblk) {
        const int pm = it >> 3, pn = it & 7;
        auto rp = [&](int m) { return MIX + (size_t)m * 1024; };
        auto epi = [&](int m, int nl, f32x4 v, f32x4) { const int n = pn * 128 + nl; const f32x4 xv = *(const f32x4*)(p.x + (size_t)m * 1024 + n); const f32x4 g = *(const f32x4*)(MOD + (m >> 13) * 6144 + 2048 + n);
            *(f32x4*)(p.out + (size_t)m * 1024 + n) = ALPHA * xv + g * v; };
        gemm_tile_naive<false>(lds, 1024, pm * 128, WOUTT + (size_t)pn * 128 * 1024, rp, epi);
    }
}

__device__ __forceinline__ void ph7(const Params& p, unsigned char* lds, int bid, int nblk) {
    const int tid = threadIdx.x, lane = tid & 63, wave = tid >> 6;
    const float* MOD = (const float*)(p.ws + WS_MOD); bf16_t* HMOD = (bf16_t*)(p.ws + WS_HMOD); float* AFF = (float*)(p.ws + WS_AFF);
    const int gw = bid * NWAVES + wave, ngw = nblk * NWAVES;
    for (int m = gw; m < NLAT; m += ngw) {
        const int b = m >> 13, t = m & 8191;
        const float* y = p.out + (size_t)m * 1024; const float* sh2 = MOD + b * 6144 + 3072; const float* sc2 = sh2 + 1024;
        f32x4 v[4]; float s = 0.f;
#pragma unroll
        for (int j = 0; j < 4; ++j) { v[j] = *(const f32x4*)(y + j * 256 + lane * 4); s += (v[j].x + v[j].y) + (v[j].z + v[j].w); }
        const float mean = wave_sum(s) * (1.f / 1024.f); float s2 = 0.f;
#pragma unroll
        for (int j = 0; j < 4; ++j) { v[j] = v[j] - mean; s2 += (v[j].x * v[j].x + v[j].y * v[j].y) + (v[j].z * v[j].z + v[j].w * v[j].w); }
        const float rstd = rsqrtf(wave_sum(s2) * (1.f / 1024.f) + LN_EPS);
        float lg[16];
#pragma unroll
        for (int e = 0; e < 16; ++e) lg[e] = 0.f;
#pragma unroll
        for (int j = 0; j < 4; ++j) {
            const int k = j * 256 + lane * 4;
            const f32x4 g = *(const f32x4*)(p.ln1_g + k), be = *(const f32x4*)(p.ln1_b + k), a = *(const f32x4*)(sc2 + k), sb = *(const f32x4*)(sh2 + k);
            f32x4 hm = (v[j] * rstd * g + be) * (1.f + a) + sb;
            u32x2 o; o.x = pk2(hm.x, hm.y); o.y = pk2(hm.z, hm.w); *(u32x2*)(HMOD + (size_t)m * 1024 + k) = o;
            const float hv[4] = {hm.x, hm.y, hm.z, hm.w};
#pragma unroll
            for (int i = 0; i < 4; ++i) { const f32x4* wr = (const f32x4*)(p.w_router + (size_t)(k + i) * 16);
#pragma unroll
                for (int q = 0; q < 4; ++q) { const f32x4 w = wr[q]; lg[q * 4 + 0] += hv[i] * w.x; lg[q * 4 + 1] += hv[i] * w.y; lg[q * 4 + 2] += hv[i] * w.z; lg[q * 4 + 3] += hv[i] * w.w; } }
        }
        float mx = -INFINITY;
#pragma unroll
        for (int e = 0; e < 16; ++e) { lg[e] = wave_sum(lg[e]); mx = fmaxf(mx, lg[e]); }
        float sum = 0.f;
#pragma unroll
        for (int e = 0; e < 16; ++e) { lg[e] = expf(lg[e] - mx); sum += lg[e]; }
        float mine = 0.f;
#pragma unroll
        for (int e = 0; e < 16; ++e) if (lane == e) mine = lg[e] / sum;
        if (lane < 16) AFF[((size_t)b * 16 + lane) * 8192 + t] = mine;
    }
    float* scr = (float*)lds + wave * (64 * 33);
    bf16_t* WGUT = (bf16_t*)(p.ws + WS_WGUT); bf16_t* WDT = (bf16_t*)(p.ws + WS_WDT);
    for (int it = gw; it < NE * 3 * 1408; it += ngw) {
        const int e = it / (3 * 1408), r = it % (3 * 1408), which = r / 1408, q = r % 1408;
        if (which < 2) { const int kb = q / 88, nb = q % 88, n0 = nb * 32; const float* W = (which == 0 ? p.w_eg : p.w_eu) + (size_t)e * 1024 * DFF;
            transpose_item(W, DFF, kb * 64, n0, 32, WGUT + (size_t)e * 2 * DFF * 1024, (size_t)((n0 >> 7) * 256 + which * 128 + (n0 & 127)), 1024, scr, lane); }
        else { const int kb = q / 32, nb = q % 32; const float* W = p.w_ed + (size_t)e * DFF * 1024;
            transpose_item(W, 1024, kb * 64, nb * 32, 32, WDT + (size_t)e * 1024 * DFF, (size_t)nb * 32, DFF, scr, lane); }
    }
}

__device__ __forceinline__ void topk_item(const Params& p, unsigned char* lds, int item) {
    const float* AFF = (const float*)(p.ws + WS_AFF); int* IDX = (int*)(p.ws + WS_IDX); float* GSEL = (float*)(p.ws + WS_GSEL); int* INV = (int*)(p.ws + WS_INV);
    const int tid = threadIdx.x, lane = tid & 63, wave = tid >> 6;
    const int b = item >> 4, e = item & 15;
    unsigned* wcnt = (unsigned*)lds;
    const float* a = AFF + ((size_t)b * 16 + e) * 8192;
    unsigned bits[16];
#pragma unroll
    for (int j = 0; j < 16; ++j) bits[j] = __float_as_uint(a[j * 512 + tid]);
    unsigned tau = 0u;
    for (int bit = 31; bit >= 0; --bit) {
        const unsigned cand = tau | (1u << bit);
        unsigned cnt = 0;
#pragma unroll
        for (int j = 0; j < 16; ++j) cnt += (unsigned)__popcll(__ballot(bits[j] >= cand));
        if (lane == 0) wcnt[wave] = cnt;
        __syncthreads();
        unsigned tot = 0;
#pragma unroll
        for (int w = 0; w < 8; ++w) tot += wcnt[w];
        if (tot >= (unsigned)CAP) tau = cand;
        __syncthreads();
    }
    unsigned ngt;
    { unsigned cnt = 0;
#pragma unroll
      for (int j = 0; j < 16; ++j) cnt += (unsigned)__popcll(__ballot(bits[j] > tau));
      if (lane == 0) wcnt[wave] = cnt;
      __syncthreads();
      ngt = 0;
#pragma unroll
      for (int w = 0; w < 8; ++w) ngt += wcnt[w];
      __syncthreads(); }
    const unsigned need = (unsigned)CAP - ngt;
    unsigned base_gt = 0, base_eq = 0;
    const unsigned long long lt_mask = (1ull << lane) - 1ull;
#pragma unroll
    for (int j = 0; j < 16; ++j) {
        const bool gt = bits[j] > tau, eq = bits[j] == tau;
        const unsigned long long bg = __ballot(gt), be = __ballot(eq);
        if (lane == 0) { wcnt[wave] = (unsigned)__popcll(bg); wcnt[8 + wave] = (unsigned)__popcll(be); }
        __syncthreads();
        unsigned pgt = 0, peq = 0, tgt = 0, teq = 0;
#pragma unroll
        for (int w = 0; w < 8; ++w) { const unsigned cg_ = wcnt[w], ce = wcnt[8 + w]; if (w < wave) { pgt += cg_; peq += ce; } tgt += cg_; teq += ce; }
        const unsigned gt_before = base_gt + pgt + (unsigned)__popcll(bg & lt_mask), eq_before = base_eq + peq + (unsigned)__popcll(be & lt_mask);
        const bool sel = gt || (eq && eq_before < need);
        const unsigned slot = gt_before + (eq_before < need ? eq_before : need);
        const int i = j * 512 + tid;
        if (sel) { IDX[(e * 8 + b) * CAP + slot] = i; GSEL[(e * 8 + b) * CAP + slot] = __uint_as_float(bits[j]); }
        INV[((size_t)b * 8192 + i) * 16 + e] = sel ? (int)slot : -1;
        base_gt += tgt; base_eq += teq;
        __syncthreads();
    }
}
__device__ __forceinline__ void ph8(const Params& p, unsigned char* lds, int bid, int nblk) { for (int it = bid; it < 128; it += nblk) topk_item(p, lds, it); }

__device__ __forceinline__ void ph_gu(const Params& p, unsigned char* lds, int grp, int bid, int nblk) {
    const bf16_t* HMOD = (const bf16_t*)(p.ws + WS_HMOD); const bf16_t* WGUT = (const bf16_t*)(p.ws + WS_WGUT); const int* IDX = (const int*)(p.ws + WS_IDX);
    bf16_t* ACT = (bf16_t*)(p.ws + WS_ACT);
    for (int it = bid; it < EPG * 64 * 22; it += nblk) {
        const int el = it / (64 * 22), r = it % (64 * 22), pm = r / 22, pn = r % 22, e = grp * EPG + el;
        auto rp = [&](int m) { const int bb = m >> 10, s = m & 1023; return HMOD + ((size_t)bb * 8192 + IDX[(e * 8 + bb) * CAP + s]) * 1024; };
        auto epi = [&](int m, int nl, f32x4 g, f32x4 u) { u32x2 o; o.x = pk2(siluf(g.x) * u.x, siluf(g.y) * u.y); o.y = pk2(siluf(g.z) * u.z, siluf(g.w) * u.w);
            *(u32x2*)(ACT + ((size_t)el * 8192 + m) * DFF + pn * 128 + nl) = o; };
        gemm_tile_naive<true>(lds, 1024, pm * 128, WGUT + ((size_t)e * 2 * DFF + (size_t)pn * 256) * 1024, rp, epi);
    }
}
__device__ __forceinline__ void ph_dn(const Params& p, unsigned char* lds, int grp, int bid, int nblk) {
    const bf16_t* ACT = (const bf16_t*)(p.ws + WS_ACT); const bf16_t* WDT = (const bf16_t*)(p.ws + WS_WDT); bf16_t* EO = (bf16_t*)(p.ws + WS_EO);
    for (int it = bid; it < EPG * 64 * 8; it += nblk) {
        const int el = it / (64 * 8), r = it % (64 * 8), pm = r >> 3, pn = r & 7, e = grp * EPG + el;
        auto rp = [&](int m) { return ACT + ((size_t)el * 8192 + m) * DFF; };
        auto epi = [&](int m, int nl, f32x4 v, f32x4) { u32x2 o; o.x = pk2(v.x, v.y); o.y = pk2(v.z, v.w); *(u32x2*)(EO + ((size_t)e * 8192 + m) * 1024 + pn * 128 + nl) = o; };
        gemm_tile_naive<false>(lds, DFF, pm * 128, WDT + ((size_t)e * 1024 + (size_t)pn * 128) * DFF, rp, epi);
    }
}

__device__ __forceinline__ void ph_final(const Params& p, int bid, int nblk) {
    const int tid = threadIdx.x, lane = tid & 63, wave = tid >> 6;
    const float* MOD = (const float*)(p.ws + WS_MOD); const bf16_t* EO = (const bf16_t*)(p.ws + WS_EO); const float* GSEL = (const float*)(p.ws + WS_GSEL); const int* INV = (const int*)(p.ws + WS_INV);
    for (int m = bid * NWAVES + wave; m < NLAT; m += nblk * NWAVES) {
        const int b = m >> 13;
        float* y = p.out + (size_t)m * 1024; const float* g2 = MOD + b * 6144 + 5120;
        f32x4 v[4]; float s = 0.f;
#pragma unroll
        for (int j = 0; j < 4; ++j) { v[j] = *(const f32x4*)(y + j * 256 + lane * 4); s += (v[j].x + v[j].y) + (v[j].z + v[j].w); }
        const float mean = wave_sum(s) * (1.f / 1024.f); float s2 = 0.f;
#pragma unroll
        for (int j = 0; j < 4; ++j) { v[j] = v[j] - mean; s2 += (v[j].x * v[j].x + v[j].y * v[j].y) + (v[j].z * v[j].z + v[j].w * v[j].w); }
        const float rstd = rsqrtf(wave_sum(s2) * (1.f / 1024.f) + LN_EPS);
        f32x4 moe[4];
#pragma unroll
        for (int j = 0; j < 4; ++j) moe[j] = (f32x4){0.f, 0.f, 0.f, 0.f};
        const int myinv = lane < 16 ? INV[(size_t)m * 16 + lane] : -1;
        for (int e = 0; e < 16; ++e) {
            const int slot = __shfl(myinv, e);
            if (slot >= 0) {
                const float g = GSEL[(e * 8 + b) * CAP + slot];
                const bf16_t* row = EO + ((size_t)e * 8192 + b * 1024 + slot) * 1024;
#pragma unroll
                for (int j = 0; j < 4; ++j) { const u32x2 w = *(const u32x2*)(row + j * 256 + lane * 4); moe[j].x += g * bflo(w.x); moe[j].y += g * bfhi(w.x); moe[j].z += g * bflo(w.y); moe[j].w += g * bfhi(w.y); }
            }
        }
        float s3 = 0.f;
#pragma unroll
        for (int j = 0; j < 4; ++j) { const int k = j * 256 + lane * 4;
            const f32x4 g = *(const f32x4*)(p.ln1_g + k), be = *(const f32x4*)(p.ln1_b + k), gg = *(const f32x4*)(g2 + k);
            v[j] = ALPHA * (v[j] * rstd * g + be) + gg * moe[j]; s3 += (v[j].x + v[j].y) + (v[j].z + v[j].w); }
        const float mean2 = wave_sum(s3) * (1.f / 1024.f); float s4 = 0.f;
#pragma unroll
        for (int j = 0; j < 4; ++j) { v[j] = v[j] - mean2; s4 += (v[j].x * v[j].x + v[j].y * v[j].y) + (v[j].z * v[j].z + v[j].w * v[j].w); }
        const float rstd2 = rsqrtf(wave_sum(s4) * (1.f / 1024.f) + LN_EPS);
#pragma unroll
        for (int j = 0; j < 4; ++j) { const int k = j * 256 + lane * 4; const f32x4 g = *(const f32x4*)(p.ln2_g + k), be = *(const f32x4*)(p.ln2_b + k);
            *(f32x4*)(y + k) = v[j] * rstd2 * g + be; }
    }
}

constexpr int NPHASE = 14;
#ifndef ONLY_PH
#define ONLY_PH -1
#endif
#define PH_EN(n) (ONLY_PH < 0 || ONLY_PH == (n))
template <int PH>
__global__ void __launch_bounds__(NTHR, 2) mk_phase(Params p) {
    extern __shared__ __attribute__((aligned(16))) unsigned char lds[];
    const int bid = blockIdx.x, nblk = gridDim.x;
    if constexpr (PH == 0) ph0(p, lds, bid, nblk);
    if constexpr (PH == 1) ph1(p, bid, nblk);
    if constexpr (PH == 2) ph2(p, lds, bid, nblk);
    if constexpr (PH == 3) ph3(p, lds, bid, nblk);
    if constexpr (PH == 4) ph4(p, bid, nblk);
    if constexpr (PH == 5) ph5(p, lds, bid, nblk);
    if constexpr (PH == 6) ph6(p, lds, bid, nblk);
    if constexpr (PH == 7) ph7(p, lds, bid, nblk);
    if constexpr (PH == 8) ph8(p, lds, bid, nblk);
    if constexpr (PH == 9) ph_gu(p, lds, 0, bid, nblk);
    if constexpr (PH == 10) ph_dn(p, lds, 0, bid, nblk);
    if constexpr (PH == 11) ph_gu(p, lds, 1, bid, nblk);
    if constexpr (PH == 12) ph_dn(p, lds, 1, bid, nblk);
    if constexpr (PH == 13) ph_final(p, bid, nblk);
}
template <int PH> static void launch_phase(const Params& p, hipStream_t stream) {
    static bool attr = false;
    if (!attr) { (void)hipFuncSetAttribute((const void*)mk_phase<PH>, hipFuncAttributeMaxDynamicSharedMemorySize, LDS_BYTES); attr = true; }
    hipLaunchKernelGGL(mk_phase<PH>, dim3(1024), dim3(NTHR), LDS_BYTES, stream, p);
}

extern "C" void kernel_launch(void* const* d_in, const int* in_sizes, int n_in, void* d_out, int out_size, void* d_ws, size_t ws_size, hipStream_t stream) {
    if (n_in != 20 || out_size != NLAT * D_ || ws_size < WS_END) { fprintf(stderr, "kernel_launch: unexpected shapes (n_in %d out %d ws %zu need %zu)\n", n_in, out_size, ws_size, (size_t)WS_END); return; }
    Params p{};
    const float** pp = (const float**)&p;
    for (int i = 0; i < 20; ++i) pp[i] = (const float*)d_in[i];
    p.out = (float*)d_out; p.ws = (unsigned char*)d_ws;
    launch_phase<0>(p, stream); launch_phase<1>(p, stream); launch_phase<2>(p, stream); launch_phase<3>(p, stream); launch_phase<4>(p, stream);
    launch_phase<5>(p, stream); launch_phase<6>(p, stream); launch_phase<7>(p, stream); launch_phase<8>(p, stream); launch_phase<9>(p, stream);
    launch_phase<10>(p, stream); launch_phase<11>(p, stream); launch_phase<12>(p, stream); launch_phase<13>(p, stream);
}
```

```cpp
#include <hip/hip_runtime.h>
#include <hip/hip_cooperative_groups.h>
#include <cstdio>
#include <cstdint>
namespace cg = cooperative_groups;
#ifndef REPMASK
#define REPMASK 0
#endif
#define REPN(k) ((((REPMASK) >> (k)) & 1) ? 2 : 1)

typedef unsigned short bf16_t;
#define GAS __attribute__((address_space(1)))
typedef float f32x4 __attribute__((ext_vector_type(4)));
typedef unsigned u32x4 __attribute__((ext_vector_type(4)));
typedef unsigned u32x2 __attribute__((ext_vector_type(2)));

constexpr int NB = 8, T_ = 8192, D_ = 1024, LC = 256;
constexpr int NLAT = NB * T_, NCTX = NB * LC, MROWS = NLAT + NCTX;
constexpr int DIN = 3088, DINP = 3328;
constexpr int NE = 16, CAP = 1024, DFF = 2816;
constexpr int C_QA = 0, C_KA = 512, C_VA = 1024, C_QM = 1536, C_KM = 1792, C_VM = 2048, C_OM = 2560, C_GT = 3072;
constexpr int NCH = 66;
constexpr float LN_EPS = 1e-5f;
constexpr float ALPHA = 1.189207115002721f;
constexpr int NGROUPS = 1, EPG = NE / NGROUPS;

constexpr int NTHR = 512, NWAVES = 8;
constexpr int LDS_BYTES = 163840;

constexpr size_t MiB = 1u << 20;
constexpr size_t WS_CTL = 0;
constexpr size_t WS_MOD = 1 * MiB;
constexpr size_t WS_ROPE = 1 * MiB + 256 * 1024;
constexpr size_t WS_BLAST = 1 * MiB + 512 * 1024;
constexpr size_t WS_MLOC = WS_BLAST + 32 * 1024;
constexpr size_t WS_MIN = WS_MLOC + 32 * 1024;
constexpr size_t WS_NLOC = 2 * MiB;
constexpr size_t WS_IDX = 4 * MiB;
constexpr size_t WS_GSEL = 4 * MiB + 512 * 1024;
constexpr size_t WS_AFF = 5 * MiB;
constexpr size_t WS_INV = 9 * MiB;
constexpr size_t WS_WINT = 16 * MiB;
constexpr size_t WS_WOUTT = 23 * MiB;
constexpr size_t WS_XM = 32 * MiB;
constexpr size_t WS_U = 164 * MiB;
constexpr size_t WS_QP = 593 * MiB;
constexpr size_t WS_KP = 625 * MiB;
constexpr size_t WS_CLOC = 658 * MiB;
constexpr size_t WS_MIX = 32 * MiB;
constexpr size_t WS_WOUTG = 948 * MiB;
constexpr size_t WS_Y = 820 * MiB;
constexpr size_t WS_HMOD = 16 * MiB;
constexpr size_t WS_WGUT = 688 * MiB;
constexpr size_t WS_WDT = 776 * MiB;
constexpr size_t WS_EO = 80 * MiB;
constexpr size_t WS_ACT = 336 * MiB;
constexpr size_t WS_END = WS_WDT + (size_t)NE * D_ * DFF;
static_assert(WS_XM + (size_t)MROWS * D_ * 2 <= WS_U, "map");
static_assert(WS_U + (size_t)MROWS * DINP * 2 <= WS_QP, "map");
static_assert(WS_KP + (size_t)MROWS * 256 * 2 <= WS_CLOC, "map");
static_assert(WS_CLOC + (size_t)64 * NCH * 8192 * 4 <= WS_Y, "map");
static_assert(WS_MIX + (size_t)NLAT * D_ * 2 <= WS_U, "map");
static_assert(WS_Y + (size_t)NLAT * D_ * 2 <= WS_WOUTG && WS_WOUTG + (size_t)NB * D_ * D_ * 2 <= 1024 * MiB, "map");
static_assert(WS_HMOD + (size_t)NLAT * D_ <= WS_EO && WS_EO + (size_t)NE * 8192 * D_ * 2 <= WS_ACT, "map");
static_assert(WS_ACT + (size_t)NE * 8192 * DFF <= WS_WGUT && WS_WGUT + (size_t)NE * 2 * DFF * D_ <= WS_WDT, "map");
static_assert(WS_MIX + (size_t)NLAT * D_ * 2 <= WS_WGUT && WS_CLOC <= WS_WGUT, "map");
static_assert(WS_END <= WS_Y, "map");

struct Params {
    const float *x, *c, *ctx, *c_ctx, *w_ada, *b_ada, *w_in, *b_gate, *conv_qk, *na_bias, *ml_norm_g, *w_out,
        *ln1_g, *ln1_b, *w_router, *w_eg, *w_eu, *w_ed, *ln2_g, *ln2_b;
    float* out; unsigned char* ws;
    int ph_lo, ph_hi;
};


template <class T> __device__ __forceinline__ T* as_global(T* p) { return (T*)(__attribute__((address_space(1))) T*)p; }
__device__ __forceinline__ Params load_params_s() {
    const Params* kp = (const Params*)__builtin_amdgcn_kernarg_segment_ptr(); asm volatile("" : "+s"(kp));
    const __attribute__((address_space(4))) unsigned long long* kc = (const __attribute__((address_space(4))) unsigned long long*)(unsigned long long)kp;
    Params q;
    q.x = (const float*)kc[0]; q.c = (const float*)kc[1]; q.ctx = (const float*)kc[2]; q.c_ctx = (const float*)kc[3]; q.w_ada = (const float*)kc[4]; q.b_ada = (const float*)kc[5]; q.w_in = (const float*)kc[6];
    q.b_gate = (const float*)kc[7]; q.conv_qk = (const float*)kc[8]; q.na_bias = (const float*)kc[9]; q.ml_norm_g = (const float*)kc[10]; q.w_out = (const float*)kc[11];
    q.ln1_g = (const float*)kc[12]; q.ln1_b = (const float*)kc[13]; q.w_router = (const float*)kc[14]; q.w_eg = (const float*)kc[15]; q.w_eu = (const float*)kc[16]; q.w_ed = (const float*)kc[17];
    q.ln2_g = (const float*)kc[18]; q.ln2_b = (const float*)kc[19]; q.out = (float*)kc[20]; q.ws = (unsigned char*)kc[21];
    { const unsigned long long ph = kc[22]; q.ph_lo = (int)(unsigned)ph; q.ph_hi = (int)(unsigned)(ph >> 32); }
    q.x = as_global(q.x); q.c = as_global(q.c); q.ctx = as_global(q.ctx); q.c_ctx = as_global(q.c_ctx); q.w_ada = as_global(q.w_ada); q.b_ada = as_global(q.b_ada); q.w_in = as_global(q.w_in);
    q.b_gate = as_global(q.b_gate); q.conv_qk = as_global(q.conv_qk); q.na_bias = as_global(q.na_bias); q.ml_norm_g = as_global(q.ml_norm_g); q.w_out = as_global(q.w_out);
    q.ln1_g = as_global(q.ln1_g); q.ln1_b = as_global(q.ln1_b); q.w_router = as_global(q.w_router); q.w_eg = as_global(q.w_eg); q.w_eu = as_global(q.w_eu); q.w_ed = as_global(q.w_ed);
    q.ln2_g = as_global(q.ln2_g); q.ln2_b = as_global(q.ln2_b); q.out = as_global(q.out); q.ws = as_global(q.ws);
    return q;
}
__device__ __forceinline__ Params load_params() {
    const Params* kp = (const Params*)__builtin_amdgcn_kernarg_segment_ptr(); asm volatile("" : "+s"(kp));
    Params q = *kp;
    q.x = as_global(q.x); q.c = as_global(q.c); q.ctx = as_global(q.ctx); q.c_ctx = as_global(q.c_ctx); q.w_ada = as_global(q.w_ada); q.b_ada = as_global(q.b_ada); q.w_in = as_global(q.w_in);
    q.b_gate = as_global(q.b_gate); q.conv_qk = as_global(q.conv_qk); q.na_bias = as_global(q.na_bias); q.ml_norm_g = as_global(q.ml_norm_g); q.w_out = as_global(q.w_out);
    q.ln1_g = as_global(q.ln1_g); q.ln1_b = as_global(q.ln1_b); q.w_router = as_global(q.w_router); q.w_eg = as_global(q.w_eg); q.w_eu = as_global(q.w_eu); q.w_ed = as_global(q.w_ed);
    q.ln2_g = as_global(q.ln2_g); q.ln2_b = as_global(q.ln2_b); q.out = as_global(q.out); q.ws = as_global(q.ws);
    return q;
}
__device__ __forceinline__ float bf2f(bf16_t v) { return __uint_as_float((unsigned)v << 16); }
__device__ __forceinline__ unsigned f2bf(float f) { unsigned u = __float_as_uint(f); return (u + 0x7fffu + ((u >> 16) & 1u)) >> 16; }
__device__ __forceinline__ unsigned pk2(float lo, float hi) { return f2bf(lo) | (f2bf(hi) << 16); }
__device__ __forceinline__ float bflo(unsigned w) { return __uint_as_float(w << 16); }
__device__ __forceinline__ float bfhi(unsigned w) { return __uint_as_float(w & 0xffff0000u); }
typedef _Float16 f16x2 __attribute__((ext_vector_type(2)));
typedef float f32x2_ __attribute__((ext_vector_type(2)));
__device__ __forceinline__ unsigned pk_f16(float lo, float hi) {
    const f32x2_ v = {__builtin_amdgcn_fmed3f(lo, -65504.f, 65504.f), __builtin_amdgcn_fmed3f(hi, -65504.f, 65504.f)};
    const f16x2 h = __builtin_convertvector(v, f16x2); return __builtin_bit_cast(unsigned, h); }
__device__ __forceinline__ float hlo(unsigned w) { const f16x2 h = __builtin_bit_cast(f16x2, w); return (float)h.x; }
__device__ __forceinline__ float hhi(unsigned w) { const f16x2 h = __builtin_bit_cast(f16x2, w); return (float)h.y; }
__device__ __forceinline__ float wave_sum(float v) {
#pragma unroll
    for (int o = 1; o < 64; o <<= 1) v += __shfl_xor(v, o);
    return v;
}
__device__ __forceinline__ float wave_max(float v) {
#pragma unroll
    for (int o = 1; o < 64; o <<= 1) v = fmaxf(v, __shfl_xor(v, o));
    return v;
}

__device__ __forceinline__ float wscan_add(float v, int lane) {
#pragma unroll
    for (int o = 1; o < 64; o <<= 1) { const float t = __shfl_up(v, o); if (lane >= o) v += t; }
    return v;
}
__device__ __forceinline__ float wscan_max(float v, int lane) {
#pragma unroll
    for (int o = 1; o < 64; o <<= 1) { const float t = __shfl_up(v, o); if (lane >= o) v = fmaxf(v, t); }
    return v;
}
typedef short bf16x8_t __attribute__((ext_vector_type(8)));
typedef short bf16x4_t __attribute__((ext_vector_type(4)));
typedef float f32x2_t __attribute__((ext_vector_type(2)));
typedef __bf16 bf16x2_t __attribute__((ext_vector_type(2)));
__device__ __forceinline__ unsigned cvtpk(float lo, float hi) { const f32x2_t v = {lo, hi}; const bf16x2_t b = __builtin_convertvector(v, bf16x2_t); return __builtin_bit_cast(unsigned, b); }
__device__ __forceinline__ float siluf(float v) { return v * __builtin_amdgcn_rcpf(1.f + __expf(-v)); }
__device__ __forceinline__ float sigmoidf_(float v) { return __builtin_amdgcn_rcpf(1.f + __expf(-v)); }
__device__ __forceinline__ float logsigf(float v) { return fminf(v, 0.f) - log1pf(__expf(-fabsf(v))); }
__device__ __forceinline__ int ltid() { int t = threadIdx.x; asm volatile("" : "+v"(t)); return t; }
#define FP8EMU 0
__device__ __forceinline__ float q8(float x) { const int p = __builtin_amdgcn_cvt_pk_fp8_f32(x, x, 0, false); return __builtin_amdgcn_cvt_f32_fp8(p, 0); }
__device__ __forceinline__ unsigned pk4_fp8(float a, float b, float c, float d) { int w = __builtin_amdgcn_cvt_pk_fp8_f32(a, b, 0, false); w = __builtin_amdgcn_cvt_pk_fp8_f32(c, d, w, true); return (unsigned)w; }
#define LDS_FENCE() asm volatile("s_waitcnt lgkmcnt(0)" ::: "memory")

__device__ __forceinline__ void ph_ada_item(const Params& p, unsigned char* lds, int item) {
    float* sc = (float*)lds;
    float* red = sc + 9 * 1024;
    const int tid = ltid();
    float* MOD = (float*)(p.ws + WS_MOD);
    for (int i = tid; i < 9 * 1024; i += NTHR) { const int r = i >> 10, k = i & 1023; const float v = r < 8 ? p.c[r * 1024 + k] : p.c_ctx[k]; sc[i] = v / (1.f + expf(-v)); }
    __syncthreads();
    const int col = item * 64 + (tid & 63), ks = tid >> 6;
    float acc[9];
#pragma unroll
    for (int r = 0; r < 9; ++r) acc[r] = 0.f;
    { const GAS float* wa = (const GAS float*)p.w_ada + col;
      for (int k = ks * 128; k < ks * 128 + 128; k += 64) {
          float w[64];
#pragma unroll
          for (int u = 0; u < 64; ++u) w[u] = __builtin_nontemporal_load(wa + (size_t)(k + u) * 6144);
#pragma unroll
          for (int u = 0; u < 64; ++u)
#pragma unroll
              for (int r = 0; r < 9; ++r) acc[r] += sc[r * 1024 + k + u] * w[u];
      } }
#pragma unroll
    for (int r = 0; r < 9; ++r) red[(ks * 64 + (tid & 63)) * 9 + r] = acc[r];
    __syncthreads();
    if (tid < 64) {
#pragma unroll
        for (int r = 0; r < 9; ++r) { float s = p.b_ada[col]; for (int k2 = 0; k2 < 8; ++k2) s += red[(k2 * 64 + tid) * 9 + r]; MOD[r * 6144 + col] = s; }
    }
    __syncthreads();
}
__device__ __forceinline__ void transpose_item(const float* W, int N, int k0, int n0, int nvalid, bf16_t* WT, size_t orow0, int ldt, float* scr, int lane) {
#pragma unroll 8
    for (int i = 0; i < 32; ++i) { const int kk = 2 * i + (lane >> 5), nn = lane & 31; scr[kk * 33 + nn] = nn < nvalid ? W[(size_t)(k0 + kk) * N + n0 + nn] : 0.f; }
    LDS_FENCE();
    const int c = lane & 7;
#pragma unroll
    for (int j = 0; j < 4; ++j) {
        const int n = (lane >> 3) + 8 * j; const float* s = scr + (8 * c) * 33 + n;
        u32x4 o; o.x = pk2(s[0 * 33], s[1 * 33]); o.y = pk2(s[2 * 33], s[3 * 33]); o.z = pk2(s[4 * 33], s[5 * 33]); o.w = pk2(s[6 * 33], s[7 * 33]);
        *(u32x4*)(WT + (orow0 + n) * ldt + k0 + 8 * c) = o;
    }
    LDS_FENCE();
}
__device__ __forceinline__ void ph0(const Params& p, unsigned char* lds, int bid, int nblk) {
    __syncthreads();
    for (int it = bid; it < 96; it += nblk) ph_ada_item(p, lds, it);
    const int tid = ltid(), lane = tid & 63, wave = tid >> 6;
    float* scr = (float*)lds + wave * (64 * 33);
    bf16_t* WINT = (bf16_t*)(p.ws + WS_WINT); bf16_t* WOUTT = (bf16_t*)(p.ws + WS_WOUTT);
    const int gw = bid * NWAVES + wave, ngw = nblk * NWAVES;
    constexpr int I_IN = 16 * 97, I_OUT = 16 * 32;
    for (int it = gw; it < I_IN + I_OUT; it += ngw) {
        if (it < I_IN) { const int kb = it / 97, nb = it % 97; const int n0 = nb * 32; const int nv = (DIN - n0) < 32 ? (DIN - n0) : 32; transpose_item(p.w_in, DIN, kb * 64, n0, nv, WINT, (size_t)n0, 1024, scr, lane); }
        else { const int r = it - I_IN; const int kb = r / 32, nb = r % 32; transpose_item(p.w_out, 1024, kb * 64, nb * 32, 32, WOUTT, (size_t)nb * 32, 1024, scr, lane); }
    }
    { float* ROPE = (float*)(p.ws + WS_ROPE); for (int idx = bid * NTHR + tid; idx < 2048; idx += nblk * NTHR) { const int pos = idx >> 4, i = idx & 15;
        const float inv = exp2f(-(float)i * (13.287712379549449f / 16.f)); float sn, cs_; sincosf((float)pos * inv, &sn, &cs_); ROPE[idx * 2] = cs_; ROPE[idx * 2 + 1] = sn; } }
    { const size_t n16 = (size_t)(DINP - 3104) * 1024 * 2 / 16; u32x4* z = (u32x4*)(WINT + (size_t)3104 * 1024);
      for (size_t i = (size_t)bid * NTHR + tid; i < n16; i += (size_t)nblk * NTHR) z[i] = (u32x4){0u, 0u, 0u, 0u}; }
}

__device__ __forceinline__ void ph1(const Params& p, int bid, int nblk) {
    const int tid = ltid(), lane = tid & 63, wave = tid >> 6;
    const GAS float* MOD = (const GAS float*)(p.ws + WS_MOD); GAS bf16_t* XM = (GAS bf16_t*)(p.ws + WS_XM);
    const GAS float* xs = (const GAS float*)p.x; const GAS float* cs = (const GAS float*)p.ctx;
    const int nw = nblk * NWAVES, gw = bid * NWAVES + wave, per = (MROWS + nw - 1) / nw, m_beg = gw * per, m_end = min(m_beg + per, MROWS);
    { const GAS bf16_t* WT = (const GAS bf16_t*)(p.ws + WS_WOUTT); GAS bf16_t* WG = (GAS bf16_t*)(p.ws + WS_WOUTG);
      for (int i = bid * NTHR + tid; i < NB * 1024 * 128; i += nblk * NTHR) { const int b = i >> 17, n = (i >> 7) & 1023, k8 = (i & 127) * 8;
          const float g = MOD[b * 6144 + 2048 + n]; const u32x4 w = *(const GAS u32x4*)(WT + (size_t)n * 1024 + k8); u32x4 o;
          o.x = pk2(g * bflo(w.x), g * bfhi(w.x)); o.y = pk2(g * bflo(w.y), g * bfhi(w.y)); o.z = pk2(g * bflo(w.z), g * bfhi(w.z)); o.w = pk2(g * bflo(w.w), g * bfhi(w.w));
          *(GAS u32x4*)(WG + ((size_t)b * 1024 + n) * 1024 + k8) = o; } }
    int rcur = -1; f32x4 sa[4], sb[4];
    for (int m0 = m_beg; m0 < m_end; m0 += 4) {
        f32x4 v[4][4]; int rr_[4];
#pragma unroll
        for (int i = 0; i < 4; ++i) { const int m = min(m0 + i, m_end - 1); rr_[i] = m < NLAT ? (m >> 13) : 8;
            const GAS float* src = m < NLAT ? xs + (size_t)m * 1024 : cs + (size_t)(m - NLAT) * 1024;
#pragma unroll
            for (int j = 0; j < 4; ++j) v[i][j] = __builtin_nontemporal_load((const GAS f32x4*)(src + j * 256 + lane * 4)); }
#pragma unroll
        for (int i = 0; i < 4; ++i) { if (m0 + i < m_end) {
            if (rr_[i] != rcur) { rcur = rr_[i];
#pragma unroll
                for (int j = 0; j < 4; ++j) { sb[j] = *(const GAS f32x4*)(MOD + rcur * 6144 + j * 256 + lane * 4); sa[j] = *(const GAS f32x4*)(MOD + rcur * 6144 + 1024 + j * 256 + lane * 4) + 1.f; } }
#pragma unroll
            for (int j = 0; j < 4; ++j) { const f32x4 r = v[i][j] * sa[j] + sb[j]; u32x2 o; o.x = pk2(r.x, r.y); o.y = pk2(r.z, r.w);
                *(GAS u32x2*)(XM + (size_t)(m0 + i) * 1024 + j * 256 + lane * 4) = o; } } }
    }
}


#define LAS __attribute__((address_space(3)))
typedef short bf16x8 __attribute__((ext_vector_type(8)));
typedef int i32x8 __attribute__((ext_vector_type(8)));
constexpr float NA_C2 = 0.125f * 1.4426950408889634f;
namespace pg8 {
constexpr int BM = 256, BK = 64, HALF = 128, HTB = HALF * BK * 2, STAGE_BYTES = 8 * HTB, NXCD = 8, WGM = 8;
constexpr int TAB_OFF = STAGE_BYTES;
__device__ __forceinline__ int lds_byte(int r, int c) { const int st = (r >> 4) * 2 + (c >> 5), rr = r & 15, cc = c & 31, ob = rr * 64 + cc * 2; return st * 1024 + (ob ^ (((ob >> 9) & 1) << 5)); }
__device__ __forceinline__ void stage_rc(int b, int& R, int& C) { const int st = b / 1024, sb = b % 1024, swz = sb ^ (((sb >> 9) & 1) << 5); R = (st >> 1) * 16 + swz / 64; C = (st & 1) * 32 + (swz % 64) / 2; }
__device__ __forceinline__ int perm32(int rho) { const int n = rho >> 4, i = rho & 15; return 8 * (i >> 2) + 4 * n + (i & 3); }
struct Unit { int pm, pn; };
struct StaticOrder {
    int nM, nN, nwg, G, c;
    __device__ void init(int nM_, int nN_, int G_, int c_) { nM = nM_; nN = nN_; nwg = nM * nN; G = G_; c = c_; }
    __device__ bool next(int i, Unit& u) const {
        const long L = (long)i * G + c; if (L >= nwg) return false;
        int wgid = (int)L; { const int q = nwg / NXCD, r = nwg % NXCD, xcd = wgid % NXCD, off = wgid / NXCD; wgid = (xcd < r ? xcd * (q + 1) : r * (q + 1) + (xcd - r) * q) + off; }
        const int nig = WGM * nN, gid = wgid / nig, fm = gid * WGM, gsz = (nM - fm) < WGM ? (nM - fm) : WGM;
        u.pm = fm + ((wgid % nig) % gsz); u.pn = (wgid % nig) / gsz; return true;
    }
};
__device__ __forceinline__ unsigned cvt_pk_bf16(float lo, float hi) { return cvtpk(lo, hi); }
struct GemmDesc { const void* A; const void* Bt; const int* IDX; void* O; const float* x; const float* MOD; size_t bEstride  ; int Kb  , egrp0, nM, nN, epi, ldc, qtiles  ; };

__device__ __forceinline__ void epilogue(const GemmDesc& g, const f32x4 (&acc)[2][2][4][2], const Unit& u, int wr, int wc, int fr, int fq) {
    if (g.epi == 0 || g.epi == 3) {
        const float sc = g.epi == 3 ? (1.f / 64.f) : (u.pn < g.qtiles ? NA_C2 : 1.f);
        GAS bf16_t* O = (GAS bf16_t*)g.O; const int row0 = u.pm * BM + wr * 64 + fr, col0 = u.pn * BM + wc * 32 + 8 * fq;
#pragma unroll
        for (int ai = 0; ai < 2; ++ai)
#pragma unroll
            for (int m = 0; m < 4; ++m) { GAS bf16_t* rowp = O + (size_t)(row0 + ai * HALF + m * 16) * g.ldc + col0;
#pragma unroll
                for (int bj = 0; bj < 2; ++bj) { const f32x4 v0 = acc[ai][bj][m][0] * sc, v1 = acc[ai][bj][m][1] * sc;
                    u32x4 w; w.x = cvt_pk_bf16(v0[0], v0[1]); w.y = cvt_pk_bf16(v0[2], v0[3]); w.z = cvt_pk_bf16(v1[0], v1[1]); w.w = cvt_pk_bf16(v1[2], v1[3]);
                    *(GAS u32x4*)(rowp + bj * HALF) = w; } }
    } else if (g.epi == 1) {
        GAS unsigned char* O = (GAS unsigned char*)g.O; const int row0 = u.pm * BM + wr * 64 + fr, col0 = u.pn * HALF + wc * 32 + 8 * fq;
#pragma unroll
        for (int ai = 0; ai < 2; ++ai)
#pragma unroll
            for (int m = 0; m < 4; ++m) { GAS unsigned char* rowp = O + (size_t)(row0 + ai * HALF + m * 16) * DFF + col0;
                float r[8];
#pragma unroll
                for (int n = 0; n < 2; ++n)
#pragma unroll
                    for (int jp = 0; jp < 2; ++jp) { const f32x2_ gg = {acc[ai][0][m][n][2 * jp], acc[ai][0][m][n][2 * jp + 1]}, uu = {acc[ai][1][m][n][2 * jp], acc[ai][1][m][n][2 * jp + 1]};
                        const f32x2_ a = gg * (-(1.f / 32.f) * 1.4426950408889634f); f32x2_ e = {__builtin_amdgcn_exp2f(a.x), __builtin_amdgcn_exp2f(a.y)};
                        e = e * 1024.f + 1024.f; const f32x2_ rc = {__builtin_amdgcn_rcpf(e.x), __builtin_amdgcn_rcpf(e.y)}; const f32x2_ rr = (gg * uu) * rc;
                        r[n * 4 + 2 * jp] = rr.x; r[n * 4 + 2 * jp + 1] = rr.y; }
                u32x2 w; w.x = pk4_fp8(r[0], r[1], r[2], r[3]); w.y = pk4_fp8(r[4], r[5], r[6], r[7]);
                *(GAS u32x2*)rowp = w; }
    } else {
        GAS bf16_t* Yo = (GAS bf16_t*)g.O; const int row0 = u.pm * BM + wr * 64 + fr, col0 = u.pn * BM + wc * 32 + 8 * fq;
#pragma unroll
        for (int ai = 0; ai < 2; ++ai)
#pragma unroll
            for (int m = 0; m < 4; ++m) { GAS bf16_t* rowp = Yo + (size_t)(row0 + ai * HALF + m * 16) * 1024 + col0;
#pragma unroll
                for (int bj = 0; bj < 2; ++bj) { const f32x4 y0 = acc[ai][bj][m][0], y1 = acc[ai][bj][m][1];
                    u32x4 w; w.x = pk_f16(y0[0], y0[1]); w.y = pk_f16(y0[2], y0[3]); w.z = pk_f16(y1[0], y1[1]); w.w = pk_f16(y1[2], y1[3]);
                    *(GAS u32x4*)(rowp + bj * HALF) = w; } }
    }
}

template <bool MAYGATHER, bool FP8>
__device__ __forceinline__ void gemm_phase(LAS unsigned char* lds, const GemmDesc g, int G, int c) {
    const int tid = ltid(), wid = __builtin_amdgcn_readfirstlane(tid >> 6), lane = tid & 63, wr = wid >> 2, wc = wid & 3, fr = lane & 15, fq = lane >> 4;
    const int Kb = g.Kb, nt = Kb / (BK * 2);
    const bool perm = true, gather = MAYGATHER && g.IDX != nullptr;
    StaticOrder S; S.init(g.nM, g.nN, G, c);
    unsigned voffB[2];
#pragma unroll
    for (int i = 0; i < 2; ++i) { int R, C; stage_rc(tid * 16 + i * 8192, R, C); const int Rb = perm ? ((R & ~31) + perm32(R & 31)) : R; voffB[i] = (unsigned)(Rb * Kb + C * 2); }
    const size_t kstep = (size_t)(BK * 2), hstep = (size_t)HALF * Kb, tstep = 2 * hstep;
    const unsigned ldsw = (unsigned)wid * 1024u;
    const int aoff = lds_byte(wr * 64 + fr, fq * 8), boff = lds_byte(wc * 32 + fr, fq * 8);
    LAS int* tab = (LAS int*)(lds + TAB_OFF);
#define PG8_SA(b, h) (((b) * 2 + (h)) * HTB)
#define PG8_SB(b, h) ((4 + (b) * 2 + (h)) * HTB)
#define PG8_UNI(p_) ({ const unsigned long long _v = (unsigned long long)(p_); (const GAS char*)(((unsigned long long)(unsigned)__builtin_amdgcn_readfirstlane((int)(_v >> 32)) << 32) | (unsigned)__builtin_amdgcn_readfirstlane((int)_v)); })
#define PG8_GLDS(gptr, ldsoff) __builtin_amdgcn_global_load_lds((const GAS unsigned*)(gptr), (LAS unsigned*)(lds + (ldsoff)), 16, 0, 0)
#define PG8_STAGE_B(bufoff, gbase) do { const GAS char* _gb = (const GAS char*)(gbase); _Pragma("unroll") for (int _i = 0; _i < 2; ++_i) { asm volatile("" : "+v"(voffB[_i])); PG8_GLDS(_gb + voffB[_i], (bufoff) + ldsw + _i * 8192); } } while (0)
#define PG8_STAGE_A(bufoff, kt, v0_, v1_) do { const GAS char* _b = (const GAS char*)g.A + (size_t)(kt) * kstep; asm volatile("" : "+v"(v0_), "+v"(v1_)); PG8_GLDS(_b + (v0_), (bufoff) + ldsw); PG8_GLDS(_b + (v1_), (bufoff) + ldsw + 8192); } while (0)
#define PG8_LDA(dst, b, h) do { _Pragma("unroll") for (int m = 0; m < 4; ++m) _Pragma("unroll") for (int k = 0; k < 2; ++k) dst[m][k] = *(const LAS bf16x8*)(lds + PG8_SA(b, h) + aoff + m * 2048 + k * 1024); } while (0)
#define PG8_LDB(dst, b, h) do { _Pragma("unroll") for (int n = 0; n < 2; ++n) _Pragma("unroll") for (int k = 0; k < 2; ++k) dst[n][k] = *(const LAS bf16x8*)(lds + PG8_SB(b, h) + boff + n * 2048 + k * 1024); } while (0)
#define PG8_MMA(ai, bj, At, Bt) do { __builtin_amdgcn_s_setprio(1); \
        if constexpr (FP8) { _Pragma("unroll") for (int m = 0; m < 4; ++m) _Pragma("unroll") for (int n = 0; n < 2; ++n) { \
            const bf16x8 _b0 = Bt[n][0], _b1 = Bt[n][1], _a0 = At[m][0], _a1 = At[m][1]; \
            const i32x8 _bw = __builtin_bit_cast(i32x8, __builtin_shufflevector(_b0, _b1, 0, 1, 2, 3, 4, 5, 6, 7, 8, 9, 10, 11, 12, 13, 14, 15)); \
            const i32x8 _aw = __builtin_bit_cast(i32x8, __builtin_shufflevector(_a0, _a1, 0, 1, 2, 3, 4, 5, 6, 7, 8, 9, 10, 11, 12, 13, 14, 15)); \
            acc[ai][bj][m][n] = __builtin_amdgcn_mfma_scale_f32_16x16x128_f8f6f4(_bw, _aw, acc[ai][bj][m][n], 0, 0, 0, 0x7f7f7f7f, 0, 0x7f7f7f7f); } } \
        else { _Pragma("unroll") for (int m = 0; m < 4; ++m) _Pragma("unroll") for (int n = 0; n < 2; ++n) _Pragma("unroll") for (int k = 0; k < 2; ++k) \
            acc[ai][bj][m][n] = __builtin_amdgcn_mfma_f32_16x16x32_bf16(Bt[n][k], At[m][k], acc[ai][bj][m][n], 0, 0, 0); } \
        __builtin_amdgcn_s_setprio(0); } while (0)
#define PG8_WAIT_V(n) asm volatile("s_waitcnt vmcnt(" #n ")" ::: "memory")
#define PG8_WAIT_L(n) asm volatile("s_waitcnt lgkmcnt(" #n ")" ::: "memory")
#define PG8_BAR __builtin_amdgcn_s_barrier()
#define PG8_SCHED __builtin_amdgcn_sched_barrier(0)
#define PG8_TAB_FILL(u, s) do { if (wid < 4) { const int _e = g.egrp0 + ((u).pm >> 5), _m0 = ((u).pm & 31) * 256, _b = _m0 >> 10, _s0 = _m0 & 1023; \
        __builtin_amdgcn_global_load_lds((const unsigned*)(g.IDX + (_e * 8 + _b) * CAP + _s0 + wid * 64 + lane), (LAS unsigned*)(lds + TAB_OFF + (s) * 1024 + wid * 256), 4, 0, 0); } } while (0)
#define PG8_ROWS(u, s, v) do { int _t = tid; asm volatile("" : "+v"(_t)); _Pragma("unroll") for (int _i = 0; _i < 2; ++_i) { int _R, _C; stage_rc(_t * 16 + _i * 8192, _R, _C); \
        _Pragma("unroll") for (int _h = 0; _h < 2; ++_h) { \
            if (gather) { const int _b = (((u).pm & 31) * 256) >> 10; const int _ix = tab[(s) * 256 + _h * 128 + _R]; v[_h][_i] = (unsigned)((_b * 8192 + _ix) * Kb + _C * 2); } \
            else v[_h][_i] = (unsigned)(((u).pm * 256 + _h * 128 + _R) * Kb + _C * 2); } } } while (0)
    Unit cur, nxt; int ui = 0;
    if (!S.next(0, cur)) return;
    cur.pm = __builtin_amdgcn_readfirstlane(cur.pm); cur.pn = __builtin_amdgcn_readfirstlane(cur.pn);
    f32x4 acc[2][2][4][2];
#define PG8_ACC_INIT(u) do { if (g.epi == 2) { const GAS float* _x = (const GAS float*)g.x + (size_t)((u).pm * BM + wr * 64 + fr) * 1024 + (u).pn * BM + wc * 32 + 8 * fq; \
        _Pragma("unroll") for (int a = 0; a < 2; ++a) _Pragma("unroll") for (int m = 0; m < 4; ++m) _Pragma("unroll") for (int b = 0; b < 2; ++b) _Pragma("unroll") for (int n = 0; n < 2; ++n) \
            acc[a][b][m][n] = *(const GAS f32x4*)(_x + (size_t)(a * HALF + m * 16) * 1024 + b * HALF + n * 4); \
        _Pragma("unroll") for (int a = 0; a < 2; ++a) _Pragma("unroll") for (int m = 0; m < 4; ++m) _Pragma("unroll") for (int b = 0; b < 2; ++b) _Pragma("unroll") for (int n = 0; n < 2; ++n) \
            acc[a][b][m][n] = acc[a][b][m][n] * ALPHA; } \
      else { float z = 0.f; asm volatile("" : "+v"(z));                   \
        _Pragma("unroll") for (int a = 0; a < 2; ++a) _Pragma("unroll") for (int b = 0; b < 2; ++b) _Pragma("unroll") for (int m = 0; m < 4; ++m) _Pragma("unroll") for (int n = 0; n < 2; ++n) \
            acc[a][b][m][n] = (f32x4){z, z, z, z}; } } while (0)
    PG8_ACC_INIT(cur);
    bf16x8 At[4][2], B0[2][2], B1[2][2];
    unsigned vc[2][2];
    const char* cB = (const char*)g.Bt + (size_t)(g.egrp0 + (cur.pm >> 5)) * g.bEstride + (size_t)cur.pn * tstep;
    const char* nB = cB;
    if (gather) { PG8_TAB_FILL(cur, 0); PG8_WAIT_V(0); PG8_BAR; }
    PG8_ROWS(cur, 0, vc);
    PG8_STAGE_B(PG8_SB(0, 0), cB); PG8_STAGE_B(PG8_SB(0, 1), cB + hstep); PG8_STAGE_A(PG8_SA(0, 0), 0, vc[0][0], vc[0][1]); PG8_STAGE_A(PG8_SA(0, 1), 0, vc[1][0], vc[1][1]);
    if (wr == 1) PG8_BAR;
    PG8_WAIT_V(2); PG8_BAR;
    PG8_STAGE_B(PG8_SB(1, 0), cB + kstep); PG8_STAGE_A(PG8_SA(1, 0), 1, vc[0][0], vc[0][1]); PG8_STAGE_B(PG8_SB(1, 1), cB + hstep + kstep);
    PG8_WAIT_V(6); PG8_BAR;
    for (;;) {
        const bool has_next = S.next(ui + 1, nxt);
        nxt.pm = __builtin_amdgcn_readfirstlane(nxt.pm); nxt.pn = __builtin_amdgcn_readfirstlane(nxt.pn);
        if (has_next) nB = (const char*)g.Bt + (size_t)(g.egrp0 + (nxt.pm >> 5)) * g.bEstride + (size_t)nxt.pn * tstep; else nB = cB;
        if (gather && has_next) PG8_TAB_FILL(nxt, (ui + 1) & 1);
        for (int t = 0; t < nt; t += 2) {
            const bool last = (t == nt - 2);
            const int k2 = last ? 0 : t + 2, k3 = k2 + 1;
            const char* b2 = last ? nB : cB + (size_t)(t + 2) * kstep; const char* b3 = b2 + kstep;
            PG8_LDB(B0, 0, 0); PG8_LDB(B1, 0, 1); PG8_SCHED; PG8_LDA(At, 0, 0); PG8_STAGE_A(PG8_SA(1, 1), t + 1, vc[1][0], vc[1][1]);
            if (last && has_next) PG8_ROWS(nxt, (ui + 1) & 1, vc);
            PG8_WAIT_V(8); PG8_WAIT_L(0); PG8_BAR; PG8_MMA(0, 0, At, B0); PG8_MMA(0, 1, At, B1); PG8_BAR; PG8_SCHED;
            PG8_LDA(At, 0, 1); PG8_STAGE_B(PG8_SB(0, 0), b2); PG8_STAGE_B(PG8_SB(0, 1), b2 + hstep); PG8_STAGE_A(PG8_SA(0, 0), k2, vc[0][0], vc[0][1]);
            PG8_WAIT_V(8); PG8_WAIT_L(0); PG8_BAR; PG8_MMA(1, 0, At, B0); PG8_MMA(1, 1, At, B1); PG8_BAR; PG8_SCHED;
            PG8_LDB(B0, 1, 0); PG8_LDB(B1, 1, 1); PG8_SCHED; PG8_LDA(At, 1, 0); PG8_STAGE_A(PG8_SA(0, 1), k2, vc[1][0], vc[1][1]);
            PG8_WAIT_V(8); PG8_WAIT_L(0); PG8_BAR; PG8_MMA(0, 0, At, B0); PG8_MMA(0, 1, At, B1); PG8_BAR; PG8_SCHED;
            PG8_LDA(At, 1, 1); PG8_STAGE_B(PG8_SB(1, 0), b3); PG8_STAGE_B(PG8_SB(1, 1), b3 + hstep); PG8_STAGE_A(PG8_SA(1, 0), k3, vc[0][0], vc[0][1]);
            PG8_WAIT_V(8); PG8_WAIT_L(0); PG8_BAR; PG8_MMA(1, 0, At, B0); PG8_MMA(1, 1, At, B1); PG8_BAR; PG8_SCHED;
        }
        if (wr == 0) PG8_BAR;
        epilogue(g, acc, cur, wr, wc, fr, fq);
        if (!has_next) break;
        cur = nxt; cB = nB; ++ui;
        PG8_ACC_INIT(cur);
        if (wr == 1) PG8_BAR;
    }
    PG8_WAIT_V(0);
    PG8_BAR;
#undef PG8_SA
#undef PG8_SB
#undef PG8_GLDS
#undef PG8_STAGE_A
#undef PG8_STAGE_B
#undef PG8_LDA
#undef PG8_LDB
#undef PG8_MMA
#undef PG8_WAIT_V
#undef PG8_WAIT_L
#undef PG8_BAR
#undef PG8_ACC_INIT
#undef PG8_SCHED
#undef PG8_TAB_FILL
#undef PG8_ROWS
}
}


constexpr int NA_SLOTS = 9, NA_SLOT_EL = 64 * 72;
__device__ __forceinline__ int vtl_off(int d, int key) { return d * 72 + key; }
__device__ __forceinline__ int vtc_off(int d, int key) { return d * 264 + key; }
__device__ __forceinline__ void na_item(const Params& p, unsigned char* lds, int item) {
    const GAS bf16_t* U = (const GAS bf16_t*)(p.ws + WS_U); GAS bf16_t* MIX = (GAS bf16_t*)(p.ws + WS_MIX);
    const int tid = ltid(), lane = tid & 63, wave = __builtin_amdgcn_readfirstlane(tid >> 6), fr = lane & 15, fq = lane >> 4;
    const int seg = item & 3, bh = item >> 2, h = bh & 7, b = bh >> 3;
    bf16_t* VTL = (bf16_t*)lds;
    bf16_t* VTC = VTL + NA_SLOTS * NA_SLOT_EL;
    bf16_t* KC = VTC + 64 * 264;
    float* BIAS = (float*)(KC + 256 * 72);
    const size_t lat0 = (size_t)b * 8192, ctx0 = (size_t)NLAT + b * 256;
    const GAS bf16_t* Uv = U + C_VA + h * 64 + wave * 8;
#pragma unroll
    for (int i = 0; i < 2; ++i) { const int kp = lane + 64 * i;
        const u32x4 w0 = *(const GAS u32x4*)(Uv + (ctx0 + 2 * kp) * DINP), w1 = *(const GAS u32x4*)(Uv + (ctx0 + 2 * kp + 1) * DINP);
        const unsigned ws_[8] = {(w0.x & 0xffffu) | (w1.x << 16), (w0.x >> 16) | (w1.x & 0xffff0000u), (w0.y & 0xffffu) | (w1.y << 16), (w0.y >> 16) | (w1.y & 0xffff0000u),
                                 (w0.z & 0xffffu) | (w1.z << 16), (w0.z >> 16) | (w1.z & 0xffff0000u), (w0.w & 0xffffu) | (w1.w << 16), (w0.w >> 16) | (w1.w & 0xffff0000u)};
#pragma unroll
        for (int e = 0; e < 8; ++e) *(unsigned*)(VTC + vtc_off(wave * 8 + e, 2 * kp)) = ws_[e]; }
    for (int idx = tid; idx < 256 * 8; idx += NTHR) { const int key = idx >> 3, ck = idx & 7;
        *(u32x4*)(KC + key * 72 + ck * 8) = *(const GAS u32x4*)(U + (ctx0 + key) * DINP + C_KA + h * 64 + ck * 8); }
    if (tid < 512) BIAS[tid] = tid < 465 ? p.na_bias[h * 465 + tid] * 1.4426950408889634f : 0.f;
    const int cg = wave & 3, rr = wave >> 2, c0 = 16 * cg, kb = cg == 0 ? 0 : (cg == 1 ? 8 : (cg == 2 ? 24 : 32));
    const int c = c0 + fr, cs = min(max(c - 8, 0), 48);
    const int r00 = 32 * seg;
#define NA_VFILL(kra_, w0_, w1_) do { const unsigned ws_[8] = {(w0_.x & 0xffffu) | (w1_.x << 16), (w0_.x >> 16) | (w1_.x & 0xffff0000u), (w0_.y & 0xffffu) | (w1_.y << 16), (w0_.y >> 16) | (w1_.y & 0xffff0000u), \
            (w0_.z & 0xffffu) | (w1_.z << 16), (w0_.z >> 16) | (w1_.z & 0xffff0000u), (w0_.w & 0xffffu) | (w1_.w << 16), (w0_.w >> 16) | (w1_.w & 0xffff0000u)}; \
        bf16_t* sl_ = VTL + ((kra_) % NA_SLOTS) * NA_SLOT_EL; _Pragma("unroll") for (int e_ = 0; e_ < 8; ++e_) *(unsigned*)(sl_ + vtl_off(wave * 8 + e_, 2 * (lane & 31))) = ws_[e_]; } while (0)
    { const int lo = min(max(r00 - 4, 0), 120), hi = min(max(r00 + 1 - 4, 0), 120) + 7;
      for (int kra = lo + (lane >> 5); kra <= hi; kra += 2) { const size_t k0 = lat0 + kra * 64 + 2 * (lane & 31);
          const u32x4 w0 = *(const GAS u32x4*)(Uv + k0 * DINP), w1 = *(const GAS u32x4*)(Uv + (k0 + 1) * DINP);
          NA_VFILL(kra, w0, w1); } }
#define NA_LOADK(kf_, ch, rw_) do { const int rs_ = min(max((rw_) - 4, 0), 120); unsigned koff_ = koff; asm volatile("" : "+v"(koff_));     \
        _Pragma("unroll") for (int t_ = 0; t_ < 4; ++t_) { \
        const size_t krow_ = lat0 + (rs_ + 2 * (ch) + (t_ >> 1)) * 64 + kb + 16 * (t_ & 1); \
        const GAS char* bp_ = Ub + krow_ * (DINP * 2); \
        kf_[2 * t_] = *(const GAS bf16x8_t*)(bp_ + koff_); kf_[2 * t_ + 1] = *(const GAS bf16x8_t*)(bp_ + koff_ + 64); } } while (0)
    const GAS char* Ub = (const GAS char*)U;
    const unsigned koff = (unsigned)((fr * DINP + C_KA + h * 64 + 8 * fq) * 2);
    bf16x8_t kfa[8], kfb[8], qf[2];
    { const int rw0 = r00 + rr; const size_t qrow = lat0 + rw0 * 64 + c0 + fr;
      qf[0] = *(const GAS bf16x8_t*)(U + qrow * DINP + C_QA + h * 64 + 8 * fq); qf[1] = *(const GAS bf16x8_t*)(U + qrow * DINP + C_QA + h * 64 + 32 + 8 * fq);
      NA_LOADK(kfa, 0, rw0); NA_LOADK(kfb, 1, rw0); }
    __syncthreads();
#pragma unroll 1
    for (int step = 0; step < 16; ++step) {
        const int r = r00 + 2 * step, rw = r + rr, rsw = min(max(rw - 4, 0), 120);
        const int nhi_cur = min(max(r + 1 - 4, 0), 120) + 7, nhi_nxt = min(max(r + 3 - 4, 0), 120) + 7;
        const int vkra = nhi_cur + 1 + (lane >> 5); const bool vld = step < 15 && vkra <= nhi_nxt;
        u32x4 vw0 = (u32x4){0u, 0u, 0u, 0u}, vw1 = (u32x4){0u, 0u, 0u, 0u};
        float m_run = -INFINITY, l_run = 0.f;
        f32x4 o[4];
#pragma unroll
        for (int db = 0; db < 4; ++db) o[db] = (f32x4){0.f, 0.f, 0.f, 0.f};
#pragma unroll
        for (int ch = 0; ch < 8; ++ch) {
            f32x4 sc[4];
            if (ch < 4) {
#pragma unroll
                for (int t = 0; t < 4; ++t) { f32x4 a = (f32x4){0.f, 0.f, 0.f, 0.f};
                    if (ch & 1) { a = __builtin_amdgcn_mfma_f32_16x16x32_bf16(kfb[2 * t], qf[0], a, 0, 0, 0); a = __builtin_amdgcn_mfma_f32_16x16x32_bf16(kfb[2 * t + 1], qf[1], a, 0, 0, 0); }
                    else { a = __builtin_amdgcn_mfma_f32_16x16x32_bf16(kfa[2 * t], qf[0], a, 0, 0, 0); a = __builtin_amdgcn_mfma_f32_16x16x32_bf16(kfa[2 * t + 1], qf[1], a, 0, 0, 0); }
                    sc[t] = a; }
                __builtin_amdgcn_sched_barrier(0);
                if (ch < 2) { if (ch & 1) { NA_LOADK(kfb, ch + 2, rw); } else { NA_LOADK(kfa, ch + 2, rw); } }
                else if (step < 15) { if (ch & 1) { NA_LOADK(kfb, 1, rw + 2); } else { NA_LOADK(kfa, 0, rw + 2); } }
            } else {
#pragma unroll
                for (int t = 0; t < 4; ++t) { const bf16_t* kp = KC + (64 * (ch - 4) + 16 * t + fr) * 72 + 8 * fq;
                    const bf16x8_t k0 = *(const bf16x8_t*)kp, k1 = *(const bf16x8_t*)(kp + 32);
                    f32x4 a = (f32x4){0.f, 0.f, 0.f, 0.f};
                    a = __builtin_amdgcn_mfma_f32_16x16x32_bf16(k0, qf[0], a, 0, 0, 0); a = __builtin_amdgcn_mfma_f32_16x16x32_bf16(k1, qf[1], a, 0, 0, 0); sc[t] = a; }
                __builtin_amdgcn_sched_barrier(0);
                if (ch == 7 && step < 15) { const size_t qrow = lat0 + (rw + 2) * 64 + c0 + fr;
                    qf[0] = *(const GAS bf16x8_t*)(U + qrow * DINP + C_QA + h * 64 + 8 * fq); qf[1] = *(const GAS bf16x8_t*)(U + qrow * DINP + C_QA + h * 64 + 32 + 8 * fq); }
                if (ch == 4 && vld) { const size_t k0 = lat0 + vkra * 64 + 2 * (lane & 31); vw0 = *(const GAS u32x4*)(Uv + k0 * DINP); vw1 = *(const GAS u32x4*)(Uv + (k0 + 1) * DINP); }
            }
            u32x2 vfr[2][4][2];
#pragma unroll
            for (int t = 0; t < 2; ++t)
#pragma unroll
                for (int db = 0; db < 4; ++db) {
                    if (ch < 4) { const bf16_t* sl = VTL + ((rsw + 2 * ch + t) % NA_SLOTS) * NA_SLOT_EL;
                        vfr[t][db][0] = *(const u32x2*)(sl + vtl_off(db * 16 + fr, kb + 4 * fq)); vfr[t][db][1] = *(const u32x2*)(sl + vtl_off(db * 16 + fr, kb + 16 + 4 * fq)); }
                    else { vfr[t][db][0] = *(const u32x2*)(VTC + vtc_off(db * 16 + fr, 64 * (ch - 4) + 32 * t + 4 * fq)); vfr[t][db][1] = *(const u32x2*)(VTC + vtc_off(db * 16 + fr, 64 * (ch - 4) + 32 * t + 16 + 4 * fq)); }
                }
            float bv[4][4];
            if (ch < 4) {
#pragma unroll
                for (int t = 0; t < 4; ++t) { const int kr = 2 * ch + (t >> 1), cb = t & 1;
                    const float* brow = BIAS + (rsw + kr - rw + 7) * 31;
#pragma unroll
                    for (int j = 0; j < 4; ++j) bv[t][j] = brow[kb + 16 * cb + 4 * fq + j - c + 15]; }
                asm volatile("" : "+v"(bv[0][0]), "+v"(bv[0][1]), "+v"(bv[0][2]), "+v"(bv[0][3]), "+v"(bv[1][0]), "+v"(bv[1][1]), "+v"(bv[1][2]), "+v"(bv[1][3]),
                                  "+v"(bv[2][0]), "+v"(bv[2][1]), "+v"(bv[2][2]), "+v"(bv[2][3]), "+v"(bv[3][0]), "+v"(bv[3][1]), "+v"(bv[3][2]), "+v"(bv[3][3]));
            }
            __builtin_amdgcn_sched_barrier(0);
            if (ch < 4) {
#pragma unroll
                for (int t = 0; t < 4; ++t) { const int cb = t & 1;
#pragma unroll
                    for (int j = 0; j < 4; ++j) { const int col = kb + 16 * cb + 4 * fq + j; const bool valid = (col >= cs) && (col < cs + 16);
                        sc[t][j] = valid ? sc[t][j] + bv[t][j] : -INFINITY; } }
            }
            float cm = -INFINITY;
#pragma unroll
            for (int t = 0; t < 4; ++t) cm = fmaxf(cm, fmaxf(fmaxf(sc[t][0], sc[t][1]), fmaxf(sc[t][2], sc[t][3])));
            if (__any(cm > m_run + 11.5f)) {
                cm = fmaxf(cm, __shfl_xor(cm, 16)); cm = fmaxf(cm, __shfl_xor(cm, 32));
                const float m_new = fmaxf(m_run, cm), alpha = __builtin_amdgcn_exp2f(m_run - m_new);
                m_run = m_new; l_run *= alpha;
#pragma unroll
                for (int j = 0; j < 4; ++j) { const float aj = __shfl(alpha, 4 * fq + j);
#pragma unroll
                    for (int db = 0; db < 4; ++db) o[db][j] *= aj; }
            }
            const float m_new = m_run;
            float psum = 0.f;
            u32x4 pw[2];
#pragma unroll
            for (int t = 0; t < 2; ++t) {
                f32x4 e0, e1;
#pragma unroll
                for (int j = 0; j < 4; ++j) { e0[j] = __builtin_amdgcn_exp2f(sc[2 * t][j] - m_new); e1[j] = __builtin_amdgcn_exp2f(sc[2 * t + 1][j] - m_new); }
                psum += (e0[0] + e0[1]) + (e0[2] + e0[3]) + (e1[0] + e1[1]) + (e1[2] + e1[3]);
                pw[t].x = cvtpk(e0[0], e0[1]); pw[t].y = cvtpk(e0[2], e0[3]); pw[t].z = cvtpk(e1[0], e1[1]); pw[t].w = cvtpk(e1[2], e1[3]);
            }
            l_run += psum;
#pragma unroll
            for (int t = 0; t < 2; ++t)
#pragma unroll
                for (int db = 0; db < 4; ++db) { const u32x4 vw = (u32x4){vfr[t][db][0].x, vfr[t][db][0].y, vfr[t][db][1].x, vfr[t][db][1].y};
                    o[db] = __builtin_amdgcn_mfma_f32_16x16x32_bf16(__builtin_bit_cast(bf16x8_t, pw[t]), __builtin_bit_cast(bf16x8_t, vw), o[db], 0, 0, 0); }
            __builtin_amdgcn_sched_barrier(0);
        }
        float lsum = l_run; lsum += __shfl_xor(lsum, 16); lsum += __shfl_xor(lsum, 32);
        const float rinv = 1.f / lsum;
#pragma unroll
        for (int j = 0; j < 4; ++j) { const float rj = __shfl(rinv, 4 * fq + j);
            GAS bf16_t* orow = MIX + (lat0 + rw * 64 + c0 + 4 * fq + j) * 1024 + h * 64 + fr;
#pragma unroll
            for (int db = 0; db < 4; ++db) orow[db * 16] = (bf16_t)f2bf(o[db][j] * rj); }
        __syncthreads();
        if (vld) NA_VFILL(vkra, vw0, vw1);
        __syncthreads();
    }
#undef NA_LOADK
#undef NA_VFILL
}

__device__ __forceinline__ float rope_elem(const float* xr, int d, int t, const GAS float* ROPE) {
    const int half = d >> 5, dd = d & 31, i = dd & 15;
    const int pos = half == 0 ? (t >> 6) : (t & 63);
    const float cs_ = ROPE[(pos * 16 + i) * 2], sn = ROPE[(pos * 16 + i) * 2 + 1];
    const float x1 = xr[half * 32 + i], x2 = xr[half * 32 + 16 + i];
    return dd < 16 ? x1 * cs_ - x2 * sn : x1 * sn + x2 * cs_;
}

struct StPre { u32x4 raw[5]; u32x4 v[4]; };
__device__ __forceinline__ void ml_stats_prefetch(const Params& p, int item, int tid, StPre& r) {
    const GAS bf16_t* U = (const GAS bf16_t*)(p.ws + WS_U);
    const int ch = item % NCH, bh = item / NCH, h = bh & 3, b = bh >> 2;
    const bool is_ctx = ch >= 64; const int Tseq = is_ctx ? 256 : 8192, t0 = (is_ctx ? ch - 64 : ch) * 128;
    const size_t rowbase = is_ctx ? (size_t)NLAT + b * 256 : (size_t)b * 8192;
#pragma unroll
    for (int i = 0; i < 5; ++i) { const int idx = tid + i * NTHR, tt = idx >> 4, ck = idx & 15, t = t0 - 2 + tt;
        u32x4 w = (u32x4){0u, 0u, 0u, 0u};
        if (idx < 132 * 16 && t >= 0 && t < Tseq) w = *(const GAS u32x4*)(U + (rowbase + t) * DINP + (ck < 8 ? C_QM : C_KM) + h * 64 + (ck & 7) * 8);
        r.raw[i] = w; }
#pragma unroll
    for (int i = 0; i < 4; ++i) { const int idx = tid + i * NTHR, l = idx & 127, ck = idx >> 7; r.v[i] = *(const GAS u32x4*)(U + (rowbase + t0 + l) * DINP + C_VM + h * 128 + ck * 8); }
}
__device__ __forceinline__ void ml_stats_item(const Params& p, unsigned char* lds, int item, StPre& pre, int next_item) {
    const GAS bf16_t* U = (const GAS bf16_t*)(p.ws + WS_U); GAS bf16_t* QP = (GAS bf16_t*)(p.ws + WS_QP); GAS bf16_t* KP = (GAS bf16_t*)(p.ws + WS_KP);
    GAS bf16_t* CLOC = (GAS bf16_t*)(p.ws + WS_CLOC); GAS float* NLOC = (GAS float*)(p.ws + WS_NLOC); GAS float* MLOC = (GAS float*)(p.ws + WS_MLOC); GAS float* BLAST = (GAS float*)(p.ws + WS_BLAST);
    const GAS float* ROPE = (const GAS float*)(p.ws + WS_ROPE); const GAS float* convw = (const GAS float*)p.conv_qk;
    const int tid = ltid(), lane = tid & 63, wave = __builtin_amdgcn_readfirstlane(tid >> 6), fr = lane & 15, fq = lane >> 4;
    const int ch = item % NCH, bh = item / NCH, h = bh & 3, b = bh >> 2;
    const bool is_ctx = ch >= 64; const int Tseq = is_ctx ? 256 : 8192, cl = is_ctx ? ch - 64 : ch, t0 = cl * 128;
    const size_t rowbase = is_ctx ? (size_t)NLAT + b * 256 : (size_t)b * 8192;
    bf16_t* KT = (bf16_t*)lds;
    bf16_t* RAW = KT + 64 * 136;
    float* TMP = (float*)(RAW + 132 * 128);
    bf16_t* WV = RAW;
    float* gl = TMP + 128 * 129;
    float* wgt = gl + 512;
    const float* RT = wgt + 256;
#pragma unroll
    for (int i = 0; i < 5; ++i) { const int idx = tid + i * NTHR; if (idx < 132 * 16) *(u32x4*)(RAW + (idx >> 4) * 128 + (idx & 15) * 8) = pre.raw[i]; }
    { const int g = tid >> 7, l = tid & 127; gl[tid] = bf2f(U[(rowbase + t0 + l) * DINP + C_GT + g * 4 + h]) + p.b_gate[g * 4 + h]; }
    __syncthreads();
    for (int rr19_ = 0; rr19_ < REPN(19); ++rr19_) {
    { const int chn = tid & 127, wofs = (chn < 64 ? 0 : 256) + h * 64 + (chn & 63);
      float cw[5];
#pragma unroll
      for (int j = 0; j < 5; ++j) cw[j] = convw[j * 512 + wofs];
      const int l0 = (tid >> 7) * 32;
      float w0 = bf2f(RAW[(l0 + 0) * 128 + chn]), w1 = bf2f(RAW[(l0 + 1) * 128 + chn]), w2 = bf2f(RAW[(l0 + 2) * 128 + chn]), w3 = bf2f(RAW[(l0 + 3) * 128 + chn]);
#pragma unroll 8
      for (int i = 0; i < 32; ++i) { const float w4 = bf2f(RAW[(l0 + i + 4) * 128 + chn]);
          const float a = cw[0] * w0 + cw[1] * w1 + cw[2] * w2 + cw[3] * w3 + cw[4] * w4;
          TMP[(l0 + i) * 129 + chn] = siluf(a); w0 = w1; w1 = w2; w2 = w3; w3 = w4; } }
    if (wave < 2) {
        const int dir = wave, l0 = dir == 0 ? 2 * lane : 127 - 2 * lane, l1 = dir == 0 ? 2 * lane + 1 : 126 - 2 * lane;
        const float* ig = gl + dir * 256; const float* fg = ig + 128;
        const float lf0 = logsigf(fg[l0]), lf1 = logsigf(fg[l1]);
        const float incl = wscan_add(lf0 + lf1, lane), bc0 = incl - lf1, bc1 = incl, blast = __shfl(incl, 63);
        const float a0 = blast - bc0 + ig[l0], a1 = blast - bc1 + ig[l1];
        const float m = wave_max(fmaxf(a0, a1));
        wgt[dir * 128 + l0] = __expf(a0 - m); wgt[dir * 128 + l1] = __expf(a1 - m);
        if (lane == 0) { BLAST[(dir * 32 + bh) * NCH + ch] = blast; MLOC[(dir * 32 + bh) * NCH + ch] = m; }
    }
    }
    __syncthreads();
    for (int rr20_ = 0; rr20_ < REPN(20); ++rr20_) {
    for (int idx = tid; idx < 128 * 16; idx += NTHR) { const int l = idx & 127, ck = idx >> 7, isk = ck >> 3, d0 = (ck & 7) * 8, t = t0 + l;
        if (is_ctx && !isk) continue;
        const float* xr = TMP + l * 129 + isk * 64;
        float o[8];
        if (is_ctx) {
#pragma unroll
            for (int e = 0; e < 8; ++e) o[e] = xr[d0 + e];
        } else {
            const int half = d0 >> 5, dd0 = d0 & 31, i0 = dd0 & 15, pos = half == 0 ? (t >> 6) : (t & 63);
            const f32x4* rp = (const f32x4*)(RT + (pos * 16 + i0) * 2);
            const f32x4 r0 = rp[0], r1 = rp[1], r2 = rp[2], r3 = rp[3];
            const float cs_[8] = {r0.x, r0.z, r1.x, r1.z, r2.x, r2.z, r3.x, r3.z}, sn[8] = {r0.y, r0.w, r1.y, r1.w, r2.y, r2.w, r3.y, r3.w};
#pragma unroll
            for (int e = 0; e < 8; ++e) { const float x1 = xr[half * 32 + i0 + e], x2 = xr[half * 32 + 16 + i0 + e]; o[e] = dd0 < 16 ? x1 * cs_[e] - x2 * sn[e] : x1 * sn[e] + x2 * cs_[e]; }
        }
        if (!isk) { u32x4 w; w.x = pk2(o[0] * 0.125f, o[1] * 0.125f); w.y = pk2(o[2] * 0.125f, o[3] * 0.125f); w.z = pk2(o[4] * 0.125f, o[5] * 0.125f); w.w = pk2(o[6] * 0.125f, o[7] * 0.125f);
            *(GAS u32x4*)(QP + ((size_t)b * 8192 + t) * 256 + h * 64 + d0) = w; }
        else { u32x4 w; w.x = pk2(o[0], o[1]); w.y = pk2(o[2], o[3]); w.z = pk2(o[4], o[5]); w.w = pk2(o[6], o[7]);
            *(GAS u32x4*)(KP + (rowbase + t) * 256 + h * 64 + d0) = w;
            KT[(d0 + 0) * 136 + l] = (bf16_t)(w.x & 0xffffu); KT[(d0 + 1) * 136 + l] = (bf16_t)(w.x >> 16); KT[(d0 + 2) * 136 + l] = (bf16_t)(w.y & 0xffffu); KT[(d0 + 3) * 136 + l] = (bf16_t)(w.y >> 16);
            KT[(d0 + 4) * 136 + l] = (bf16_t)(w.z & 0xffffu); KT[(d0 + 5) * 136 + l] = (bf16_t)(w.z >> 16); KT[(d0 + 6) * 136 + l] = (bf16_t)(w.w & 0xffffu); KT[(d0 + 7) * 136 + l] = (bf16_t)(w.w >> 16); }
    }
    }
    __syncthreads();
    for (int rr21_ = 0; rr21_ < REPN(21); ++rr21_) {
#pragma unroll
    for (int i = 0; i < 4; ++i) { const int idx = tid + i * NTHR, l = idx & 127, ck = idx >> 7;
        const u32x4 w = pre.v[i];
        const float wf = wgt[l], wb = wgt[128 + l];
        const float vv[8] = {bflo(w.x), bfhi(w.x), bflo(w.y), bfhi(w.y), bflo(w.z), bfhi(w.z), bflo(w.w), bfhi(w.w)};
#pragma unroll
        for (int e = 0; e < 8; ++e) { WV[(ck * 8 + e) * 136 + l] = (bf16_t)f2bf(wf * vv[e]); WV[(128 + ck * 8 + e) * 136 + l] = (bf16_t)f2bf(wb * vv[e]); } }
    }
    __syncthreads();
    if (next_item >= 0) ml_stats_prefetch(p, next_item, tid, pre);
    for (int rr22_ = 0; rr22_ < REPN(22); ++rr22_) {
    { const int dir = wave >> 2, vb0 = (wave & 3) * 2;
      GAS bf16_t* cdst = CLOC + ((size_t)(dir * 32 + bh) * NCH + ch) * 8192;
#pragma unroll
      for (int vbi = 0; vbi < 2; ++vbi) {
          const int vb = vb0 + vbi;
          bf16x8_t af[4];
#pragma unroll
          for (int ls = 0; ls < 4; ++ls) af[ls] = *(const bf16x8_t*)(WV + (dir * 128 + vb * 16 + fr) * 136 + ls * 32 + 8 * fq);
#pragma unroll
          for (int kb = 0; kb < 4; ++kb) {
              f32x4 acc = (f32x4){0.f, 0.f, 0.f, 0.f};
#pragma unroll
              for (int ls = 0; ls < 4; ++ls) { const bf16x8_t bfr = *(const bf16x8_t*)(KT + (kb * 16 + fr) * 136 + ls * 32 + 8 * fq); acc = __builtin_amdgcn_mfma_f32_16x16x32_bf16(af[ls], bfr, acc, 0, 0, 0); }
#pragma unroll
              for (int j = 0; j < 4; ++j) cdst[(vb * 16 + 4 * fq + j) * 64 + kb * 16 + fr] = (bf16_t)f2bf(acc[j]);
          }
      }
      if (tid < 128) { const int d2 = tid >> 6, k = tid & 63; float sn = 0.f;
          for (int l = 0; l < 128; ++l) sn += wgt[d2 * 128 + l] * bf2f(KT[k * 136 + l]);
          NLOC[((size_t)(d2 * 32 + bh) * NCH + ch) * 64 + k] = sn; }
    }
    }
    __syncthreads();
}
__device__ __forceinline__ void ph3(const Params& p, unsigned char* lds, int bid, int nblk) {
    for (int rep_ = 0; rep_ < REPN(14); ++rep_) for (int it = bid; it < 256; it += nblk) na_item(p, lds, (nblk == 256) ? ((it & 7) * 32 + (it >> 3)) : it);
    {
      float* RTw = (float*)((bf16_t*)lds + 64 * 136 + 132 * 128) + 128 * 129 + 512 + 256; const GAS float* ROPEg = (const GAS float*)(p.ws + WS_ROPE);
      for (int i = threadIdx.x; i < 4096; i += NTHR) RTw[i] = ROPEg[i];
      __syncthreads(); }
    for (int rep_ = 0; rep_ < REPN(15); ++rep_) { StPre pre; if (bid < 32 * NCH) ml_stats_prefetch(p, bid, (int)threadIdx.x, pre);
        for (int it = bid; it < 32 * NCH; it += nblk) ml_stats_item(p, lds, it, pre, it + nblk < 32 * NCH ? it + nblk : -1); }
}

__device__ __forceinline__ void ph4(const Params& p, int bid, int nblk) {
    GAS bf16_t* CLOC = (GAS bf16_t*)(p.ws + WS_CLOC); GAS float* NLOC = (GAS float*)(p.ws + WS_NLOC); const GAS float* MLOC = (const GAS float*)(p.ws + WS_MLOC);
    const GAS float* BLAST = (const GAS float*)(p.ws + WS_BLAST); GAS float* MIN = (GAS float*)(p.ws + WS_MIN);
    const int tid = ltid();
    for (int it = bid; it < 64 * 5; it += nblk) {
        const bool small = it >= 256; const int q = small ? it - 256 : it >> 2, seg = it & 3, dir = q >> 5;
        if (small && tid > 64) continue;
        float c0 = 0.f, c1 = 0.f, c2 = 0.f, c3 = 0.f, m_prev = 0.f;
        GAS bf16_t* cbase = CLOC + (size_t)q * NCH * 8192 + seg * 2048 + tid * 4;
        GAS float* nbase = NLOC + (size_t)q * NCH * 64 + (tid & 63);
        for (int s0 = 0; s0 < NCH; s0 += 22) {
            u32x2 cw[22]; float nv[22], bl[22], ml[22]; int ci[22];
#pragma unroll
            for (int u = 0; u < 22; ++u) { const int step = s0 + u; ci[u] = dir == 0 ? (step < 2 ? 64 + step : step - 2) : 65 - step;
                bl[u] = BLAST[q * NCH + ci[u]]; ml[u] = MLOC[q * NCH + ci[u]];
                if (!small) cw[u] = *(const GAS u32x2*)(cbase + (size_t)ci[u] * 8192); else nv[u] = tid < 64 ? nbase[ci[u] * 64] : 0.f; }
#pragma unroll
            for (int u = 0; u < 22; ++u) {
                const float m_new = fmaxf(bl[u] + m_prev, ml[u]), sp = __expf(bl[u] + m_prev - m_new), sl = __expf(ml[u] - m_new);
                if (!small) { u32x2 o; o.x = pk2(c0, c1); o.y = pk2(c2, c3); *(GAS u32x2*)(cbase + (size_t)ci[u] * 8192) = o;
                    c0 = sp * c0 + sl * bflo(cw[u].x); c1 = sp * c1 + sl * bfhi(cw[u].x); c2 = sp * c2 + sl * bflo(cw[u].y); c3 = sp * c3 + sl * bfhi(cw[u].y); }
                else if (tid < 64) { nbase[ci[u] * 64] = c0; c0 = sp * c0 + sl * nv[u]; }
                else MIN[q * NCH + ci[u]] = m_prev;
                m_prev = m_new;
            }
        }
    }
}

struct MlPre { u32x4 q[2], k[2], v[4], c[2][2]; };
__device__ __forceinline__ void ml_out_prefetch(const Params& p, int item, int tid, MlPre& r) {
    const GAS bf16_t* U = (const GAS bf16_t*)(p.ws + WS_U); const GAS bf16_t* QP = (const GAS bf16_t*)(p.ws + WS_QP); const GAS bf16_t* KP = (const GAS bf16_t*)(p.ws + WS_KP);
    const GAS bf16_t* CLOC = (const GAS bf16_t*)(p.ws + WS_CLOC);
    const int J = item & 63, bh = item >> 6, h = bh & 3, b = bh >> 2; const size_t row0 = (size_t)b * 8192 + J * 128;
#pragma unroll
    for (int i = 0; i < 2; ++i) { const int idx = tid + i * NTHR, rr = idx >> 3, ck = idx & 7;
        r.q[i] = *(const GAS u32x4*)(QP + (row0 + rr) * 256 + h * 64 + ck * 8); r.k[i] = *(const GAS u32x4*)(KP + (row0 + rr) * 256 + h * 64 + ck * 8); }
#pragma unroll
    for (int i = 0; i < 4; ++i) { const int idx = tid + i * NTHR, l = idx & 127, ck = idx >> 7; r.v[i] = *(const GAS u32x4*)(U + (row0 + l) * DINP + C_VM + h * 128 + ck * 8); }
#pragma unroll
    for (int dir = 0; dir < 2; ++dir) { const GAS bf16_t* csrc = CLOC + ((size_t)(dir * 32 + bh) * NCH + J) * 8192;
#pragma unroll
        for (int i = 0; i < 2; ++i) { const int idx = tid + i * NTHR; r.c[dir][i] = *(const GAS u32x4*)(csrc + idx * 8); } }
}
__device__ __forceinline__ void ml_out_item(const Params& p, unsigned char* lds, int item, MlPre& pre, int next_item) {
    const GAS bf16_t* U = (const GAS bf16_t*)(p.ws + WS_U); const GAS bf16_t* QP = (const GAS bf16_t*)(p.ws + WS_QP); const GAS bf16_t* KP = (const GAS bf16_t*)(p.ws + WS_KP);
    const GAS float* NLOC = (const GAS float*)(p.ws + WS_NLOC); const GAS float* MIN = (const GAS float*)(p.ws + WS_MIN);
    GAS bf16_t* MIX = (GAS bf16_t*)(p.ws + WS_MIX);
    const int tid = ltid(), lane = tid & 63, wave = __builtin_amdgcn_readfirstlane(tid >> 6), fr = lane & 15, fq = lane >> 4;
    const int J = item & 63, bh = item >> 6, h = bh & 3, b = bh >> 2, t0 = J * 128;
    const size_t row0 = (size_t)b * 8192 + t0;
    bf16_t* Qs = (bf16_t*)lds;
    bf16_t* Ks = Qs + 128 * 72;
    bf16_t* VT = Ks + 128 * 72;
    bf16_t* Cs = VT + 128 * 136;
    float* asv = (float*)(Cs + 2 * 128 * 72);
    float* btv = asv + 256;
    float* itv = btv + 256;
    float* emt = itv + 256;
    float* nin = emt + 256;
    float* OST = nin + 128 + wave * (8 * 132);
    for (int r16_ = 0; r16_ < REPN(16); ++r16_) {
    if (wave < 2) {
        const int dir = wave, l0 = dir == 0 ? 2 * lane : 127 - 2 * lane, l1 = dir == 0 ? 2 * lane + 1 : 126 - 2 * lane;
        const GAS bf16_t* g0 = U + (row0 + l0) * DINP + C_GT + h; const GAS bf16_t* g1 = U + (row0 + l1) * DINP + C_GT + h;
        const float bi = p.b_gate[dir * 8 + h], bf_ = p.b_gate[dir * 8 + 4 + h];
        const float i0 = bf2f(g0[dir * 8]) + bi, f0 = bf2f(g0[dir * 8 + 4]) + bf_, i1 = bf2f(g1[dir * 8]) + bi, f1 = bf2f(g1[dir * 8 + 4]) + bf_;
        const float m_in = MIN[(dir * 32 + bh) * NCH + J];
        const float lf0 = logsigf(f0), lf1 = logsigf(f1);
        const float incl = wscan_add(lf0 + lf1, lane), bc0 = incl - lf1, bc1 = incl;
        const float as0 = i0 - bc0, as1 = i1 - bc1;
        const float inclm = wscan_max(fmaxf(as0, as1), lane); float exclm = __shfl_up(inclm, 1); if (lane == 0) exclm = -INFINITY;
        const float gm0 = fmaxf(exclm, as0), gm1 = inclm;
        const float mp0 = bc0 + m_in, mp1 = bc1 + m_in, mt0 = fmaxf(bc0 + gm0, mp0), mt1 = fmaxf(bc1 + gm1, mp1);
        asv[dir * 128 + l0] = as0; asv[dir * 128 + l1] = as1; btv[dir * 128 + l0] = bc0 - mt0; btv[dir * 128 + l1] = bc1 - mt1;
        itv[dir * 128 + l0] = __expf(mp0 - mt0); itv[dir * 128 + l1] = __expf(mp1 - mt1); emt[dir * 128 + l0] = __expf(-mt0); emt[dir * 128 + l1] = __expf(-mt1);
    }
#pragma unroll
    for (int i = 0; i < 2; ++i) { const int idx = tid + i * NTHR, r = idx >> 3, ck = idx & 7; *(u32x4*)(Qs + r * 72 + ck * 8) = pre.q[i]; *(u32x4*)(Ks + r * 72 + ck * 8) = pre.k[i]; }
#pragma unroll
    for (int i = 0; i < 4; ++i) { const int idx = tid + i * NTHR, l = idx & 127, ck = idx >> 7;
        const u32x4 w = pre.v[i]; bf16_t* d = VT + (ck * 8) * 136 + l;
        d[0 * 136] = (bf16_t)(w.x & 0xffffu); d[1 * 136] = (bf16_t)(w.x >> 16); d[2 * 136] = (bf16_t)(w.y & 0xffffu); d[3 * 136] = (bf16_t)(w.y >> 16);
        d[4 * 136] = (bf16_t)(w.z & 0xffffu); d[5 * 136] = (bf16_t)(w.z >> 16); d[6 * 136] = (bf16_t)(w.w & 0xffffu); d[7 * 136] = (bf16_t)(w.w >> 16); }
#pragma unroll
    for (int dir = 0; dir < 2; ++dir)
#pragma unroll
        for (int i = 0; i < 2; ++i) { const int idx = tid + i * NTHR, v = idx >> 3, k8 = idx & 7; *(u32x4*)(Cs + (dir * 128 + v) * 72 + k8 * 8) = pre.c[dir][i]; }
    if (tid < 128) nin[tid] = NLOC[((size_t)((tid >> 6) * 32 + bh) * NCH + J) * 64 + (tid & 63)];
    }
    __syncthreads();
    if (next_item >= 0) ml_out_prefetch(p, next_item, tid, pre);
    const int tb = wave;
    bf16x8_t qf[2];
#pragma unroll
    for (int ks = 0; ks < 2; ++ks) qf[ks] = *(const bf16x8_t*)(Qs + (16 * tb + fr) * 72 + ks * 32 + 8 * fq);
    f32x4 hs[8];
    for (int r17_ = 0; r17_ < REPN(17); ++r17_) {
#pragma unroll
    for (int vb = 0; vb < 8; ++vb) hs[vb] = (f32x4){0.f, 0.f, 0.f, 0.f};
#pragma unroll
    for (int dir = 0; dir < 2; ++dir) {
        f32x4 acc[8];
#pragma unroll
        for (int vb = 0; vb < 8; ++vb) { acc[vb] = (f32x4){0.f, 0.f, 0.f, 0.f};
#pragma unroll
            for (int ks = 0; ks < 2; ++ks) { const bf16x8_t cf = *(const bf16x8_t*)(Cs + (dir * 128 + vb * 16 + fr) * 72 + ks * 32 + 8 * fq); acc[vb] = __builtin_amdgcn_mfma_f32_16x16x32_bf16(qf[ks], cf, acc[vb], 0, 0, 0); } }
        { const f32x4 i4 = *(const f32x4*)(itv + dir * 128 + 16 * tb + 4 * fq);
#pragma unroll
          for (int vb = 0; vb < 8; ++vb) acc[vb] = acc[vb] * i4; }
        const float bt = btv[dir * 128 + 16 * tb + fr];
        float rowsum = 0.f;
#pragma unroll
        for (int pr = 0; pr < 4; ++pr) {
            const int sb0 = 2 * pr, sb1 = 2 * pr + 1;
            const bool need0 = dir == 0 ? (sb0 <= tb) : (sb0 >= tb), need1 = dir == 0 ? (sb1 <= tb) : (sb1 >= tb);
            if (!need0 && !need1) continue;
            f32x4 s0 = (f32x4){0.f, 0.f, 0.f, 0.f}, s1 = (f32x4){0.f, 0.f, 0.f, 0.f};
            if (need0) {
#pragma unroll
                for (int ks = 0; ks < 2; ++ks) { const bf16x8_t kf = *(const bf16x8_t*)(Ks + (16 * sb0 + fr) * 72 + ks * 32 + 8 * fq); s0 = __builtin_amdgcn_mfma_f32_16x16x32_bf16(kf, qf[ks], s0, 0, 0, 0); }
                const f32x4 a4 = *(const f32x4*)(asv + dir * 128 + 16 * sb0 + 4 * fq);
#pragma unroll
                for (int j = 0; j < 4; ++j) { const bool valid = (sb0 != tb) || (dir == 0 ? (4 * fq + j <= fr) : (4 * fq + j >= fr)); s0[j] = valid ? s0[j] * __expf(bt + a4[j]) : 0.f; }
            }
            if (need1) {
#pragma unroll
                for (int ks = 0; ks < 2; ++ks) { const bf16x8_t kf = *(const bf16x8_t*)(Ks + (16 * sb1 + fr) * 72 + ks * 32 + 8 * fq); s1 = __builtin_amdgcn_mfma_f32_16x16x32_bf16(kf, qf[ks], s1, 0, 0, 0); }
                const f32x4 a4 = *(const f32x4*)(asv + dir * 128 + 16 * sb1 + 4 * fq);
#pragma unroll
                for (int j = 0; j < 4; ++j) { const bool valid = (sb1 != tb) || (dir == 0 ? (4 * fq + j <= fr) : (4 * fq + j >= fr)); s1[j] = valid ? s1[j] * __expf(bt + a4[j]) : 0.f; }
            }
            rowsum += (s0[0] + s0[1]) + (s0[2] + s0[3]) + (s1[0] + s1[1]) + (s1[2] + s1[3]);
            u32x4 pw; pw.x = cvtpk(s0[0], s0[1]); pw.y = cvtpk(s0[2], s0[3]); pw.z = cvtpk(s1[0], s1[1]); pw.w = cvtpk(s1[2], s1[3]);
            const bf16x8_t pa = __builtin_bit_cast(bf16x8_t, pw);
#pragma unroll
            for (int vb = 0; vb < 8; ++vb) {
                const u32x2 v0 = *(const u32x2*)(VT + (vb * 16 + fr) * 136 + 16 * sb0 + 4 * fq), v1 = *(const u32x2*)(VT + (vb * 16 + fr) * 136 + 16 * sb1 + 4 * fq);
                const u32x4 vw = (u32x4){v0.x, v0.y, v1.x, v1.y};
                acc[vb] = __builtin_amdgcn_mfma_f32_16x16x32_bf16(pa, __builtin_bit_cast(bf16x8_t, vw), acc[vb], 0, 0, 0);
            }
        }
        rowsum += __shfl_xor(rowsum, 16); rowsum += __shfl_xor(rowsum, 32);
        float nq = 0.f;
        { const u32x4 qa = *(const u32x4*)(Qs + (16 * tb + fr) * 72 + 16 * fq), qb = *(const u32x4*)(Qs + (16 * tb + fr) * 72 + 16 * fq + 8); const float* nn = nin + dir * 64 + 16 * fq;
          nq = nn[0] * bflo(qa.x) + nn[1] * bfhi(qa.x) + nn[2] * bflo(qa.y) + nn[3] * bfhi(qa.y) + nn[4] * bflo(qa.z) + nn[5] * bfhi(qa.z) + nn[6] * bflo(qa.w) + nn[7] * bfhi(qa.w)
             + nn[8] * bflo(qb.x) + nn[9] * bfhi(qb.x) + nn[10] * bflo(qb.y) + nn[11] * bfhi(qb.y) + nn[12] * bflo(qb.z) + nn[13] * bfhi(qb.z) + nn[14] * bflo(qb.w) + nn[15] * bfhi(qb.w); }
        nq += __shfl_xor(nq, 16); nq += __shfl_xor(nq, 32);
        const float den = rowsum + itv[dir * 128 + 16 * tb + fr] * nq;
        const float rdn = 1.f / fmaxf(fabsf(den), emt[dir * 128 + 16 * tb + fr]);
#pragma unroll
        for (int j = 0; j < 4; ++j) { const float r = __shfl(rdn, 4 * fq + j);
#pragma unroll
            for (int vb = 0; vb < 8; ++vb) hs[vb][j] += acc[vb][j] * r; }
    }
    }
    float mu[4], rs[4];
#pragma unroll
    for (int j = 0; j < 4; ++j) { float sm = 0.f;
#pragma unroll
        for (int vb = 0; vb < 8; ++vb) sm += hs[vb][j];
        sm += __shfl_xor(sm, 1); sm += __shfl_xor(sm, 2); sm += __shfl_xor(sm, 4); sm += __shfl_xor(sm, 8);
        mu[j] = sm * (1.f / 128.f); float sq = 0.f;
#pragma unroll
        for (int vb = 0; vb < 8; ++vb) { const float d = hs[vb][j] - mu[j]; sq += d * d; }
        sq += __shfl_xor(sq, 1); sq += __shfl_xor(sq, 2); sq += __shfl_xor(sq, 4); sq += __shfl_xor(sq, 8);
        rs[j] = rsqrtf(sq * (1.f / 128.f) + LN_EPS); }
    const GAS float* mng = (const GAS float*)p.ml_norm_g + h * 128;
    for (int r18_ = 0; r18_ < REPN(18); ++r18_) {
#pragma unroll
    for (int ps = 0; ps < 2; ++ps) {
#pragma unroll
        for (int vb = 0; vb < 8; ++vb) { const float gg = mng[vb * 16 + fr];
#pragma unroll
            for (int jj = 0; jj < 2; ++jj) { const int j = 2 * ps + jj; OST[(2 * fq + jj) * 132 + vb * 16 + fr] = (hs[vb][j] - mu[j]) * rs[j] * gg; } }
        LDS_FENCE();
        { const int rl = lane >> 3, ck = lane & 7, t = 16 * tb + 4 * (rl >> 1) + 2 * ps + (rl & 1);
          const float* src = OST + rl * 132 + ck * 16;
          const f32x4 o0 = *(const f32x4*)src, o1 = *(const f32x4*)(src + 4), o2 = *(const f32x4*)(src + 8), o3 = *(const f32x4*)(src + 12);
          const GAS bf16_t* omp = U + (row0 + t) * DINP + C_OM + h * 128 + ck * 16;
          const u32x4 oa = *(const GAS u32x4*)omp, ob = *(const GAS u32x4*)(omp + 8);
          u32x4 wa, wb;
          wa.x = pk2(o0.x * sigmoidf_(bflo(oa.x)), o0.y * sigmoidf_(bfhi(oa.x))); wa.y = pk2(o0.z * sigmoidf_(bflo(oa.y)), o0.w * sigmoidf_(bfhi(oa.y)));
          wa.z = pk2(o1.x * sigmoidf_(bflo(oa.z)), o1.y * sigmoidf_(bfhi(oa.z))); wa.w = pk2(o1.z * sigmoidf_(bflo(oa.w)), o1.w * sigmoidf_(bfhi(oa.w)));
          wb.x = pk2(o2.x * sigmoidf_(bflo(ob.x)), o2.y * sigmoidf_(bfhi(ob.x))); wb.y = pk2(o2.z * sigmoidf_(bflo(ob.y)), o2.w * sigmoidf_(bfhi(ob.y)));
          wb.z = pk2(o3.x * sigmoidf_(bflo(ob.z)), o3.y * sigmoidf_(bfhi(ob.z))); wb.w = pk2(o3.z * sigmoidf_(bflo(ob.w)), o3.w * sigmoidf_(bfhi(ob.w)));
          GAS bf16_t* dst = MIX + (row0 + t) * 1024 + 512 + h * 128 + ck * 16;
          *(GAS u32x4*)dst = wa; *(GAS u32x4*)(dst + 8) = wb; }
        LDS_FENCE();
    }
    }
    __syncthreads();
}
__device__ __forceinline__ void ph5(const Params& p, unsigned char* lds, int bid, int nblk) {
    MlPre pre; const int tid0 = threadIdx.x;
    if (bid < 32 * 64) ml_out_prefetch(p, bid, tid0, pre);
    for (int it = bid; it < 32 * 64; it += nblk) ml_out_item(p, lds, it, pre, it + nblk < 32 * 64 ? it + nblk : -1);
}


struct TrItem { const GAS float* W; GAS unsigned char* WT; size_t orow0; int N, k0, n0, ldt; float qs; };
__device__ __forceinline__ TrItem tr_decode(const Params& p, int it) {
    TrItem t; const int e = it / (3 * 704), r = it % (3 * 704), which = r / 704, q = r % 704;
    if (which < 2) { const int kb = q / 44, nb = q % 44; t.n0 = nb * 64; t.k0 = kb * 64; t.W = (const GAS float*)(which == 0 ? p.w_eg : p.w_eu) + (size_t)e * 1024 * DFF; t.N = DFF;
        t.WT = (GAS unsigned char*)(p.ws + WS_WGUT) + (size_t)e * 2 * DFF * 1024; t.orow0 = (size_t)((t.n0 >> 7) * 256 + which * 128 + (t.n0 & 127)); t.ldt = 1024; t.qs = 32.f; }
    else { const int kb = q / 16, nb = q % 16; t.n0 = nb * 64; t.k0 = kb * 64; t.W = (const GAS float*)p.w_ed + (size_t)e * DFF * 1024; t.N = 1024;
        t.WT = (GAS unsigned char*)(p.ws + WS_WDT) + (size_t)e * 1024 * DFF; t.orow0 = (size_t)t.n0; t.ldt = DFF; t.qs = 64.f; }
    return t;
}
__device__ __forceinline__ void tr_load(const TrItem& t, int lane, f32x4 (&v)[16]) {
    const int cq = (lane & 15) * 4, rq = lane >> 4;
#pragma unroll
    for (int i = 0; i < 16; ++i) v[i] = __builtin_nontemporal_load((const GAS f32x4*)(t.W + (size_t)(t.k0 + 4 * i + rq) * t.N + t.n0 + cq));
}
__device__ __forceinline__ void tr_to_lds(const TrItem& t, int lane, const f32x4 (&v)[16], float* scr) {
    const int cq = (lane & 15) * 4, rq = lane >> 4;
#pragma unroll
    for (int i = 0; i < 16; ++i) { float* d = scr + (4 * i + rq) * 65 + cq; d[0] = v[i].x * t.qs; d[1] = v[i].y * t.qs; d[2] = v[i].z * t.qs; d[3] = v[i].w * t.qs; }
    LDS_FENCE();
}
__device__ __forceinline__ void tr_store(const TrItem& t, int lane, const float* scr) {
    const int c = lane & 7;
#pragma unroll
    for (int j = 0; j < 8; ++j) {
        const int n = (lane >> 3) + 8 * j; const float* sp = scr + (8 * c) * 65 + n;
        u32x2 o; o.x = pk4_fp8(sp[0 * 65], sp[1 * 65], sp[2 * 65], sp[3 * 65]); o.y = pk4_fp8(sp[4 * 65], sp[5 * 65], sp[6 * 65], sp[7 * 65]);
        *(GAS u32x2*)(t.WT + (t.orow0 + n) * t.ldt + t.k0 + 8 * c) = o;
    }
    LDS_FENCE();
}
__device__ __forceinline__ float reduce16(const float (&lg)[16], int lane) {
    float a8[8], a4[4], a2[2];
    const bool h5 = lane & 32, h4 = lane & 16, h3 = lane & 8, h2 = lane & 4;
#pragma unroll
    for (int i = 0; i < 8; ++i) { const float snd = h5 ? lg[i] : lg[8 + i], kp = h5 ? lg[8 + i] : lg[i]; a8[i] = kp + __shfl_xor(snd, 32); }
#pragma unroll
    for (int i = 0; i < 4; ++i) { const float snd = h4 ? a8[i] : a8[4 + i], kp = h4 ? a8[4 + i] : a8[i]; a4[i] = kp + __shfl_xor(snd, 16); }
#pragma unroll
    for (int i = 0; i < 2; ++i) { const float snd = h3 ? a4[i] : a4[2 + i], kp = h3 ? a4[2 + i] : a4[i]; a2[i] = kp + __shfl_xor(snd, 8); }
    const float snd = h2 ? a2[0] : a2[1], kp = h2 ? a2[1] : a2[0];
    float d = kp + __shfl_xor(snd, 4);
    d += __shfl_xor(d, 2); d += __shfl_xor(d, 1);
    return d;
}
__device__ __forceinline__ void ph7(const Params& p, unsigned char* lds, int bid, int nblk) {
    const int tid = ltid(), lane = tid & 63, wave = tid >> 6;
    const GAS float* MOD = (const GAS float*)(p.ws + WS_MOD); GAS unsigned char* HMOD = (GAS unsigned char*)(p.ws + WS_HMOD); GAS float* AFF = (GAS float*)(p.ws + WS_AFF);
    const GAS bf16_t* Y = (const GAS bf16_t*)(p.ws + WS_Y); const GAS float* ln1g = (const GAS float*)p.ln1_g; const GAS float* ln1b = (const GAS float*)p.ln1_b;
    const int gw = bid * NWAVES + wave, ngw = nblk * NWAVES;
    __syncthreads();
    float* WR = (float*)lds; float* RED = WR + 16 * 1028;
    { const GAS float* wr = (const GAS float*)p.w_router; for (int idx = tid; idx < 16 * 1024; idx += NTHR) { const int k = idx >> 4, e = idx & 15; WR[e * 1028 + k] = wr[idx]; } }
    __syncthreads();
    for (int rep12_ = 0; rep12_ < REPN(12); ++rep12_) {
    u32x2 vn[2][4];
    if (2 * gw < NLAT) {
#pragma unroll
        for (int r = 0; r < 2; ++r)
#pragma unroll
            for (int j = 0; j < 4; ++j) vn[r][j] = *(const GAS u32x2*)(Y + (size_t)(2 * gw + r) * 1024 + j * 256 + lane * 4); }
    for (int m0 = 2 * gw; m0 < NLAT; m0 += 2 * ngw) {
        asm volatile("" ::: "memory");
        const int b = m0 >> 13;
        const GAS float* sh2 = MOD + b * 6144 + 3072; const GAS float* sc2 = sh2 + 1024;
        f32x4 v[2][4]; float mean[2], rstd[2];
#pragma unroll
        for (int r = 0; r < 2; ++r)
#pragma unroll
            for (int j = 0; j < 4; ++j) v[r][j] = (f32x4){hlo(vn[r][j].x), hhi(vn[r][j].x), hlo(vn[r][j].y), hhi(vn[r][j].y)};
        if (m0 + 2 * ngw < NLAT) {
#pragma unroll
            for (int r = 0; r < 2; ++r)
#pragma unroll
                for (int j = 0; j < 4; ++j) vn[r][j] = *(const GAS u32x2*)(Y + (size_t)(m0 + 2 * ngw + r) * 1024 + j * 256 + lane * 4); }
#pragma unroll
        for (int r = 0; r < 2; ++r) { float sm = 0.f;
#pragma unroll
            for (int j = 0; j < 4; ++j) sm += (v[r][j].x + v[r][j].y) + (v[r][j].z + v[r][j].w);
            mean[r] = wave_sum(sm) * (1.f / 1024.f); float s2 = 0.f;
#pragma unroll
            for (int j = 0; j < 4; ++j) { v[r][j] = v[r][j] - mean[r]; s2 += (v[r][j].x * v[r][j].x + v[r][j].y * v[r][j].y) + (v[r][j].z * v[r][j].z + v[r][j].w * v[r][j].w); }
            rstd[r] = rsqrtf(wave_sum(s2) * (1.f / 1024.f) + LN_EPS); }
        f32x4 hm[2][4];
#pragma unroll
        for (int j = 0; j < 4; ++j) {
            const int k = j * 256 + lane * 4;
            const f32x4 g = *(const GAS f32x4*)(ln1g + k), be = *(const GAS f32x4*)(ln1b + k), a = *(const GAS f32x4*)(sc2 + k), sb = *(const GAS f32x4*)(sh2 + k);
#pragma unroll
            for (int r = 0; r < 2; ++r) { hm[r][j] = (v[r][j] * rstd[r] * g + be) * (1.f + a) + sb;
                *(GAS unsigned*)(HMOD + (size_t)(m0 + r) * 1024 + k) = pk4_fp8(hm[r][j].x, hm[r][j].y, hm[r][j].z, hm[r][j].w); }
        }
        float* red = RED + wave * (2 * 64 * 17);
#pragma unroll
        for (int e4 = 0; e4 < 4; ++e4) {
            float a[2][4];
#pragma unroll
            for (int ee = 0; ee < 4; ++ee) {
                f32x4 a0 = {0.f, 0.f, 0.f, 0.f}, a1 = {0.f, 0.f, 0.f, 0.f};
#pragma unroll
                for (int j = 0; j < 4; ++j) { const f32x4 w = *(const f32x4*)(WR + (e4 * 4 + ee) * 1028 + j * 256 + lane * 4);
                    a0 = __builtin_elementwise_fma(hm[0][j], w, a0); a1 = __builtin_elementwise_fma(hm[1][j], w, a1); }
                a[0][ee] = (a0.x + a0.y) + (a0.z + a0.w); a[1][ee] = (a1.x + a1.y) + (a1.z + a1.w);
            }
#pragma unroll
            for (int ee = 0; ee < 4; ++ee) { red[lane * 17 + e4 * 4 + ee] = a[0][ee]; red[64 * 17 + lane * 17 + e4 * 4 + ee] = a[1][ee]; }
            asm volatile("" ::: "memory");
        }
        LDS_FENCE();
        { const int e = lane & 15, r = (lane >> 4) & 1, part = lane >> 5;
          float d = 0.f; const float* src = red + r * (64 * 17) + e + part * 32 * 17;
#pragma unroll 8
          for (int l = 0; l < 32; ++l) d += src[l * 17];
          d += __shfl_xor(d, 32);
          float mx = d; mx = fmaxf(mx, __shfl_xor(mx, 1)); mx = fmaxf(mx, __shfl_xor(mx, 2)); mx = fmaxf(mx, __shfl_xor(mx, 4)); mx = fmaxf(mx, __shfl_xor(mx, 8));
          const float ex = expf(d - mx); float sm = ex; sm += __shfl_xor(sm, 1); sm += __shfl_xor(sm, 2); sm += __shfl_xor(sm, 4); sm += __shfl_xor(sm, 8);
          if (lane < 32) AFF[((size_t)b * 16 + e) * 8192 + ((m0 + r) & 8191)] = ex / sm; }
        LDS_FENCE();
    }
    }
}
__device__ __forceinline__ void ph7_conv(const Params& p, unsigned char* lds, int bid, int nblk) {
    const int tid = ltid(), lane = tid & 63, wave = tid >> 6;
    const int gw = bid * NWAVES + wave, ngw = nblk * NWAVES;
    float* scr = (float*)lds + wave * (64 * 65);
    for (int rep13_ = 0; rep13_ < REPN(13); ++rep13_) {
        f32x4 tv[16]; int it = gw;
        if (it < NE * 3 * 704) { const TrItem c0 = tr_decode(p, it); tr_load(c0, lane, tv); }
        for (; it < NE * 3 * 704; it += ngw) {
            const TrItem cur = tr_decode(p, it);
            tr_to_lds(cur, lane, tv, scr);
            if (it + ngw < NE * 3 * 704) { const TrItem nx = tr_decode(p, it + ngw); tr_load(nx, lane, tv); }
            tr_store(cur, lane, scr);
        }
    }
    __syncthreads();
}

__device__ __forceinline__ void topk_item(const Params& p, unsigned char* lds, int item) {
    const float* AFF = (const float*)(p.ws + WS_AFF); int* IDX = (int*)(p.ws + WS_IDX); float* GSEL = (float*)(p.ws + WS_GSEL); int* INV = (int*)(p.ws + WS_INV);
    const int tid = ltid(), lane = tid & 63, wave = tid >> 6;
    const int b = item >> 4, e = item & 15;
    unsigned* wcnt = (unsigned*)lds;
    const float* a = AFF + ((size_t)b * 16 + e) * 8192;
    unsigned bits[16];
#pragma unroll
    for (int j = 0; j < 16; ++j) bits[j] = __float_as_uint(a[j * 512 + tid]);
    __syncthreads();
    unsigned tau = 0u;
    for (int bit = 30; bit >= 0; --bit) {
        const unsigned cand = tau | (1u << bit);
        unsigned cnt = 0;
#pragma unroll
        for (int j = 0; j < 16; ++j) cnt += (unsigned)__popcll(__ballot(bits[j] >= cand));
        unsigned* slot = wcnt + ((bit & 1) << 3);
        if (lane == 0) slot[wave] = cnt;
        __syncthreads();
        unsigned tot = 0;
#pragma unroll
        for (int w = 0; w < 8; ++w) tot += slot[w];
        if (tot >= (unsigned)CAP) tau = cand;
    }
    unsigned* ctab = wcnt + 32;
    const unsigned long long lt_mask = (1ull << lane) - 1ull;
#pragma unroll
    for (int j = 0; j < 16; ++j) { const unsigned cw = (unsigned)__popcll(__ballot(bits[j] > tau)) | ((unsigned)__popcll(__ballot(bits[j] == tau)) << 16);
        if (lane == 0) ctab[j * 8 + wave] = cw; }
    __syncthreads();
    unsigned ngt = 0;
#pragma unroll
    for (int j = 0; j < 16; ++j)
#pragma unroll
        for (int w = 0; w < 8; ++w) ngt += ctab[j * 8 + w] & 0xffffu;
    const unsigned need = (unsigned)CAP - ngt;
    unsigned base_gt = 0, base_eq = 0;
#pragma unroll
    for (int j = 0; j < 16; ++j) {
        const bool gt = bits[j] > tau, eq = bits[j] == tau;
        const unsigned long long bg = __ballot(gt), be = __ballot(eq);
        unsigned pgt = 0, peq = 0, tgt = 0, teq = 0;
#pragma unroll
        for (int w = 0; w < 8; ++w) { const unsigned cw = ctab[j * 8 + w], cg_ = cw & 0xffffu, ce = cw >> 16; if (w < wave) { pgt += cg_; peq += ce; } tgt += cg_; teq += ce; }
        const unsigned gt_before = base_gt + pgt + (unsigned)__popcll(bg & lt_mask), eq_before = base_eq + peq + (unsigned)__popcll(be & lt_mask);
        const bool sel = gt || (eq && eq_before < need);
        const unsigned slot = gt_before + (eq_before < need ? eq_before : need);
        const int i = j * 512 + tid;
        if (sel) { IDX[(e * 8 + b) * CAP + slot] = i; GSEL[(e * 8 + b) * CAP + slot] = __uint_as_float(bits[j]); }
        INV[((size_t)b * 8192 + i) * 16 + e] = sel ? (int)slot : -1;
        base_gt += tgt; base_eq += teq;
    }
    __syncthreads();
}
__device__ __forceinline__ void ph8(const Params& p, unsigned char* lds, int bid, int nblk) { for (int it = bid; it < 128; it += nblk) topk_item(p, lds, it); }


#define XB_TMO      128
#define XB_XCNT(j)  (256  + 64 * (j))
#define XB_XSUB(j)  (1280 + 64 * (j))
#define XB_XGEN(j)  (2304 + 64 * (j))
#define XB_TOP      3328
#define XB_TOPGEN   3392
#define XCD_BAR_WORDS 3456
#define XB_SPIN_CAP (1u << 18)
__device__ __forceinline__ unsigned xb_ld(unsigned* p)              { return __hip_atomic_load(p, __ATOMIC_RELAXED, __HIP_MEMORY_SCOPE_AGENT); }
__device__ __forceinline__ unsigned xb_add(unsigned* p, unsigned v) { return __hip_atomic_fetch_add(p, v, __ATOMIC_RELAXED, __HIP_MEMORY_SCOPE_AGENT); }
__device__ __forceinline__ unsigned xb_xcc_id() { return (unsigned)__builtin_amdgcn_s_getreg((3 << 11) | 20) & 0xFu; }
#define XB_SPIN(cond, bar) do { unsigned _sp = 0; while (cond) { __builtin_amdgcn_s_sleep(1); \
    if ((++_sp & 255u) == 0u) { if (xb_ld(&(bar)[XB_TMO])) break; if (_sp > XB_SPIN_CAP) { atomicAdd(&(bar)[XB_TMO], 1u); break; } } } } while (0)
struct XcdBarrier { unsigned* bar; unsigned x; volatile LAS unsigned* st; };
__device__ __forceinline__ XcdBarrier xcd_barrier_post(unsigned* bar, volatile LAS unsigned* st) {
    XcdBarrier b; b.bar = bar; b.x = xb_xcc_id(); b.st = st;
    if (threadIdx.x == 0) (void)xb_add(&bar[XB_XCNT(b.x)], 1u);
    return b;
}
__device__ __forceinline__ void xcd_barrier_complete(unsigned* bar, unsigned x, unsigned& nloc, unsigned& nx) {
    const unsigned G = gridDim.x * gridDim.y * gridDim.z;
    unsigned sum, cnt, mine, sp = 0u;
    for (;;) {
        sum = 0u; cnt = 0u; mine = 0u;
#pragma unroll
        for (unsigned j = 0; j < 16; ++j) { const unsigned c = xb_ld(&bar[XB_XCNT(j)]); sum += c; cnt += (c > 0u) ? 1u : 0u; mine = (j == x) ? c : mine; }
        if (sum == G) break;
        __builtin_amdgcn_s_sleep(1);
        if ((++sp & 255u) == 0u) { if (xb_ld(&bar[XB_TMO])) break; if (sp > XB_SPIN_CAP) { atomicAdd(&bar[XB_TMO], 1u); break; } }
    }
    nloc = mine > 0u ? mine : 1u; nx = cnt > 0u ? cnt : 1u;
}
__device__ __forceinline__ void xcd_barrier(const XcdBarrier& b) {
    asm volatile("s_waitcnt vmcnt(0)" ::: "memory");
    __syncthreads();
    if (threadIdx.x == 0) {
        unsigned* bar = b.bar;
        __builtin_amdgcn_s_waitcnt(0);
        unsigned nloc = b.st[0], nx = b.st[1];
        if (nloc == 0u) { xcd_barrier_complete(bar, b.x, nloc, nx); b.st[0] = nloc; b.st[1] = nx; }
        const unsigned old = xb_add(&bar[XB_XSUB(b.x)], 1u);
        const unsigned gen = old / nloc;
        if (old + 1u == (gen + 1u) * nloc) {
            __builtin_amdgcn_fence(__ATOMIC_RELEASE, "agent");
            asm volatile("s_waitcnt vmcnt(0)" ::: "memory");
            const unsigned og = xb_add(&bar[XB_TOP], 1u);
            const unsigned tg = og / nx;
            if (og + 1u == (tg + 1u) * nx) xb_add(&bar[XB_TOPGEN], 1u);
            else XB_SPIN(xb_ld(&bar[XB_TOPGEN]) == tg, bar);
            __builtin_amdgcn_fence(__ATOMIC_ACQUIRE, "agent");
            xb_add(&bar[XB_XGEN(b.x)], 1u);
            asm volatile("s_waitcnt vmcnt(0)" ::: "memory");
        } else {
            XB_SPIN(xb_ld(&bar[XB_XGEN(b.x)]) == gen, bar);
            __builtin_amdgcn_fence(__ATOMIC_ACQUIRE, "agent");
            asm volatile("s_waitcnt vmcnt(0)" ::: "memory");
        }
    }
    __syncthreads();
}

__device__ __forceinline__ pg8::GemmDesc make_desc(const Params& p, int gi) {
    pg8::GemmDesc g{};
    if (gi == 0) { g.A = p.ws + WS_XM; g.Bt = p.ws + WS_WINT; g.O = p.ws + WS_U; g.Kb = 2048; g.nM = MROWS / 256; g.nN = DINP / 256; g.epi = 0; g.ldc = DINP; g.qtiles = 2; }
    else if (gi == 1) { g.A = p.ws + WS_MIX; g.Bt = p.ws + WS_WOUTG; g.bEstride = (size_t)D_ * D_ * 2; g.O = p.ws + WS_Y; g.x = p.x; g.Kb = 2048; g.nM = NLAT / 256; g.nN = 4; g.epi = 2; g.ldc = 1024; }
    else if (gi == 2) { g.A = p.ws + WS_HMOD; g.Bt = p.ws + WS_WGUT; g.IDX = (const int*)(p.ws + WS_IDX); g.O = p.ws + WS_ACT; g.bEstride = (size_t)2 * DFF * 1024; g.Kb = 1024; g.nM = NE * 32; g.nN = 22; g.epi = 1; g.ldc = DFF; }
    else { g.A = p.ws + WS_ACT; g.Bt = p.ws + WS_WDT; g.O = p.ws + WS_EO; g.bEstride = (size_t)1024 * DFF; g.Kb = DFF; g.nM = NE * 32; g.nN = 4; g.epi = 3; g.ldc = 1024; }
    return g;
}

__device__ __forceinline__ void ph_final(const Params& p, int bid, int nblk) {
    const int tid = ltid(), lane = tid & 63, wave = tid >> 6;
    const GAS float* MOD = (const GAS float*)(p.ws + WS_MOD); const GAS bf16_t* EO = (const GAS bf16_t*)(p.ws + WS_EO); const GAS float* GSEL = (const GAS float*)(p.ws + WS_GSEL); const GAS int* INV = (const GAS int*)(p.ws + WS_INV);
    const GAS bf16_t* Y = (const GAS bf16_t*)(p.ws + WS_Y); GAS float* OUT = (GAS float*)p.out; const GAS float* ln1g = (const GAS float*)p.ln1_g; const GAS float* ln1b = (const GAS float*)p.ln1_b; const GAS float* ln2g = (const GAS float*)p.ln2_g; const GAS float* ln2b = (const GAS float*)p.ln2_b;
    const int mstride = nblk * NWAVES;
    int m = bid * NWAVES + wave;
    u32x2 vn[4]; int invn = -1;
    if (m < NLAT) { invn = lane < 16 ? INV[(size_t)m * 16 + lane] : -1;
#pragma unroll
        for (int j = 0; j < 4; ++j) vn[j] = *(const GAS u32x2*)(Y + (size_t)m * 1024 + j * 256 + lane * 4); }
    for (; m < NLAT; m += mstride) {
        const int b = m >> 13;
        GAS float* y = OUT + (size_t)m * 1024; const GAS float* g2 = MOD + b * 6144 + 5120;
        const int myinv = invn;
        f32x4 v[4]; float s = 0.f;
#pragma unroll
        for (int j = 0; j < 4; ++j) { v[j] = (f32x4){hlo(vn[j].x), hhi(vn[j].x), hlo(vn[j].y), hhi(vn[j].y)}; s += (v[j].x + v[j].y) + (v[j].z + v[j].w); }
        if (m + mstride < NLAT) { invn = lane < 16 ? INV[(size_t)(m + mstride) * 16 + lane] : -1;
#pragma unroll
            for (int j = 0; j < 4; ++j) vn[j] = *(const GAS u32x2*)(Y + (size_t)(m + mstride) * 1024 + j * 256 + lane * 4); }
        f32x4 moe[4];
#pragma unroll
        for (int j = 0; j < 4; ++j) moe[j] = (f32x4){0.f, 0.f, 0.f, 0.f};
        unsigned emask = (unsigned)__ballot(myinv >= 0);
        while (emask) {
            const int e = __builtin_ctz(emask); emask &= emask - 1u;
            const int slot = __builtin_amdgcn_readlane(myinv, e);
            const float g = GSEL[(e * 8 + b) * CAP + slot];
            const GAS bf16_t* row = EO + ((size_t)e * 8192 + b * 1024 + slot) * 1024;
#pragma unroll
            for (int j = 0; j < 4; ++j) { const u32x2 w = *(const GAS u32x2*)(row + j * 256 + lane * 4); moe[j].x += g * bflo(w.x); moe[j].y += g * bfhi(w.x); moe[j].z += g * bflo(w.y); moe[j].w += g * bfhi(w.y); }
        }
        const float mean = wave_sum(s) * (1.f / 1024.f); float s2 = 0.f;
#pragma unroll
        for (int j = 0; j < 4; ++j) { v[j] = v[j] - mean; s2 += (v[j].x * v[j].x + v[j].y * v[j].y) + (v[j].z * v[j].z + v[j].w * v[j].w); }
        const float rstd = rsqrtf(wave_sum(s2) * (1.f / 1024.f) + LN_EPS);
        float s3 = 0.f;
#pragma unroll
        for (int j = 0; j < 4; ++j) { const int k = j * 256 + lane * 4;
            const f32x4 g = *(const GAS f32x4*)(ln1g + k), be = *(const GAS f32x4*)(ln1b + k), gg = *(const GAS f32x4*)(g2 + k);
            v[j] = ALPHA * (v[j] * rstd * g + be) + gg * moe[j]; s3 += (v[j].x + v[j].y) + (v[j].z + v[j].w); }
        const float mean2 = wave_sum(s3) * (1.f / 1024.f); float s4 = 0.f;
#pragma unroll
        for (int j = 0; j < 4; ++j) { v[j] = v[j] - mean2; s4 += (v[j].x * v[j].x + v[j].y * v[j].y) + (v[j].z * v[j].z + v[j].w * v[j].w); }
        const float rstd2 = rsqrtf(wave_sum(s4) * (1.f / 1024.f) + LN_EPS);
#pragma unroll
        for (int j = 0; j < 4; ++j) { const int k = j * 256 + lane * 4; const f32x4 g = *(const GAS f32x4*)(ln2g + k), be = *(const GAS f32x4*)(ln2b + k);
            __builtin_nontemporal_store(v[j] * rstd2 * g + be, (GAS f32x4*)(y + k)); }
    }
}

constexpr int NPHASE = 12;
#ifndef ONLY_PH
#define ONLY_PH -1
#endif
#define PH_EN(n) (ONLY_PH < 0 || ONLY_PH == (n))
__global__ void __launch_bounds__(NTHR, 2) mk_fwd(Params p) {
    extern __shared__ __attribute__((aligned(16))) unsigned char lds[];
    const int bid = blockIdx.x, nblk = gridDim.x;
    volatile LAS unsigned* MISC = (volatile LAS unsigned*)((LAS unsigned char*)lds + (LDS_BYTES - 16));
    if (threadIdx.x < 4) MISC[threadIdx.x] = 0u;
    __syncthreads();
    const XcdBarrier xbar = xcd_barrier_post((unsigned*)(p.ws + WS_CTL) + 4096, MISC);
#ifndef PHMASK
#define PHMASK 0xffff
#endif
#define IN(k) ((((PHMASK) >> (k)) & 1) && p.ph_lo <= (k) && (k) < p.ph_hi)
#define LOADP() load_params()
#define LAUNDER() const int bid_ = bid, nblk_ = nblk; unsigned char* const lds_ = lds
#define SEAM(k) do { if (IN(k) && IN((k) + 1)) xcd_barrier(xbar); } while (0)
    if (IN(0)) for (int rep_ = 0; rep_ < REPN(0); ++rep_) { const Params q = LOADP(); LAUNDER(); ph0(q, lds_, bid_, nblk_); }
    SEAM(0);
    if (IN(1)) for (int rep_ = 0; rep_ < REPN(1); ++rep_) { const Params q = LOADP(); LAUNDER(); ph1(q, bid_, nblk_); }
    SEAM(1);
    if (IN(2)) for (int rep_ = 0; rep_ < REPN(2); ++rep_) { const Params q = load_params_s(); LAUNDER(); const pg8::GemmDesc g = make_desc(q, 0); pg8::gemm_phase<false, false>((LAS unsigned char*)lds, g, nblk_, bid_); }
    SEAM(2);
    if (IN(3)) for (int rep_ = 0; rep_ < REPN(3); ++rep_) { const Params q = LOADP(); LAUNDER(); ph3(q, lds_, bid_, nblk_); }
    SEAM(3);
    if (IN(4)) for (int rep_ = 0; rep_ < REPN(4); ++rep_) { const Params q = LOADP(); LAUNDER(); ph4(q, bid_, nblk_); }
    SEAM(4);
    if (IN(5)) for (int rep_ = 0; rep_ < REPN(5); ++rep_) { const Params q = LOADP(); LAUNDER(); ph5(q, lds_, bid_, nblk_); }
    SEAM(5);
    if (IN(6)) for (int rep_ = 0; rep_ < REPN(6); ++rep_) { const Params q = load_params_s(); LAUNDER(); const int grp_ = (bid_ >> 5) & 1;
        if (grp_ == 0) ph7_conv(q, lds_, bid_, nblk_);
        { const pg8::GemmDesc g = make_desc(q, 1); pg8::gemm_phase<false, false>((LAS unsigned char*)lds, g, nblk_, bid_); }
        if (grp_ != 0) { const Params q2 = LOADP(); ph7_conv(q2, lds_, bid_, nblk_); } }
    SEAM(6);
    if (IN(7)) for (int rep_ = 0; rep_ < REPN(7); ++rep_) { const Params q = LOADP(); LAUNDER(); ph7(q, lds_, bid_, nblk_); }
    SEAM(7);
    if (IN(8)) for (int rep_ = 0; rep_ < REPN(8); ++rep_) { const Params q = LOADP(); LAUNDER(); ph8(q, lds_, bid_, nblk_); }
    SEAM(8);
#pragma unroll 1
    for (int st = 2; st < 4; ++st) {
        if (IN(7 + st)) for (int rep_ = 0; rep_ < REPN(9); ++rep_) { const Params q = load_params_s(); LAUNDER(); const pg8::GemmDesc g = make_desc(q, st); pg8::gemm_phase<true, true>((LAS unsigned char*)lds, g, nblk_, bid_); }
        SEAM(7 + st);
    }
    if (IN(11)) for (int rep_ = 0; rep_ < REPN(11); ++rep_) { const Params q = LOADP(); LAUNDER(); ph_final(q, bid_, nblk_); }
#undef IN
#undef SEAM
}

extern "C" void kernel_launch(void* const* d_in, const int* in_sizes, int n_in, void* d_out, int out_size, void* d_ws, size_t ws_size, hipStream_t stream) {
    static int grid_blocks = 0;
    if (grid_blocks == 0) {
        if (n_in != 20 || out_size != NLAT * D_ || ws_size < WS_WOUTG + (size_t)NB * D_ * D_ * 2 || ws_size < WS_END) { fprintf(stderr, "kernel_launch: unexpected shapes (n_in %d out %d ws %zu need %zu)\n", n_in, out_size, ws_size, (size_t)WS_END); grid_blocks = -1; return; }
        int dev = 0, cus = 0, per_cu = 0;
        if (hipGetDevice(&dev) != hipSuccess || hipDeviceGetAttribute(&cus, hipDeviceAttributeMultiprocessorCount, dev) != hipSuccess) { grid_blocks = -1; return; }
        if (hipFuncSetAttribute((const void*)mk_fwd, hipFuncAttributeMaxDynamicSharedMemorySize, LDS_BYTES) != hipSuccess) { fprintf(stderr, "kernel_launch: hipFuncSetAttribute failed\n"); grid_blocks = -1; return; }
        if (hipOccupancyMaxActiveBlocksPerMultiprocessor(&per_cu, (const void*)mk_fwd, NTHR, LDS_BYTES) != hipSuccess || per_cu < 1) { fprintf(stderr, "kernel_launch: occupancy query failed (%d)\n", per_cu); grid_blocks = -1; return; }
        grid_blocks = cus * per_cu;
    }
    if (grid_blocks < 0) return;
    if (hipMemsetAsync((char*)d_ws + WS_CTL, 0, 65536, stream) != hipSuccess) { fprintf(stderr, "kernel_launch: hipMemsetAsync failed\n"); return; }
    Params p{};
    const float** pp = (const float**)&p;
    for (int i = 0; i < 20; ++i) pp[i] = (const float*)d_in[i];
    p.out = (float*)d_out; p.ws = (unsigned char*)d_ws;
    p.ph_lo = 0; p.ph_hi = NPHASE;
    void* args[] = {&p};
    hipError_t e = hipLaunchCooperativeKernel((const void*)mk_fwd, dim3(grid_blocks), dim3(NTHR), args, LDS_BYTES, stream);
    if (e != hipSuccess) fprintf(stderr, "cooperative launch failed: %s (grid %d)\n", hipGetErrorString(e), grid_blocks);
}
```

```cpp
#include <hip/hip_runtime.h>
#include <hip/hip_cooperative_groups.h>
#include <cstdio>
#include <cstdint>
namespace cg = cooperative_groups;
#ifndef REPMASK
#define REPMASK 0
#endif
#define REPN(k) ((((REPMASK) >> (k)) & 1) ? 2 : 1)

typedef unsigned short bf16_t;
#define GAS __attribute__((address_space(1)))
typedef float f32x4 __attribute__((ext_vector_type(4)));
typedef unsigned u32x4 __attribute__((ext_vector_type(4)));
typedef unsigned u32x2 __attribute__((ext_vector_type(2)));

constexpr int NB = 8, T_ = 8192, D_ = 1024, LC = 256;
constexpr int NLAT = NB * T_, NCTX = NB * LC, MROWS = NLAT + NCTX;
constexpr int DIN = 3088, DINP = 3328;
constexpr int NE = 16, CAP = 1024, DFF = 2816;
constexpr int C_QA = 0, C_KA = 512, C_VA = 1024, C_QM = 1536, C_KM = 1792, C_VM = 2048, C_OM = 2560, C_GT = 3072;
constexpr int NCH = 66;
constexpr float LN_EPS = 1e-5f;
constexpr float ALPHA = 1.189207115002721f;
constexpr int NGROUPS = 1, EPG = NE / NGROUPS;

constexpr int NTHR = 512, NWAVES = 8;
constexpr int LDS_BYTES = 163840;

constexpr size_t MiB = 1u << 20;
constexpr size_t WS_CTL = 0;
constexpr size_t WS_MOD = 1 * MiB;
constexpr size_t WS_ROPE = 1 * MiB + 256 * 1024;
constexpr size_t WS_BLAST = 1 * MiB + 512 * 1024;
constexpr size_t WS_MLOC = WS_BLAST + 32 * 1024;
constexpr size_t WS_MIN = WS_MLOC + 32 * 1024;
constexpr size_t WS_NLOC = 2 * MiB;
constexpr size_t WS_IDX = 4 * MiB;
constexpr size_t WS_GSEL = 4 * MiB + 512 * 1024;
constexpr size_t WS_AFF = 5 * MiB;
constexpr size_t WS_INV = 9 * MiB;
constexpr size_t WS_WINT = 16 * MiB;
constexpr size_t WS_WOUTT = 23 * MiB;
constexpr size_t WS_XM = 32 * MiB;
constexpr size_t WS_U = 164 * MiB;
constexpr size_t WS_QP = 593 * MiB;
constexpr size_t WS_KP = 625 * MiB;
constexpr size_t WS_CLOC = 658 * MiB;
constexpr size_t WS_MIX = 32 * MiB;
constexpr size_t WS_WOUTG = 948 * MiB;
constexpr size_t WS_Y = 820 * MiB;
constexpr size_t WS_HMOD = 16 * MiB;
constexpr size_t WS_WGUT = 688 * MiB;
constexpr size_t WS_WDT = 776 * MiB;
constexpr size_t WS_EO = 80 * MiB;
constexpr size_t WS_ACT = 336 * MiB;
constexpr size_t WS_END = WS_WDT + (size_t)NE * D_ * DFF;
static_assert(WS_XM + (size_t)MROWS * D_ * 2 <= WS_U, "map");
static_assert(WS_U + (size_t)MROWS * DINP * 2 <= WS_QP, "map");
static_assert(WS_KP + (size_t)MROWS * 256 * 2 <= WS_CLOC, "map");
static_assert(WS_CLOC + (size_t)64 * NCH * 8192 * 4 <= WS_Y, "map");
static_assert(WS_MIX + (size_t)NLAT * D_ * 2 <= WS_U, "map");
static_assert(WS_Y + (size_t)NLAT * D_ * 2 <= WS_WOUTG && WS_WOUTG + (size_t)NB * D_ * D_ * 2 <= 1024 * MiB, "map");
static_assert(WS_HMOD + (size_t)NLAT * D_ <= WS_EO && WS_EO + (size_t)NE * 8192 * D_ * 2 <= WS_ACT, "map");
static_assert(WS_ACT + (size_t)NE * 8192 * DFF <= WS_WGUT && WS_WGUT + (size_t)NE * 2 * DFF * D_ <= WS_WDT, "map");
static_assert(WS_MIX + (size_t)NLAT * D_ * 2 <= WS_WGUT && WS_CLOC <= WS_WGUT, "map");
static_assert(WS_END <= WS_Y, "map");

struct Params {
    const float *x, *c, *ctx, *c_ctx, *w_ada, *b_ada, *w_in, *b_gate, *conv_qk, *na_bias, *ml_norm_g, *w_out,
        *ln1_g, *ln1_b, *w_router, *w_eg, *w_eu, *w_ed, *ln2_g, *ln2_b;
    float* out; unsigned char* ws;
    int ph_lo, ph_hi;
};


template <class T> __device__ __forceinline__ T* as_global(T* p) { return (T*)(__attribute__((address_space(1))) T*)p; }
__device__ __forceinline__ Params load_params_s() {
    const Params* kp = (const Params*)__builtin_amdgcn_kernarg_segment_ptr(); asm volatile("" : "+s"(kp));
    const __attribute__((address_space(4))) unsigned long long* kc = (const __attribute__((address_space(4))) unsigned long long*)(unsigned long long)kp;
    Params q;
    q.x = (const float*)kc[0]; q.c = (const float*)kc[1]; q.ctx = (const float*)kc[2]; q.c_ctx = (const float*)kc[3]; q.w_ada = (const float*)kc[4]; q.b_ada = (const float*)kc[5]; q.w_in = (const float*)kc[6];
    q.b_gate = (const float*)kc[7]; q.conv_qk = (const float*)kc[8]; q.na_bias = (const float*)kc[9]; q.ml_norm_g = (const float*)kc[10]; q.w_out = (const float*)kc[11];
    q.ln1_g = (const float*)kc[12]; q.ln1_b = (const float*)kc[13]; q.w_router = (const float*)kc[14]; q.w_eg = (const float*)kc[15]; q.w_eu = (const float*)kc[16]; q.w_ed = (const float*)kc[17];
    q.ln2_g = (const float*)kc[18]; q.ln2_b = (const float*)kc[19]; q.out = (float*)kc[20]; q.ws = (unsigned char*)kc[21];
    { const unsigned long long ph = kc[22]; q.ph_lo = (int)(unsigned)ph; q.ph_hi = (int)(unsigned)(ph >> 32); }
    q.x = as_global(q.x); q.c = as_global(q.c); q.ctx = as_global(q.ctx); q.c_ctx = as_global(q.c_ctx); q.w_ada = as_global(q.w_ada); q.b_ada = as_global(q.b_ada); q.w_in = as_global(q.w_in);
    q.b_gate = as_global(q.b_gate); q.conv_qk = as_global(q.conv_qk); q.na_bias = as_global(q.na_bias); q.ml_norm_g = as_global(q.ml_norm_g); q.w_out = as_global(q.w_out);
    q.ln1_g = as_global(q.ln1_g); q.ln1_b = as_global(q.ln1_b); q.w_router = as_global(q.w_router); q.w_eg = as_global(q.w_eg); q.w_eu = as_global(q.w_eu); q.w_ed = as_global(q.w_ed);
    q.ln2_g = as_global(q.ln2_g); q.ln2_b = as_global(q.ln2_b); q.out = as_global(q.out); q.ws = as_global(q.ws);
    return q;
}
__device__ __forceinline__ Params load_params() {
    const Params* kp = (const Params*)__builtin_amdgcn_kernarg_segment_ptr(); asm volatile("" : "+s"(kp));
    Params q = *kp;
    q.x = as_global(q.x); q.c = as_global(q.c); q.ctx = as_global(q.ctx); q.c_ctx = as_global(q.c_ctx); q.w_ada = as_global(q.w_ada); q.b_ada = as_global(q.b_ada); q.w_in = as_global(q.w_in);
    q.b_gate = as_global(q.b_gate); q.conv_qk = as_global(q.conv_qk); q.na_bias = as_global(q.na_bias); q.ml_norm_g = as_global(q.ml_norm_g); q.w_out = as_global(q.w_out);
    q.ln1_g = as_global(q.ln1_g); q.ln1_b = as_global(q.ln1_b); q.w_router = as_global(q.w_router); q.w_eg = as_global(q.w_eg); q.w_eu = as_global(q.w_eu); q.w_ed = as_global(q.w_ed);
    q.ln2_g = as_global(q.ln2_g); q.ln2_b = as_global(q.ln2_b); q.out = as_global(q.out); q.ws = as_global(q.ws);
    return q;
}
__device__ __forceinline__ float bf2f(bf16_t v) { return __uint_as_float((unsigned)v << 16); }
__device__ __forceinline__ unsigned f2bf(float f) { unsigned u = __float_as_uint(f); return (u + 0x7fffu + ((u >> 16) & 1u)) >> 16; }
__device__ __forceinline__ unsigned pk2(float lo, float hi) { return f2bf(lo) | (f2bf(hi) << 16); }
__device__ __forceinline__ float bflo(unsigned w) { return __uint_as_float(w << 16); }
__device__ __forceinline__ float bfhi(unsigned w) { return __uint_as_float(w & 0xffff0000u); }
typedef _Float16 f16x2 __attribute__((ext_vector_type(2)));
typedef float f32x2_ __attribute__((ext_vector_type(2)));
__device__ __forceinline__ unsigned pk_f16(float lo, float hi) {
    const f32x2_ v = {__builtin_amdgcn_fmed3f(lo, -65504.f, 65504.f), __builtin_amdgcn_fmed3f(hi, -65504.f, 65504.f)};
    const f16x2 h = __builtin_convertvector(v, f16x2); return __builtin_bit_cast(unsigned, h); }
__device__ __forceinline__ float hlo(unsigned w) { const f16x2 h = __builtin_bit_cast(f16x2, w); return (float)h.x; }
__device__ __forceinline__ float hhi(unsigned w) { const f16x2 h = __builtin_bit_cast(f16x2, w); return (float)h.y; }
__device__ __forceinline__ float wave_sum(float v) {
#pragma unroll
    for (int o = 1; o < 64; o <<= 1) v += __shfl_xor(v, o);
    return v;
}
__device__ __forceinline__ float wave_max(float v) {
#pragma unroll
    for (int o = 1; o < 64; o <<= 1) v = fmaxf(v, __shfl_xor(v, o));
    return v;
}

__device__ __forceinline__ float wscan_add(float v, int lane) {
#pragma unroll
    for (int o = 1; o < 64; o <<= 1) { const float t = __shfl_up(v, o); if (lane >= o) v += t; }
    return v;
}
__device__ __forceinline__ float wscan_max(float v, int lane) {
#pragma unroll
    for (int o = 1; o < 64; o <<= 1) { const float t = __shfl_up(v, o); if (lane >= o) v = fmaxf(v, t); }
    return v;
}
typedef short bf16x8_t __attribute__((ext_vector_type(8)));
typedef short bf16x4_t __attribute__((ext_vector_type(4)));
typedef float f32x2_t __attribute__((ext_vector_type(2)));
typedef __bf16 bf16x2_t __attribute__((ext_vector_type(2)));
__device__ __forceinline__ unsigned cvtpk(float lo, float hi) { const f32x2_t v = {lo, hi}; const bf16x2_t b = __builtin_convertvector(v, bf16x2_t); return __builtin_bit_cast(unsigned, b); }
__device__ __forceinline__ float siluf(float v) { return v * __builtin_amdgcn_rcpf(1.f + __expf(-v)); }
__device__ __forceinline__ float sigmoidf_(float v) { return __builtin_amdgcn_rcpf(1.f + __expf(-v)); }
__device__ __forceinline__ float logsigf(float v) { return fminf(v, 0.f) - log1pf(__expf(-fabsf(v))); }
__device__ __forceinline__ int ltid() { int t = threadIdx.x; asm volatile("" : "+v"(t)); return t; }
#define FP8EMU 0
__device__ __forceinline__ float q8(float x) { const int p = __builtin_amdgcn_cvt_pk_fp8_f32(x, x, 0, false); return __builtin_amdgcn_cvt_f32_fp8(p, 0); }
__device__ __forceinline__ unsigned pk4_fp8(float a, float b, float c, float d) { int w = __builtin_amdgcn_cvt_pk_fp8_f32(a, b, 0, false); w = __builtin_amdgcn_cvt_pk_fp8_f32(c, d, w, true); return (unsigned)w; }
#define LDS_FENCE() asm volatile("s_waitcnt lgkmcnt(0)" ::: "memory")

__device__ __forceinline__ void ph_ada_item(const Params& p, unsigned char* lds, int item) {
    float* sc = (float*)lds;
    float* red = sc + 9 * 1024;
    const int tid = ltid();
    float* MOD = (float*)(p.ws + WS_MOD);
    for (int i = tid; i < 9 * 1024; i += NTHR) { const int r = i >> 10, k = i & 1023; const float v = r < 8 ? p.c[r * 1024 + k] : p.c_ctx[k]; sc[i] = v / (1.f + expf(-v)); }
    __syncthreads();
    const int col = item * 64 + (tid & 63), ks = tid >> 6;
    float acc[9];
#pragma unroll
    for (int r = 0; r < 9; ++r) acc[r] = 0.f;
    { const GAS float* wa = (const GAS float*)p.w_ada + col;
      for (int k = ks * 128; k < ks * 128 + 128; k += 16) {
          float w[16];
#pragma unroll
          for (int u = 0; u < 16; ++u) w[u] = wa[(size_t)(k + u) * 6144];
#pragma unroll
          for (int u = 0; u < 16; ++u)
#pragma unroll
              for (int r = 0; r < 9; ++r) acc[r] += sc[r * 1024 + k + u] * w[u];
      } }
#pragma unroll
    for (int r = 0; r < 9; ++r) red[(ks * 64 + (tid & 63)) * 9 + r] = acc[r];
    __syncthreads();
    if (tid < 64) {
#pragma unroll
        for (int r = 0; r < 9; ++r) { float s = p.b_ada[col]; for (int k2 = 0; k2 < 8; ++k2) s += red[(k2 * 64 + tid) * 9 + r]; MOD[r * 6144 + col] = s; }
    }
    __syncthreads();
}
__device__ __forceinline__ void transpose_item(const float* W, int N, int k0, int n0, int nvalid, bf16_t* WT, size_t orow0, int ldt, float* scr, int lane) {
#pragma unroll 8
    for (int i = 0; i < 32; ++i) { const int kk = 2 * i + (lane >> 5), nn = lane & 31; scr[kk * 33 + nn] = nn < nvalid ? W[(size_t)(k0 + kk) * N + n0 + nn] : 0.f; }
    LDS_FENCE();
    const int c = lane & 7;
#pragma unroll
    for (int j = 0; j < 4; ++j) {
        const int n = (lane >> 3) + 8 * j; const float* s = scr + (8 * c) * 33 + n;
        u32x4 o; o.x = pk2(s[0 * 33], s[1 * 33]); o.y = pk2(s[2 * 33], s[3 * 33]); o.z = pk2(s[4 * 33], s[5 * 33]); o.w = pk2(s[6 * 33], s[7 * 33]);
        *(u32x4*)(WT + (orow0 + n) * ldt + k0 + 8 * c) = o;
    }
    LDS_FENCE();
}
__device__ __forceinline__ void ph0(const Params& p, unsigned char* lds, int bid, int nblk) {
    __syncthreads();
    for (int it = bid; it < 96; it += nblk) ph_ada_item(p, lds, it);
    const int tid = ltid(), lane = tid & 63, wave = tid >> 6;
    float* scr = (float*)lds + wave * (64 * 33);
    bf16_t* WINT = (bf16_t*)(p.ws + WS_WINT); bf16_t* WOUTT = (bf16_t*)(p.ws + WS_WOUTT);
    const int gw = bid * NWAVES + wave, ngw = nblk * NWAVES;
    constexpr int I_IN = 16 * 97, I_OUT = 16 * 32;
    for (int it = gw; it < I_IN + I_OUT; it += ngw) {
        if (it < I_IN) { const int kb = it / 97, nb = it % 97; const int n0 = nb * 32; const int nv = (DIN - n0) < 32 ? (DIN - n0) : 32; transpose_item(p.w_in, DIN, kb * 64, n0, nv, WINT, (size_t)n0, 1024, scr, lane); }
        else { const int r = it - I_IN; const int kb = r / 32, nb = r % 32; transpose_item(p.w_out, 1024, kb * 64, nb * 32, 32, WOUTT, (size_t)nb * 32, 1024, scr, lane); }
    }
    { float* ROPE = (float*)(p.ws + WS_ROPE); for (int idx = bid * NTHR + tid; idx < 2048; idx += nblk * NTHR) { const int pos = idx >> 4, i = idx & 15;
        const float inv = exp2f(-(float)i * (13.287712379549449f / 16.f)); float sn, cs_; sincosf((float)pos * inv, &sn, &cs_); ROPE[idx * 2] = cs_; ROPE[idx * 2 + 1] = sn; } }
    { const size_t n16 = (size_t)(DINP - 3104) * 1024 * 2 / 16; u32x4* z = (u32x4*)(WINT + (size_t)3104 * 1024);
      for (size_t i = (size_t)bid * NTHR + tid; i < n16; i += (size_t)nblk * NTHR) z[i] = (u32x4){0u, 0u, 0u, 0u}; }
}

__device__ __forceinline__ void ph1(const Params& p, int bid, int nblk) {
    const int tid = ltid(), lane = tid & 63, wave = tid >> 6;
    const GAS float* MOD = (const GAS float*)(p.ws + WS_MOD); GAS bf16_t* XM = (GAS bf16_t*)(p.ws + WS_XM);
    const GAS float* xs = (const GAS float*)p.x; const GAS float* cs = (const GAS float*)p.ctx;
    const int nw = nblk * NWAVES, gw = bid * NWAVES + wave, per = (MROWS + nw - 1) / nw, m_beg = gw * per, m_end = min(m_beg + per, MROWS);
    { const GAS bf16_t* WT = (const GAS bf16_t*)(p.ws + WS_WOUTT); GAS bf16_t* WG = (GAS bf16_t*)(p.ws + WS_WOUTG);
      for (int i = bid * NTHR + tid; i < NB * 1024 * 128; i += nblk * NTHR) { const int b = i >> 17, n = (i >> 7) & 1023, k8 = (i & 127) * 8;
          const float g = MOD[b * 6144 + 2048 + n]; const u32x4 w = *(const GAS u32x4*)(WT + (size_t)n * 1024 + k8); u32x4 o;
          o.x = pk2(g * bflo(w.x), g * bfhi(w.x)); o.y = pk2(g * bflo(w.y), g * bfhi(w.y)); o.z = pk2(g * bflo(w.z), g * bfhi(w.z)); o.w = pk2(g * bflo(w.w), g * bfhi(w.w));
          *(GAS u32x4*)(WG + ((size_t)b * 1024 + n) * 1024 + k8) = o; } }
    int rcur = -1; f32x4 sa[4], sb[4];
    for (int m0 = m_beg; m0 < m_end; m0 += 4) {
        f32x4 v[4][4]; int rr_[4];
#pragma unroll
        for (int i = 0; i < 4; ++i) { const int m = min(m0 + i, m_end - 1); rr_[i] = m < NLAT ? (m >> 13) : 8;
            const GAS float* src = m < NLAT ? xs + (size_t)m * 1024 : cs + (size_t)(m - NLAT) * 1024;
#pragma unroll
            for (int j = 0; j < 4; ++j) v[i][j] = __builtin_nontemporal_load((const GAS f32x4*)(src + j * 256 + lane * 4)); }
#pragma unroll
        for (int i = 0; i < 4; ++i) { if (m0 + i < m_end) {
            if (rr_[i] != rcur) { rcur = rr_[i];
#pragma unroll
                for (int j = 0; j < 4; ++j) { sb[j] = *(const GAS f32x4*)(MOD + rcur * 6144 + j * 256 + lane * 4); sa[j] = *(const GAS f32x4*)(MOD + rcur * 6144 + 1024 + j * 256 + lane * 4) + 1.f; } }
#pragma unroll
            for (int j = 0; j < 4; ++j) { const f32x4 r = v[i][j] * sa[j] + sb[j]; u32x2 o; o.x = pk2(r.x, r.y); o.y = pk2(r.z, r.w);
                *(GAS u32x2*)(XM + (size_t)(m0 + i) * 1024 + j * 256 + lane * 4) = o; } } }
    }
}


#define LAS __attribute__((address_space(3)))
typedef short bf16x8 __attribute__((ext_vector_type(8)));
typedef int i32x8 __attribute__((ext_vector_type(8)));
constexpr float NA_C2 = 0.125f * 1.4426950408889634f;
namespace pg8 {
constexpr int BM = 256, BK = 64, HALF = 128, HTB = HALF * BK * 2, STAGE_BYTES = 8 * HTB, NXCD = 8, WGM = 8;
constexpr int TAB_OFF = STAGE_BYTES;
__device__ __forceinline__ int lds_byte(int r, int c) { const int st = (r >> 4) * 2 + (c >> 5), rr = r & 15, cc = c & 31, ob = rr * 64 + cc * 2; return st * 1024 + (ob ^ (((ob >> 9) & 1) << 5)); }
__device__ __forceinline__ void stage_rc(int b, int& R, int& C) { const int st = b / 1024, sb = b % 1024, swz = sb ^ (((sb >> 9) & 1) << 5); R = (st >> 1) * 16 + swz / 64; C = (st & 1) * 32 + (swz % 64) / 2; }
__device__ __forceinline__ int perm32(int rho) { const int n = rho >> 4, i = rho & 15; return 8 * (i >> 2) + 4 * n + (i & 3); }
struct Unit { int pm, pn; };
struct StaticOrder {
    int nM, nN, nwg, G, c;
    __device__ void init(int nM_, int nN_, int G_, int c_) { nM = nM_; nN = nN_; nwg = nM * nN; G = G_; c = c_; }
    __device__ bool next(int i, Unit& u) const {
        const long L = (long)i * G + c; if (L >= nwg) return false;
        int wgid = (int)L; { const int q = nwg / NXCD, r = nwg % NXCD, xcd = wgid % NXCD, off = wgid / NXCD; wgid = (xcd < r ? xcd * (q + 1) : r * (q + 1) + (xcd - r) * q) + off; }
        const int nig = WGM * nN, gid = wgid / nig, fm = gid * WGM, gsz = (nM - fm) < WGM ? (nM - fm) : WGM;
        u.pm = fm + ((wgid % nig) % gsz); u.pn = (wgid % nig) / gsz; return true;
    }
};
__device__ __forceinline__ unsigned cvt_pk_bf16(float lo, float hi) { return cvtpk(lo, hi); }
struct GemmDesc { const void* A; const void* Bt; const int* IDX; void* O; const float* x; const float* MOD; size_t bEstride  ; int Kb  , egrp0, nM, nN, epi, ldc, qtiles  ; };

__device__ __forceinline__ void epilogue(const GemmDesc& g, const f32x4 (&acc)[2][2][4][2], const Unit& u, int wr, int wc, int fr, int fq) {
    if (g.epi == 0 || g.epi == 3) {
        const float sc = g.epi == 3 ? (1.f / 64.f) : (u.pn < g.qtiles ? NA_C2 : 1.f);
        GAS bf16_t* O = (GAS bf16_t*)g.O; const int row0 = u.pm * BM + wr * 64 + fr, col0 = u.pn * BM + wc * 32 + 8 * fq;
#pragma unroll
        for (int ai = 0; ai < 2; ++ai)
#pragma unroll
            for (int m = 0; m < 4; ++m) { GAS bf16_t* rowp = O + (size_t)(row0 + ai * HALF + m * 16) * g.ldc + col0;
#pragma unroll
                for (int bj = 0; bj < 2; ++bj) { const f32x4 v0 = acc[ai][bj][m][0] * sc, v1 = acc[ai][bj][m][1] * sc;
                    u32x4 w; w.x = cvt_pk_bf16(v0[0], v0[1]); w.y = cvt_pk_bf16(v0[2], v0[3]); w.z = cvt_pk_bf16(v1[0], v1[1]); w.w = cvt_pk_bf16(v1[2], v1[3]);
                    *(GAS u32x4*)(rowp + bj * HALF) = w; } }
    } else if (g.epi == 1) {
        GAS unsigned char* O = (GAS unsigned char*)g.O; const int row0 = u.pm * BM + wr * 64 + fr, col0 = u.pn * HALF + wc * 32 + 8 * fq;
#pragma unroll
        for (int ai = 0; ai < 2; ++ai)
#pragma unroll
            for (int m = 0; m < 4; ++m) { GAS unsigned char* rowp = O + (size_t)(row0 + ai * HALF + m * 16) * DFF + col0;
                float r[8];
#pragma unroll
                for (int n = 0; n < 2; ++n)
#pragma unroll
                    for (int jp = 0; jp < 2; ++jp) { const f32x2_ gg = {acc[ai][0][m][n][2 * jp], acc[ai][0][m][n][2 * jp + 1]}, uu = {acc[ai][1][m][n][2 * jp], acc[ai][1][m][n][2 * jp + 1]};
                        const f32x2_ a = gg * (-(1.f / 32.f) * 1.4426950408889634f); f32x2_ e = {__builtin_amdgcn_exp2f(a.x), __builtin_amdgcn_exp2f(a.y)};
                        e = e * 1024.f + 1024.f; const f32x2_ rc = {__builtin_amdgcn_rcpf(e.x), __builtin_amdgcn_rcpf(e.y)}; const f32x2_ rr = (gg * uu) * rc;
                        r[n * 4 + 2 * jp] = rr.x; r[n * 4 + 2 * jp + 1] = rr.y; }
                u32x2 w; w.x = pk4_fp8(r[0], r[1], r[2], r[3]); w.y = pk4_fp8(r[4], r[5], r[6], r[7]);
                *(GAS u32x2*)rowp = w; }
    } else {
        GAS bf16_t* Yo = (GAS bf16_t*)g.O; const int row0 = u.pm * BM + wr * 64 + fr, col0 = u.pn * BM + wc * 32 + 8 * fq;
#pragma unroll
        for (int ai = 0; ai < 2; ++ai)
#pragma unroll
            for (int m = 0; m < 4; ++m) { GAS bf16_t* rowp = Yo + (size_t)(row0 + ai * HALF + m * 16) * 1024 + col0;
#pragma unroll
                for (int bj = 0; bj < 2; ++bj) { const f32x4 y0 = acc[ai][bj][m][0], y1 = acc[ai][bj][m][1];
                    u32x4 w; w.x = pk_f16(y0[0], y0[1]); w.y = pk_f16(y0[2], y0[3]); w.z = pk_f16(y1[0], y1[1]); w.w = pk_f16(y1[2], y1[3]);
                    *(GAS u32x4*)(rowp + bj * HALF) = w; } }
    }
}

template <bool MAYGATHER, bool FP8>
__device__ __forceinline__ void gemm_phase(LAS unsigned char* lds, const GemmDesc g, int G, int c) {
    const int tid = ltid(), wid = __builtin_amdgcn_readfirstlane(tid >> 6), lane = tid & 63, wr = wid >> 2, wc = wid & 3, fr = lane & 15, fq = lane >> 4;
    const int Kb = g.Kb, nt = Kb / (BK * 2);
    const bool perm = true, gather = MAYGATHER && g.IDX != nullptr;
    StaticOrder S; S.init(g.nM, g.nN, G, c);
    unsigned voffB[2];
#pragma unroll
    for (int i = 0; i < 2; ++i) { int R, C; stage_rc(tid * 16 + i * 8192, R, C); const int Rb = perm ? ((R & ~31) + perm32(R & 31)) : R; voffB[i] = (unsigned)(Rb * Kb + C * 2); }
    const size_t kstep = (size_t)(BK * 2), hstep = (size_t)HALF * Kb, tstep = 2 * hstep;
    const unsigned ldsw = (unsigned)wid * 1024u;
    const int aoff = lds_byte(wr * 64 + fr, fq * 8), boff = lds_byte(wc * 32 + fr, fq * 8);
    LAS int* tab = (LAS int*)(lds + TAB_OFF);
#define PG8_SA(b, h) (((b) * 2 + (h)) * HTB)
#define PG8_SB(b, h) ((4 + (b) * 2 + (h)) * HTB)
#define PG8_UNI(p_) ({ const unsigned long long _v = (unsigned long long)(p_); (const GAS char*)(((unsigned long long)(unsigned)__builtin_amdgcn_readfirstlane((int)(_v >> 32)) << 32) | (unsigned)__builtin_amdgcn_readfirstlane((int)_v)); })
#define PG8_GLDS(gptr, ldsoff) __builtin_amdgcn_global_load_lds((const GAS unsigned*)(gptr), (LAS unsigned*)(lds + (ldsoff)), 16, 0, 0)
#define PG8_STAGE_B(bufoff, gbase) do { const GAS char* _gb = (const GAS char*)(gbase); _Pragma("unroll") for (int _i = 0; _i < 2; ++_i) { asm volatile("" : "+v"(voffB[_i])); PG8_GLDS(_gb + voffB[_i], (bufoff) + ldsw + _i * 8192); } } while (0)
#define PG8_STAGE_A(bufoff, kt, v0_, v1_) do { const GAS char* _b = (const GAS char*)g.A + (size_t)(kt) * kstep; asm volatile("" : "+v"(v0_), "+v"(v1_)); PG8_GLDS(_b + (v0_), (bufoff) + ldsw); PG8_GLDS(_b + (v1_), (bufoff) + ldsw + 8192); } while (0)
#define PG8_LDA(dst, b, h) do { _Pragma("unroll") for (int m = 0; m < 4; ++m) _Pragma("unroll") for (int k = 0; k < 2; ++k) dst[m][k] = *(const LAS bf16x8*)(lds + PG8_SA(b, h) + aoff + m * 2048 + k * 1024); } while (0)
#define PG8_LDB(dst, b, h) do { _Pragma("unroll") for (int n = 0; n < 2; ++n) _Pragma("unroll") for (int k = 0; k < 2; ++k) dst[n][k] = *(const LAS bf16x8*)(lds + PG8_SB(b, h) + boff + n * 2048 + k * 1024); } while (0)
#define PG8_MMA(ai, bj, At, Bt) do { __builtin_amdgcn_s_setprio(1); \
        if constexpr (FP8) { _Pragma("unroll") for (int m = 0; m < 4; ++m) _Pragma("unroll") for (int n = 0; n < 2; ++n) { \
            const bf16x8 _b0 = Bt[n][0], _b1 = Bt[n][1], _a0 = At[m][0], _a1 = At[m][1]; \
            const i32x8 _bw = __builtin_bit_cast(i32x8, __builtin_shufflevector(_b0, _b1, 0, 1, 2, 3, 4, 5, 6, 7, 8, 9, 10, 11, 12, 13, 14, 15)); \
            const i32x8 _aw = __builtin_bit_cast(i32x8, __builtin_shufflevector(_a0, _a1, 0, 1, 2, 3, 4, 5, 6, 7, 8, 9, 10, 11, 12, 13, 14, 15)); \
            acc[ai][bj][m][n] = __builtin_amdgcn_mfma_scale_f32_16x16x128_f8f6f4(_bw, _aw, acc[ai][bj][m][n], 0, 0, 0, 0x7f7f7f7f, 0, 0x7f7f7f7f); } } \
        else { _Pragma("unroll") for (int m = 0; m < 4; ++m) _Pragma("unroll") for (int n = 0; n < 2; ++n) _Pragma("unroll") for (int k = 0; k < 2; ++k) \
            acc[ai][bj][m][n] = __builtin_amdgcn_mfma_f32_16x16x32_bf16(Bt[n][k], At[m][k], acc[ai][bj][m][n], 0, 0, 0); } \
        __builtin_amdgcn_s_setprio(0); } while (0)
#define PG8_WAIT_V(n) asm volatile("s_waitcnt vmcnt(" #n ")" ::: "memory")
#define PG8_WAIT_L(n) asm volatile("s_waitcnt lgkmcnt(" #n ")" ::: "memory")
#define PG8_BAR __builtin_amdgcn_s_barrier()
#define PG8_SCHED __builtin_amdgcn_sched_barrier(0)
#define PG8_TAB_FILL(u, s) do { if (wid < 4) { const int _e = g.egrp0 + ((u).pm >> 5), _m0 = ((u).pm & 31) * 256, _b = _m0 >> 10, _s0 = _m0 & 1023; \
        __builtin_amdgcn_global_load_lds((const unsigned*)(g.IDX + (_e * 8 + _b) * CAP + _s0 + wid * 64 + lane), (LAS unsigned*)(lds + TAB_OFF + (s) * 1024 + wid * 256), 4, 0, 0); } } while (0)
#define PG8_ROWS(u, s, v) do { int _t = tid; asm volatile("" : "+v"(_t)); _Pragma("unroll") for (int _i = 0; _i < 2; ++_i) { int _R, _C; stage_rc(_t * 16 + _i * 8192, _R, _C); \
        _Pragma("unroll") for (int _h = 0; _h < 2; ++_h) { \
            if (gather) { const int _b = (((u).pm & 31) * 256) >> 10; const int _ix = tab[(s) * 256 + _h * 128 + _R]; v[_h][_i] = (unsigned)((_b * 8192 + _ix) * Kb + _C * 2); } \
            else v[_h][_i] = (unsigned)(((u).pm * 256 + _h * 128 + _R) * Kb + _C * 2); } } } while (0)
    Unit cur, nxt; int ui = 0;
    if (!S.next(0, cur)) return;
    cur.pm = __builtin_amdgcn_readfirstlane(cur.pm); cur.pn = __builtin_amdgcn_readfirstlane(cur.pn);
    f32x4 acc[2][2][4][2];
#define PG8_ACC_INIT(u) do { if (g.epi == 2) { const GAS float* _x = (const GAS float*)g.x + (size_t)((u).pm * BM + wr * 64 + fr) * 1024 + (u).pn * BM + wc * 32 + 8 * fq; \
        _Pragma("unroll") for (int a = 0; a < 2; ++a) _Pragma("unroll") for (int m = 0; m < 4; ++m) _Pragma("unroll") for (int b = 0; b < 2; ++b) _Pragma("unroll") for (int n = 0; n < 2; ++n) \
            acc[a][b][m][n] = *(const GAS f32x4*)(_x + (size_t)(a * HALF + m * 16) * 1024 + b * HALF + n * 4); \
        _Pragma("unroll") for (int a = 0; a < 2; ++a) _Pragma("unroll") for (int m = 0; m < 4; ++m) _Pragma("unroll") for (int b = 0; b < 2; ++b) _Pragma("unroll") for (int n = 0; n < 2; ++n) \
            acc[a][b][m][n] = acc[a][b][m][n] * ALPHA; } \
      else { float z = 0.f; asm volatile("" : "+v"(z));                   \
        _Pragma("unroll") for (int a = 0; a < 2; ++a) _Pragma("unroll") for (int b = 0; b < 2; ++b) _Pragma("unroll") for (int m = 0; m < 4; ++m) _Pragma("unroll") for (int n = 0; n < 2; ++n) \
            acc[a][b][m][n] = (f32x4){z, z, z, z}; } } while (0)
    PG8_ACC_INIT(cur);
    bf16x8 At[4][2], B0[2][2], B1[2][2];
    unsigned vc[2][2];
    const char* cB = (const char*)g.Bt + (size_t)(g.egrp0 + (cur.pm >> 5)) * g.bEstride + (size_t)cur.pn * tstep;
    const char* nB = cB;
    if (gather) { PG8_TAB_FILL(cur, 0); PG8_WAIT_V(0); PG8_BAR; }
    PG8_ROWS(cur, 0, vc);
    PG8_STAGE_B(PG8_SB(0, 0), cB); PG8_STAGE_B(PG8_SB(0, 1), cB + hstep); PG8_STAGE_A(PG8_SA(0, 0), 0, vc[0][0], vc[0][1]); PG8_STAGE_A(PG8_SA(0, 1), 0, vc[1][0], vc[1][1]);
    if (wr == 1) PG8_BAR;
    PG8_WAIT_V(2); PG8_BAR;
    PG8_STAGE_B(PG8_SB(1, 0), cB + kstep); PG8_STAGE_A(PG8_SA(1, 0), 1, vc[0][0], vc[0][1]); PG8_STAGE_B(PG8_SB(1, 1), cB + hstep + kstep);
    PG8_WAIT_V(6); PG8_BAR;
    for (;;) {
        const bool has_next = S.next(ui + 1, nxt);
        nxt.pm = __builtin_amdgcn_readfirstlane(nxt.pm); nxt.pn = __builtin_amdgcn_readfirstlane(nxt.pn);
        if (has_next) nB = (const char*)g.Bt + (size_t)(g.egrp0 + (nxt.pm >> 5)) * g.bEstride + (size_t)nxt.pn * tstep; else nB = cB;
        if (gather && has_next) PG8_TAB_FILL(nxt, (ui + 1) & 1);
        for (int t = 0; t < nt; t += 2) {
            const bool last = (t == nt - 2);
            const int k2 = last ? 0 : t + 2, k3 = k2 + 1;
            const char* b2 = last ? nB : cB + (size_t)(t + 2) * kstep; const char* b3 = b2 + kstep;
            PG8_LDB(B0, 0, 0); PG8_LDB(B1, 0, 1); PG8_SCHED; PG8_LDA(At, 0, 0); PG8_STAGE_A(PG8_SA(1, 1), t + 1, vc[1][0], vc[1][1]);
            if (last && has_next) PG8_ROWS(nxt, (ui + 1) & 1, vc);
            PG8_WAIT_V(8); PG8_WAIT_L(0); PG8_BAR; PG8_MMA(0, 0, At, B0); PG8_MMA(0, 1, At, B1); PG8_BAR; PG8_SCHED;
            PG8_LDA(At, 0, 1); PG8_STAGE_B(PG8_SB(0, 0), b2); PG8_STAGE_B(PG8_SB(0, 1), b2 + hstep); PG8_STAGE_A(PG8_SA(0, 0), k2, vc[0][0], vc[0][1]);
            PG8_WAIT_V(8); PG8_WAIT_L(0); PG8_BAR; PG8_MMA(1, 0, At, B0); PG8_MMA(1, 1, At, B1); PG8_BAR; PG8_SCHED;
            PG8_LDB(B0, 1, 0); PG8_LDB(B1, 1, 1); PG8_SCHED; PG8_LDA(At, 1, 0); PG8_STAGE_A(PG8_SA(0, 1), k2, vc[1][0], vc[1][1]);
            PG8_WAIT_V(8); PG8_WAIT_L(0); PG8_BAR; PG8_MMA(0, 0, At, B0); PG8_MMA(0, 1, At, B1); PG8_BAR; PG8_SCHED;
            PG8_LDA(At, 1, 1); PG8_STAGE_B(PG8_SB(1, 0), b3); PG8_STAGE_B(PG8_SB(1, 1), b3 + hstep); PG8_STAGE_A(PG8_SA(1, 0), k3, vc[0][0], vc[0][1]);
            PG8_WAIT_V(8); PG8_WAIT_L(0); PG8_BAR; PG8_MMA(1, 0, At, B0); PG8_MMA(1, 1, At, B1); PG8_BAR; PG8_SCHED;
        }
        if (wr == 0) PG8_BAR;
        epilogue(g, acc, cur, wr, wc, fr, fq);
        if (!has_next) break;
        cur = nxt; cB = nB; ++ui;
        PG8_ACC_INIT(cur);
        if (wr == 1) PG8_BAR;
    }
    PG8_WAIT_V(0);
    PG8_BAR;
#undef PG8_SA
#undef PG8_SB
#undef PG8_GLDS
#undef PG8_STAGE_A
#undef PG8_STAGE_B
#undef PG8_LDA
#undef PG8_LDB
#undef PG8_MMA
#undef PG8_WAIT_V
#undef PG8_WAIT_L
#undef PG8_BAR
#undef PG8_ACC_INIT
#undef PG8_SCHED
#undef PG8_TAB_FILL
#undef PG8_ROWS
}
}


constexpr int NA_SLOTS = 9, NA_SLOT_EL = 64 * 72;
__device__ __forceinline__ int vtl_off(int d, int key) { return d * 72 + key; }
__device__ __forceinline__ int vtc_off(int d, int key) { return d * 264 + key; }
__device__ __forceinline__ void na_item(const Params& p, unsigned char* lds, int item) {
    const GAS bf16_t* U = (const GAS bf16_t*)(p.ws + WS_U); GAS bf16_t* MIX = (GAS bf16_t*)(p.ws + WS_MIX);
    const int tid = ltid(), lane = tid & 63, wave = __builtin_amdgcn_readfirstlane(tid >> 6), fr = lane & 15, fq = lane >> 4;
    const int seg = item & 3, bh = item >> 2, h = bh & 7, b = bh >> 3;
    bf16_t* VTL = (bf16_t*)lds;
    bf16_t* VTC = VTL + NA_SLOTS * NA_SLOT_EL;
    bf16_t* KC = VTC + 64 * 264;
    float* BIAS = (float*)(KC + 256 * 72);
    const size_t lat0 = (size_t)b * 8192, ctx0 = (size_t)NLAT + b * 256;
    const GAS bf16_t* Uv = U + C_VA + h * 64 + wave * 8;
#pragma unroll
    for (int i = 0; i < 2; ++i) { const int kp = lane + 64 * i;
        const u32x4 w0 = *(const GAS u32x4*)(Uv + (ctx0 + 2 * kp) * DINP), w1 = *(const GAS u32x4*)(Uv + (ctx0 + 2 * kp + 1) * DINP);
        const unsigned ws_[8] = {(w0.x & 0xffffu) | (w1.x << 16), (w0.x >> 16) | (w1.x & 0xffff0000u), (w0.y & 0xffffu) | (w1.y << 16), (w0.y >> 16) | (w1.y & 0xffff0000u),
                                 (w0.z & 0xffffu) | (w1.z << 16), (w0.z >> 16) | (w1.z & 0xffff0000u), (w0.w & 0xffffu) | (w1.w << 16), (w0.w >> 16) | (w1.w & 0xffff0000u)};
#pragma unroll
        for (int e = 0; e < 8; ++e) *(unsigned*)(VTC + vtc_off(wave * 8 + e, 2 * kp)) = ws_[e]; }
    for (int idx = tid; idx < 256 * 8; idx += NTHR) { const int key = idx >> 3, ck = idx & 7;
        *(u32x4*)(KC + key * 72 + ck * 8) = *(const GAS u32x4*)(U + (ctx0 + key) * DINP + C_KA + h * 64 + ck * 8); }
    if (tid < 512) BIAS[tid] = tid < 465 ? p.na_bias[h * 465 + tid] * 1.4426950408889634f : 0.f;
    const int cg = wave & 3, rr = wave >> 2, c0 = 16 * cg, kb = cg == 0 ? 0 : (cg == 1 ? 8 : (cg == 2 ? 24 : 32));
    const int c = c0 + fr, cs = min(max(c - 8, 0), 48);
    const int r00 = 32 * seg;
#define NA_VFILL(kra_, w0_, w1_) do { const unsigned ws_[8] = {(w0_.x & 0xffffu) | (w1_.x << 16), (w0_.x >> 16) | (w1_.x & 0xffff0000u), (w0_.y & 0xffffu) | (w1_.y << 16), (w0_.y >> 16) | (w1_.y & 0xffff0000u), \
            (w0_.z & 0xffffu) | (w1_.z << 16), (w0_.z >> 16) | (w1_.z & 0xffff0000u), (w0_.w & 0xffffu) | (w1_.w << 16), (w0_.w >> 16) | (w1_.w & 0xffff0000u)}; \
        bf16_t* sl_ = VTL + ((kra_) % NA_SLOTS) * NA_SLOT_EL; _Pragma("unroll") for (int e_ = 0; e_ < 8; ++e_) *(unsigned*)(sl_ + vtl_off(wave * 8 + e_, 2 * (lane & 31))) = ws_[e_]; } while (0)
    { const int lo = min(max(r00 - 4, 0), 120), hi = min(max(r00 + 1 - 4, 0), 120) + 7;
      for (int kra = lo + (lane >> 5); kra <= hi; kra += 2) { const size_t k0 = lat0 + kra * 64 + 2 * (lane & 31);
          const u32x4 w0 = *(const GAS u32x4*)(Uv + k0 * DINP), w1 = *(const GAS u32x4*)(Uv + (k0 + 1) * DINP);
          NA_VFILL(kra, w0, w1); } }
#define NA_LOADK(kf_, ch, rw_) do { const int rs_ = min(max((rw_) - 4, 0), 120); unsigned koff_ = koff; asm volatile("" : "+v"(koff_));     \
        _Pragma("unroll") for (int t_ = 0; t_ < 4; ++t_) { \
        const size_t krow_ = lat0 + (rs_ + 2 * (ch) + (t_ >> 1)) * 64 + kb + 16 * (t_ & 1); \
        const GAS char* bp_ = Ub + krow_ * (DINP * 2); \
        kf_[2 * t_] = *(const GAS bf16x8_t*)(bp_ + koff_); kf_[2 * t_ + 1] = *(const GAS bf16x8_t*)(bp_ + koff_ + 64); } } while (0)
    const GAS char* Ub = (const GAS char*)U;
    const unsigned koff = (unsigned)((fr * DINP + C_KA + h * 64 + 8 * fq) * 2);
    bf16x8_t kfa[8], kfb[8], qf[2];
    { const int rw0 = r00 + rr; const size_t qrow = lat0 + rw0 * 64 + c0 + fr;
      qf[0] = *(const GAS bf16x8_t*)(U + qrow * DINP + C_QA + h * 64 + 8 * fq); qf[1] = *(const GAS bf16x8_t*)(U + qrow * DINP + C_QA + h * 64 + 32 + 8 * fq);
      NA_LOADK(kfa, 0, rw0); NA_LOADK(kfb, 1, rw0); }
    __syncthreads();
#pragma unroll 1
    for (int step = 0; step < 16; ++step) {
        const int r = r00 + 2 * step, rw = r + rr, rsw = min(max(rw - 4, 0), 120);
        const int nhi_cur = min(max(r + 1 - 4, 0), 120) + 7, nhi_nxt = min(max(r + 3 - 4, 0), 120) + 7;
        const int vkra = nhi_cur + 1 + (lane >> 5); const bool vld = step < 15 && vkra <= nhi_nxt;
        u32x4 vw0 = (u32x4){0u, 0u, 0u, 0u}, vw1 = (u32x4){0u, 0u, 0u, 0u};
        float m_run = -INFINITY, l_run = 0.f;
        f32x4 o[4];
#pragma unroll
        for (int db = 0; db < 4; ++db) o[db] = (f32x4){0.f, 0.f, 0.f, 0.f};
#pragma unroll
        for (int ch = 0; ch < 8; ++ch) {
            f32x4 sc[4];
            if (ch < 4) {
#pragma unroll
                for (int t = 0; t < 4; ++t) { f32x4 a = (f32x4){0.f, 0.f, 0.f, 0.f};
                    if (ch & 1) { a = __builtin_amdgcn_mfma_f32_16x16x32_bf16(kfb[2 * t], qf[0], a, 0, 0, 0); a = __builtin_amdgcn_mfma_f32_16x16x32_bf16(kfb[2 * t + 1], qf[1], a, 0, 0, 0); }
                    else { a = __builtin_amdgcn_mfma_f32_16x16x32_bf16(kfa[2 * t], qf[0], a, 0, 0, 0); a = __builtin_amdgcn_mfma_f32_16x16x32_bf16(kfa[2 * t + 1], qf[1], a, 0, 0, 0); }
                    sc[t] = a; }
                __builtin_amdgcn_sched_barrier(0);
                if (ch < 2) { if (ch & 1) { NA_LOADK(kfb, ch + 2, rw); } else { NA_LOADK(kfa, ch + 2, rw); } }
                else if (step < 15) { if (ch & 1) { NA_LOADK(kfb, 1, rw + 2); } else { NA_LOADK(kfa, 0, rw + 2); } }
            } else {
#pragma unroll
                for (int t = 0; t < 4; ++t) { const bf16_t* kp = KC + (64 * (ch - 4) + 16 * t + fr) * 72 + 8 * fq;
                    const bf16x8_t k0 = *(const bf16x8_t*)kp, k1 = *(const bf16x8_t*)(kp + 32);
                    f32x4 a = (f32x4){0.f, 0.f, 0.f, 0.f};
                    a = __builtin_amdgcn_mfma_f32_16x16x32_bf16(k0, qf[0], a, 0, 0, 0); a = __builtin_amdgcn_mfma_f32_16x16x32_bf16(k1, qf[1], a, 0, 0, 0); sc[t] = a; }
                __builtin_amdgcn_sched_barrier(0);
                if (ch == 7 && step < 15) { const size_t qrow = lat0 + (rw + 2) * 64 + c0 + fr;
                    qf[0] = *(const GAS bf16x8_t*)(U + qrow * DINP + C_QA + h * 64 + 8 * fq); qf[1] = *(const GAS bf16x8_t*)(U + qrow * DINP + C_QA + h * 64 + 32 + 8 * fq); }
                if (ch == 4 && vld) { const size_t k0 = lat0 + vkra * 64 + 2 * (lane & 31); vw0 = *(const GAS u32x4*)(Uv + k0 * DINP); vw1 = *(const GAS u32x4*)(Uv + (k0 + 1) * DINP); }
            }
            u32x2 vfr[2][4][2];
#pragma unroll
            for (int t = 0; t < 2; ++t)
#pragma unroll
                for (int db = 0; db < 4; ++db) {
                    if (ch < 4) { const bf16_t* sl = VTL + ((rsw + 2 * ch + t) % NA_SLOTS) * NA_SLOT_EL;
                        vfr[t][db][0] = *(const u32x2*)(sl + vtl_off(db * 16 + fr, kb + 4 * fq)); vfr[t][db][1] = *(const u32x2*)(sl + vtl_off(db * 16 + fr, kb + 16 + 4 * fq)); }
                    else { vfr[t][db][0] = *(const u32x2*)(VTC + vtc_off(db * 16 + fr, 64 * (ch - 4) + 32 * t + 4 * fq)); vfr[t][db][1] = *(const u32x2*)(VTC + vtc_off(db * 16 + fr, 64 * (ch - 4) + 32 * t + 16 + 4 * fq)); }
                }
            float bv[4][4];
            if (ch < 4) {
#pragma unroll
                for (int t = 0; t < 4; ++t) { const int kr = 2 * ch + (t >> 1), cb = t & 1;
                    const float* brow = BIAS + (rsw + kr - rw + 7) * 31;
#pragma unroll
                    for (int j = 0; j < 4; ++j) bv[t][j] = brow[kb + 16 * cb + 4 * fq + j - c + 15]; }
                asm volatile("" : "+v"(bv[0][0]), "+v"(bv[0][1]), "+v"(bv[0][2]), "+v"(bv[0][3]), "+v"(bv[1][0]), "+v"(bv[1][1]), "+v"(bv[1][2]), "+v"(bv[1][3]),
                                  "+v"(bv[2][0]), "+v"(bv[2][1]), "+v"(bv[2][2]), "+v"(bv[2][3]), "+v"(bv[3][0]), "+v"(bv[3][1]), "+v"(bv[3][2]), "+v"(bv[3][3]));
            }
            __builtin_amdgcn_sched_barrier(0);
            if (ch < 4) {
#pragma unroll
                for (int t = 0; t < 4; ++t) { const int cb = t & 1;
#pragma unroll
                    for (int j = 0; j < 4; ++j) { const int col = kb + 16 * cb + 4 * fq + j; const bool valid = (col >= cs) && (col < cs + 16);
                        sc[t][j] = valid ? sc[t][j] + bv[t][j] : -INFINITY; } }
            }
            float cm = -INFINITY;
#pragma unroll
            for (int t = 0; t < 4; ++t) cm = fmaxf(cm, fmaxf(fmaxf(sc[t][0], sc[t][1]), fmaxf(sc[t][2], sc[t][3])));
            if (__any(cm > m_run + 11.5f)) {
                cm = fmaxf(cm, __shfl_xor(cm, 16)); cm = fmaxf(cm, __shfl_xor(cm, 32));
                const float m_new = fmaxf(m_run, cm), alpha = __builtin_amdgcn_exp2f(m_run - m_new);
                m_run = m_new; l_run *= alpha;
#pragma unroll
                for (int j = 0; j < 4; ++j) { const float aj = __shfl(alpha, 4 * fq + j);
#pragma unroll
                    for (int db = 0; db < 4; ++db) o[db][j] *= aj; }
            }
            const float m_new = m_run;
            float psum = 0.f;
            u32x4 pw[2];
#pragma unroll
            for (int t = 0; t < 2; ++t) {
                f32x4 e0, e1;
#pragma unroll
                for (int j = 0; j < 4; ++j) { e0[j] = __builtin_amdgcn_exp2f(sc[2 * t][j] - m_new); e1[j] = __builtin_amdgcn_exp2f(sc[2 * t + 1][j] - m_new); }
                psum += (e0[0] + e0[1]) + (e0[2] + e0[3]) + (e1[0] + e1[1]) + (e1[2] + e1[3]);
                pw[t].x = cvtpk(e0[0], e0[1]); pw[t].y = cvtpk(e0[2], e0[3]); pw[t].z = cvtpk(e1[0], e1[1]); pw[t].w = cvtpk(e1[2], e1[3]);
            }
            l_run += psum;
#pragma unroll
            for (int t = 0; t < 2; ++t)
#pragma unroll
                for (int db = 0; db < 4; ++db) { const u32x4 vw = (u32x4){vfr[t][db][0].x, vfr[t][db][0].y, vfr[t][db][1].x, vfr[t][db][1].y};
                    o[db] = __builtin_amdgcn_mfma_f32_16x16x32_bf16(__builtin_bit_cast(bf16x8_t, pw[t]), __builtin_bit_cast(bf16x8_t, vw), o[db], 0, 0, 0); }
            __builtin_amdgcn_sched_barrier(0);
        }
        float lsum = l_run; lsum += __shfl_xor(lsum, 16); lsum += __shfl_xor(lsum, 32);
        const float rinv = 1.f / lsum;
#pragma unroll
        for (int j = 0; j < 4; ++j) { const float rj = __shfl(rinv, 4 * fq + j);
            GAS bf16_t* orow = MIX + (lat0 + rw * 64 + c0 + 4 * fq + j) * 1024 + h * 64 + fr;
#pragma unroll
            for (int db = 0; db < 4; ++db) orow[db * 16] = (bf16_t)f2bf(o[db][j] * rj); }
        __syncthreads();
        if (vld) NA_VFILL(vkra, vw0, vw1);
        __syncthreads();
    }
#undef NA_LOADK
#undef NA_VFILL
}

__device__ __forceinline__ float rope_elem(const float* xr, int d, int t, const GAS float* ROPE) {
    const int half = d >> 5, dd = d & 31, i = dd & 15;
    const int pos = half == 0 ? (t >> 6) : (t & 63);
    const float cs_ = ROPE[(pos * 16 + i) * 2], sn = ROPE[(pos * 16 + i) * 2 + 1];
    const float x1 = xr[half * 32 + i], x2 = xr[half * 32 + 16 + i];
    return dd < 16 ? x1 * cs_ - x2 * sn : x1 * sn + x2 * cs_;
}

struct StPre { u32x4 raw[5]; u32x4 v[4]; };
__device__ __forceinline__ void ml_stats_prefetch(const Params& p, int item, int tid, StPre& r) {
    const GAS bf16_t* U = (const GAS bf16_t*)(p.ws + WS_U);
    const int ch = item % NCH, bh = item / NCH, h = bh & 3, b = bh >> 2;
    const bool is_ctx = ch >= 64; const int Tseq = is_ctx ? 256 : 8192, t0 = (is_ctx ? ch - 64 : ch) * 128;
    const size_t rowbase = is_ctx ? (size_t)NLAT + b * 256 : (size_t)b * 8192;
#pragma unroll
    for (int i = 0; i < 5; ++i) { const int idx = tid + i * NTHR, tt = idx >> 4, ck = idx & 15, t = t0 - 2 + tt;
        u32x4 w = (u32x4){0u, 0u, 0u, 0u};
        if (idx < 132 * 16 && t >= 0 && t < Tseq) w = *(const GAS u32x4*)(U + (rowbase + t) * DINP + (ck < 8 ? C_QM : C_KM) + h * 64 + (ck & 7) * 8);
        r.raw[i] = w; }
#pragma unroll
    for (int i = 0; i < 4; ++i) { const int idx = tid + i * NTHR, l = idx & 127, ck = idx >> 7; r.v[i] = *(const GAS u32x4*)(U + (rowbase + t0 + l) * DINP + C_VM + h * 128 + ck * 8); }
}
__device__ __forceinline__ void ml_stats_item(const Params& p, unsigned char* lds, int item, StPre& pre, int next_item) {
    const GAS bf16_t* U = (const GAS bf16_t*)(p.ws + WS_U); GAS bf16_t* QP = (GAS bf16_t*)(p.ws + WS_QP); GAS bf16_t* KP = (GAS bf16_t*)(p.ws + WS_KP);
    GAS bf16_t* CLOC = (GAS bf16_t*)(p.ws + WS_CLOC); GAS float* NLOC = (GAS float*)(p.ws + WS_NLOC); GAS float* MLOC = (GAS float*)(p.ws + WS_MLOC); GAS float* BLAST = (GAS float*)(p.ws + WS_BLAST);
    const GAS float* ROPE = (const GAS float*)(p.ws + WS_ROPE); const GAS float* convw = (const GAS float*)p.conv_qk;
    const int tid = ltid(), lane = tid & 63, wave = __builtin_amdgcn_readfirstlane(tid >> 6), fr = lane & 15, fq = lane >> 4;
    const int ch = item % NCH, bh = item / NCH, h = bh & 3, b = bh >> 2;
    const bool is_ctx = ch >= 64; const int Tseq = is_ctx ? 256 : 8192, cl = is_ctx ? ch - 64 : ch, t0 = cl * 128;
    const size_t rowbase = is_ctx ? (size_t)NLAT + b * 256 : (size_t)b * 8192;
    bf16_t* KT = (bf16_t*)lds;
    bf16_t* RAW = KT + 64 * 136;
    float* TMP = (float*)(RAW + 132 * 128);
    bf16_t* WV = RAW;
    float* gl = TMP + 128 * 129;
    float* wgt = gl + 512;
    const float* RT = wgt + 256;
#pragma unroll
    for (int i = 0; i < 5; ++i) { const int idx = tid + i * NTHR; if (idx < 132 * 16) *(u32x4*)(RAW + (idx >> 4) * 128 + (idx & 15) * 8) = pre.raw[i]; }
    { const int g = tid >> 7, l = tid & 127; gl[tid] = bf2f(U[(rowbase + t0 + l) * DINP + C_GT + g * 4 + h]) + p.b_gate[g * 4 + h]; }
    __syncthreads();
    for (int rr19_ = 0; rr19_ < REPN(19); ++rr19_) {
    { const int chn = tid & 127, wofs = (chn < 64 ? 0 : 256) + h * 64 + (chn & 63);
      float cw[5];
#pragma unroll
      for (int j = 0; j < 5; ++j) cw[j] = convw[j * 512 + wofs];
      const int l0 = (tid >> 7) * 32;
      float w0 = bf2f(RAW[(l0 + 0) * 128 + chn]), w1 = bf2f(RAW[(l0 + 1) * 128 + chn]), w2 = bf2f(RAW[(l0 + 2) * 128 + chn]), w3 = bf2f(RAW[(l0 + 3) * 128 + chn]);
#pragma unroll 8
      for (int i = 0; i < 32; ++i) { const float w4 = bf2f(RAW[(l0 + i + 4) * 128 + chn]);
          const float a = cw[0] * w0 + cw[1] * w1 + cw[2] * w2 + cw[3] * w3 + cw[4] * w4;
          TMP[(l0 + i) * 129 + chn] = siluf(a); w0 = w1; w1 = w2; w2 = w3; w3 = w4; } }
    if (wave < 2) {
        const int dir = wave, l0 = dir == 0 ? 2 * lane : 127 - 2 * lane, l1 = dir == 0 ? 2 * lane + 1 : 126 - 2 * lane;
        const float* ig = gl + dir * 256; const float* fg = ig + 128;
        const float lf0 = logsigf(fg[l0]), lf1 = logsigf(fg[l1]);
        const float incl = wscan_add(lf0 + lf1, lane), bc0 = incl - lf1, bc1 = incl, blast = __shfl(incl, 63);
        const float a0 = blast - bc0 + ig[l0], a1 = blast - bc1 + ig[l1];
        const float m = wave_max(fmaxf(a0, a1));
        wgt[dir * 128 + l0] = __expf(a0 - m); wgt[dir * 128 + l1] = __expf(a1 - m);
        if (lane == 0) { BLAST[(dir * 32 + bh) * NCH + ch] = blast; MLOC[(dir * 32 + bh) * NCH + ch] = m; }
    }
    }
    __syncthreads();
    for (int rr20_ = 0; rr20_ < REPN(20); ++rr20_) {
    for (int idx = tid; idx < 128 * 16; idx += NTHR) { const int l = idx & 127, ck = idx >> 7, isk = ck >> 3, d0 = (ck & 7) * 8, t = t0 + l;
        if (is_ctx && !isk) continue;
        const float* xr = TMP + l * 129 + isk * 64;
        float o[8];
        if (is_ctx) {
#pragma unroll
            for (int e = 0; e < 8; ++e) o[e] = xr[d0 + e];
        } else {
            const int half = d0 >> 5, dd0 = d0 & 31, i0 = dd0 & 15, pos = half == 0 ? (t >> 6) : (t & 63);
            const f32x4* rp = (const f32x4*)(RT + (pos * 16 + i0) * 2);
            const f32x4 r0 = rp[0], r1 = rp[1], r2 = rp[2], r3 = rp[3];
            const float cs_[8] = {r0.x, r0.z, r1.x, r1.z, r2.x, r2.z, r3.x, r3.z}, sn[8] = {r0.y, r0.w, r1.y, r1.w, r2.y, r2.w, r3.y, r3.w};
#pragma unroll
            for (int e = 0; e < 8; ++e) { const float x1 = xr[half * 32 + i0 + e], x2 = xr[half * 32 + 16 + i0 + e]; o[e] = dd0 < 16 ? x1 * cs_[e] - x2 * sn[e] : x1 * sn[e] + x2 * cs_[e]; }
        }
        if (!isk) { u32x4 w; w.x = pk2(o[0] * 0.125f, o[1] * 0.125f); w.y = pk2(o[2] * 0.125f, o[3] * 0.125f); w.z = pk2(o[4] * 0.125f, o[5] * 0.125f); w.w = pk2(o[6] * 0.125f, o[7] * 0.125f);
            *(GAS u32x4*)(QP + ((size_t)b * 8192 + t) * 256 + h * 64 + d0) = w; }
        else { u32x4 w; w.x = pk2(o[0], o[1]); w.y = pk2(o[2], o[3]); w.z = pk2(o[4], o[5]); w.w = pk2(o[6], o[7]);
            *(GAS u32x4*)(KP + (rowbase + t) * 256 + h * 64 + d0) = w;
            KT[(d0 + 0) * 136 + l] = (bf16_t)(w.x & 0xffffu); KT[(d0 + 1) * 136 + l] = (bf16_t)(w.x >> 16); KT[(d0 + 2) * 136 + l] = (bf16_t)(w.y & 0xffffu); KT[(d0 + 3) * 136 + l] = (bf16_t)(w.y >> 16);
            KT[(d0 + 4) * 136 + l] = (bf16_t)(w.z & 0xffffu); KT[(d0 + 5) * 136 + l] = (bf16_t)(w.z >> 16); KT[(d0 + 6) * 136 + l] = (bf16_t)(w.w & 0xffffu); KT[(d0 + 7) * 136 + l] = (bf16_t)(w.w >> 16); }
    }
    }
    __syncthreads();
    for (int rr21_ = 0; rr21_ < REPN(21); ++rr21_) {
#pragma unroll
    for (int i = 0; i < 4; ++i) { const int idx = tid + i * NTHR, l = idx & 127, ck = idx >> 7;
        const u32x4 w = pre.v[i];
        const float wf = wgt[l], wb = wgt[128 + l];
        const float vv[8] = {bflo(w.x), bfhi(w.x), bflo(w.y), bfhi(w.y), bflo(w.z), bfhi(w.z), bflo(w.w), bfhi(w.w)};
#pragma unroll
        for (int e = 0; e < 8; ++e) { WV[(ck * 8 + e) * 136 + l] = (bf16_t)f2bf(wf * vv[e]); WV[(128 + ck * 8 + e) * 136 + l] = (bf16_t)f2bf(wb * vv[e]); } }
    }
    __syncthreads();
    if (next_item >= 0) ml_stats_prefetch(p, next_item, tid, pre);
    for (int rr22_ = 0; rr22_ < REPN(22); ++rr22_) {
    { const int dir = wave >> 2, vb0 = (wave & 3) * 2;
      GAS bf16_t* cdst = CLOC + ((size_t)(dir * 32 + bh) * NCH + ch) * 8192;
#pragma unroll
      for (int vbi = 0; vbi < 2; ++vbi) {
          const int vb = vb0 + vbi;
          bf16x8_t af[4];
#pragma unroll
          for (int ls = 0; ls < 4; ++ls) af[ls] = *(const bf16x8_t*)(WV + (dir * 128 + vb * 16 + fr) * 136 + ls * 32 + 8 * fq);
#pragma unroll
          for (int kb = 0; kb < 4; ++kb) {
              f32x4 acc = (f32x4){0.f, 0.f, 0.f, 0.f};
#pragma unroll
              for (int ls = 0; ls < 4; ++ls) { const bf16x8_t bfr = *(const bf16x8_t*)(KT + (kb * 16 + fr) * 136 + ls * 32 + 8 * fq); acc = __builtin_amdgcn_mfma_f32_16x16x32_bf16(af[ls], bfr, acc, 0, 0, 0); }
#pragma unroll
              for (int j = 0; j < 4; ++j) cdst[(vb * 16 + 4 * fq + j) * 64 + kb * 16 + fr] = (bf16_t)f2bf(acc[j]);
          }
      }
      if (tid < 128) { const int d2 = tid >> 6, k = tid & 63; float sn = 0.f;
          for (int l = 0; l < 128; ++l) sn += wgt[d2 * 128 + l] * bf2f(KT[k * 136 + l]);
          NLOC[((size_t)(d2 * 32 + bh) * NCH + ch) * 64 + k] = sn; }
    }
    }
    __syncthreads();
}
__device__ __forceinline__ void ph3(const Params& p, unsigned char* lds, int bid, int nblk) {
    for (int rep_ = 0; rep_ < REPN(14); ++rep_) for (int it = bid; it < 256; it += nblk) na_item(p, lds, (nblk == 256) ? ((it & 7) * 32 + (it >> 3)) : it);
    {
      float* RTw = (float*)((bf16_t*)lds + 64 * 136 + 132 * 128) + 128 * 129 + 512 + 256; const GAS float* ROPEg = (const GAS float*)(p.ws + WS_ROPE);
      for (int i = threadIdx.x; i < 4096; i += NTHR) RTw[i] = ROPEg[i];
      __syncthreads(); }
    for (int rep_ = 0; rep_ < REPN(15); ++rep_) { StPre pre; if (bid < 32 * NCH) ml_stats_prefetch(p, bid, (int)threadIdx.x, pre);
        for (int it = bid; it < 32 * NCH; it += nblk) ml_stats_item(p, lds, it, pre, it + nblk < 32 * NCH ? it + nblk : -1); }
}

__device__ __forceinline__ void ph4(const Params& p, int bid, int nblk) {
    GAS bf16_t* CLOC = (GAS bf16_t*)(p.ws + WS_CLOC); GAS float* NLOC = (GAS float*)(p.ws + WS_NLOC); const GAS float* MLOC = (const GAS float*)(p.ws + WS_MLOC);
    const GAS float* BLAST = (const GAS float*)(p.ws + WS_BLAST); GAS float* MIN = (GAS float*)(p.ws + WS_MIN);
    const int tid = ltid();
    for (int it = bid; it < 64 * 5; it += nblk) {
        const bool small = it >= 256; const int q = small ? it - 256 : it >> 2, seg = it & 3, dir = q >> 5;
        if (small && tid > 64) continue;
        float c0 = 0.f, c1 = 0.f, c2 = 0.f, c3 = 0.f, m_prev = 0.f;
        GAS bf16_t* cbase = CLOC + (size_t)q * NCH * 8192 + seg * 2048 + tid * 4;
        GAS float* nbase = NLOC + (size_t)q * NCH * 64 + (tid & 63);
        for (int s0 = 0; s0 < NCH; s0 += 22) {
            u32x2 cw[22]; float nv[22], bl[22], ml[22]; int ci[22];
#pragma unroll
            for (int u = 0; u < 22; ++u) { const int step = s0 + u; ci[u] = dir == 0 ? (step < 2 ? 64 + step : step - 2) : 65 - step;
                bl[u] = BLAST[q * NCH + ci[u]]; ml[u] = MLOC[q * NCH + ci[u]];
                if (!small) cw[u] = *(const GAS u32x2*)(cbase + (size_t)ci[u] * 8192); else nv[u] = tid < 64 ? nbase[ci[u] * 64] : 0.f; }
#pragma unroll
            for (int u = 0; u < 22; ++u) {
                const float m_new = fmaxf(bl[u] + m_prev, ml[u]), sp = __expf(bl[u] + m_prev - m_new), sl = __expf(ml[u] - m_new);
                if (!small) { u32x2 o; o.x = pk2(c0, c1); o.y = pk2(c2, c3); *(GAS u32x2*)(cbase + (size_t)ci[u] * 8192) = o;
                    c0 = sp * c0 + sl * bflo(cw[u].x); c1 = sp * c1 + sl * bfhi(cw[u].x); c2 = sp * c2 + sl * bflo(cw[u].y); c3 = sp * c3 + sl * bfhi(cw[u].y); }
                else if (tid < 64) { nbase[ci[u] * 64] = c0; c0 = sp * c0 + sl * nv[u]; }
                else MIN[q * NCH + ci[u]] = m_prev;
                m_prev = m_new;
            }
        }
    }
}

struct MlPre { u32x4 q[2], k[2], v[4], c[2][2]; };
__device__ __forceinline__ void ml_out_prefetch(const Params& p, int item, int tid, MlPre& r) {
    const GAS bf16_t* U = (const GAS bf16_t*)(p.ws + WS_U); const GAS bf16_t* QP = (const GAS bf16_t*)(p.ws + WS_QP); const GAS bf16_t* KP = (const GAS bf16_t*)(p.ws + WS_KP);
    const GAS bf16_t* CLOC = (const GAS bf16_t*)(p.ws + WS_CLOC);
    const int J = item & 63, bh = item >> 6, h = bh & 3, b = bh >> 2; const size_t row0 = (size_t)b * 8192 + J * 128;
#pragma unroll
    for (int i = 0; i < 2; ++i) { const int idx = tid + i * NTHR, rr = idx >> 3, ck = idx & 7;
        r.q[i] = *(const GAS u32x4*)(QP + (row0 + rr) * 256 + h * 64 + ck * 8); r.k[i] = *(const GAS u32x4*)(KP + (row0 + rr) * 256 + h * 64 + ck * 8); }
#pragma unroll
    for (int i = 0; i < 4; ++i) { const int idx = tid + i * NTHR, l = idx & 127, ck = idx >> 7; r.v[i] = *(const GAS u32x4*)(U + (row0 + l) * DINP + C_VM + h * 128 + ck * 8); }
#pragma unroll
    for (int dir = 0; dir < 2; ++dir) { const GAS bf16_t* csrc = CLOC + ((size_t)(dir * 32 + bh) * NCH + J) * 8192;
#pragma unroll
        for (int i = 0; i < 2; ++i) { const int idx = tid + i * NTHR; r.c[dir][i] = *(const GAS u32x4*)(csrc + idx * 8); } }
}
__device__ __forceinline__ void ml_out_item(const Params& p, unsigned char* lds, int item, MlPre& pre, int next_item) {
    const GAS bf16_t* U = (const GAS bf16_t*)(p.ws + WS_U); const GAS bf16_t* QP = (const GAS bf16_t*)(p.ws + WS_QP); const GAS bf16_t* KP = (const GAS bf16_t*)(p.ws + WS_KP);
    const GAS float* NLOC = (const GAS float*)(p.ws + WS_NLOC); const GAS float* MIN = (const GAS float*)(p.ws + WS_MIN);
    GAS bf16_t* MIX = (GAS bf16_t*)(p.ws + WS_MIX);
    const int tid = ltid(), lane = tid & 63, wave = __builtin_amdgcn_readfirstlane(tid >> 6), fr = lane & 15, fq = lane >> 4;
    const int J = item & 63, bh = item >> 6, h = bh & 3, b = bh >> 2, t0 = J * 128;
    const size_t row0 = (size_t)b * 8192 + t0;
    bf16_t* Qs = (bf16_t*)lds;
    bf16_t* Ks = Qs + 128 * 72;
    bf16_t* VT = Ks + 128 * 72;
    bf16_t* Cs = VT + 128 * 136;
    float* asv = (float*)(Cs + 2 * 128 * 72);
    float* btv = asv + 256;
    float* itv = btv + 256;
    float* emt = itv + 256;
    float* nin = emt + 256;
    float* OST = nin + 128 + wave * (8 * 132);
    for (int r16_ = 0; r16_ < REPN(16); ++r16_) {
    if (wave < 2) {
        const int dir = wave, l0 = dir == 0 ? 2 * lane : 127 - 2 * lane, l1 = dir == 0 ? 2 * lane + 1 : 126 - 2 * lane;
        const GAS bf16_t* g0 = U + (row0 + l0) * DINP + C_GT + h; const GAS bf16_t* g1 = U + (row0 + l1) * DINP + C_GT + h;
        const float bi = p.b_gate[dir * 8 + h], bf_ = p.b_gate[dir * 8 + 4 + h];
        const float i0 = bf2f(g0[dir * 8]) + bi, f0 = bf2f(g0[dir * 8 + 4]) + bf_, i1 = bf2f(g1[dir * 8]) + bi, f1 = bf2f(g1[dir * 8 + 4]) + bf_;
        const float m_in = MIN[(dir * 32 + bh) * NCH + J];
        const float lf0 = logsigf(f0), lf1 = logsigf(f1);
        const float incl = wscan_add(lf0 + lf1, lane), bc0 = incl - lf1, bc1 = incl;
        const float as0 = i0 - bc0, as1 = i1 - bc1;
        const float inclm = wscan_max(fmaxf(as0, as1), lane); float exclm = __shfl_up(inclm, 1); if (lane == 0) exclm = -INFINITY;
        const float gm0 = fmaxf(exclm, as0), gm1 = inclm;
        const float mp0 = bc0 + m_in, mp1 = bc1 + m_in, mt0 = fmaxf(bc0 + gm0, mp0), mt1 = fmaxf(bc1 + gm1, mp1);
        asv[dir * 128 + l0] = as0; asv[dir * 128 + l1] = as1; btv[dir * 128 + l0] = bc0 - mt0; btv[dir * 128 + l1] = bc1 - mt1;
        itv[dir * 128 + l0] = __expf(mp0 - mt0); itv[dir * 128 + l1] = __expf(mp1 - mt1); emt[dir * 128 + l0] = __expf(-mt0); emt[dir * 128 + l1] = __expf(-mt1);
    }
#pragma unroll
    for (int i = 0; i < 2; ++i) { const int idx = tid + i * NTHR, r = idx >> 3, ck = idx & 7; *(u32x4*)(Qs + r * 72 + ck * 8) = pre.q[i]; *(u32x4*)(Ks + r * 72 + ck * 8) = pre.k[i]; }
#pragma unroll
    for (int i = 0; i < 4; ++i) { const int idx = tid + i * NTHR, l = idx & 127, ck = idx >> 7;
        const u32x4 w = pre.v[i]; bf16_t* d = VT + (ck * 8) * 136 + l;
        d[0 * 136] = (bf16_t)(w.x & 0xffffu); d[1 * 136] = (bf16_t)(w.x >> 16); d[2 * 136] = (bf16_t)(w.y & 0xffffu); d[3 * 136] = (bf16_t)(w.y >> 16);
        d[4 * 136] = (bf16_t)(w.z & 0xffffu); d[5 * 136] = (bf16_t)(w.z >> 16); d[6 * 136] = (bf16_t)(w.w & 0xffffu); d[7 * 136] = (bf16_t)(w.w >> 16); }
#pragma unroll
    for (int dir = 0; dir < 2; ++dir)
#pragma unroll
        for (int i = 0; i < 2; ++i) { const int idx = tid + i * NTHR, v = idx >> 3, k8 = idx & 7; *(u32x4*)(Cs + (dir * 128 + v) * 72 + k8 * 8) = pre.c[dir][i]; }
    if (tid < 128) nin[tid] = NLOC[((size_t)((tid >> 6) * 32 + bh) * NCH + J) * 64 + (tid & 63)];
    }
    __syncthreads();
    if (next_item >= 0) ml_out_prefetch(p, next_item, tid, pre);
    const int tb = wave;
    bf16x8_t qf[2];
#pragma unroll
    for (int ks = 0; ks < 2; ++ks) qf[ks] = *(const bf16x8_t*)(Qs + (16 * tb + fr) * 72 + ks * 32 + 8 * fq);
    f32x4 hs[8];
    for (int r17_ = 0; r17_ < REPN(17); ++r17_) {
#pragma unroll
    for (int vb = 0; vb < 8; ++vb) hs[vb] = (f32x4){0.f, 0.f, 0.f, 0.f};
#pragma unroll
    for (int dir = 0; dir < 2; ++dir) {
        f32x4 acc[8];
#pragma unroll
        for (int vb = 0; vb < 8; ++vb) { acc[vb] = (f32x4){0.f, 0.f, 0.f, 0.f};
#pragma unroll
            for (int ks = 0; ks < 2; ++ks) { const bf16x8_t cf = *(const bf16x8_t*)(Cs + (dir * 128 + vb * 16 + fr) * 72 + ks * 32 + 8 * fq); acc[vb] = __builtin_amdgcn_mfma_f32_16x16x32_bf16(qf[ks], cf, acc[vb], 0, 0, 0); } }
        { const f32x4 i4 = *(const f32x4*)(itv + dir * 128 + 16 * tb + 4 * fq);
#pragma unroll
          for (int vb = 0; vb < 8; ++vb) acc[vb] = acc[vb] * i4; }
        const float bt = btv[dir * 128 + 16 * tb + fr];
        float rowsum = 0.f;
#pragma unroll
        for (int pr = 0; pr < 4; ++pr) {
            const int sb0 = 2 * pr, sb1 = 2 * pr + 1;
            const bool need0 = dir == 0 ? (sb0 <= tb) : (sb0 >= tb), need1 = dir == 0 ? (sb1 <= tb) : (sb1 >= tb);
            if (!need0 && !need1) continue;
            f32x4 s0 = (f32x4){0.f, 0.f, 0.f, 0.f}, s1 = (f32x4){0.f, 0.f, 0.f, 0.f};
            if (need0) {
#pragma unroll
                for (int ks = 0; ks < 2; ++ks) { const bf16x8_t kf = *(const bf16x8_t*)(Ks + (16 * sb0 + fr) * 72 + ks * 32 + 8 * fq); s0 = __builtin_amdgcn_mfma_f32_16x16x32_bf16(kf, qf[ks], s0, 0, 0, 0); }
                const f32x4 a4 = *(const f32x4*)(asv + dir * 128 + 16 * sb0 + 4 * fq);
#pragma unroll
                for (int j = 0; j < 4; ++j) { const bool valid = (sb0 != tb) || (dir == 0 ? (4 * fq + j <= fr) : (4 * fq + j >= fr)); s0[j] = valid ? s0[j] * __expf(bt + a4[j]) : 0.f; }
            }
            if (need1) {
#pragma unroll
                for (int ks = 0; ks < 2; ++ks) { const bf16x8_t kf = *(const bf16x8_t*)(Ks + (16 * sb1 + fr) * 72 + ks * 32 + 8 * fq); s1 = __builtin_amdgcn_mfma_f32_16x16x32_bf16(kf, qf[ks], s1, 0, 0, 0); }
                const f32x4 a4 = *(const f32x4*)(asv + dir * 128 + 16 * sb1 + 4 * fq);
#pragma unroll
                for (int j = 0; j < 4; ++j) { const bool valid = (sb1 != tb) || (dir == 0 ? (4 * fq + j <= fr) : (4 * fq + j >= fr)); s1[j] = valid ? s1[j] * __expf(bt + a4[j]) : 0.f; }
            }
            rowsum += (s0[0] + s0[1]) + (s0[2] + s0[3]) + (s1[0] + s1[1]) + (s1[2] + s1[3]);
            u32x4 pw; pw.x = cvtpk(s0[0], s0[1]); pw.y = cvtpk(s0[2], s0[3]); pw.z = cvtpk(s1[0], s1[1]); pw.w = cvtpk(s1[2], s1[3]);
            const bf16x8_t pa = __builtin_bit_cast(bf16x8_t, pw);
#pragma unroll
            for (int vb = 0; vb < 8; ++vb) {
                const u32x2 v0 = *(const u32x2*)(VT + (vb * 16 + fr) * 136 + 16 * sb0 + 4 * fq), v1 = *(const u32x2*)(VT + (vb * 16 + fr) * 136 + 16 * sb1 + 4 * fq);
                const u32x4 vw = (u32x4){v0.x, v0.y, v1.x, v1.y};
                acc[vb] = __builtin_amdgcn_mfma_f32_16x16x32_bf16(pa, __builtin_bit_cast(bf16x8_t, vw), acc[vb], 0, 0, 0);
            }
        }
        rowsum += __shfl_xor(rowsum, 16); rowsum += __shfl_xor(rowsum, 32);
        float nq = 0.f;
        { const u32x4 qa = *(const u32x4*)(Qs + (16 * tb + fr) * 72 + 16 * fq), qb = *(const u32x4*)(Qs + (16 * tb + fr) * 72 + 16 * fq + 8); const float* nn = nin + dir * 64 + 16 * fq;
          nq = nn[0] * bflo(qa.x) + nn[1] * bfhi(qa.x) + nn[2] * bflo(qa.y) + nn[3] * bfhi(qa.y) + nn[4] * bflo(qa.z) + nn[5] * bfhi(qa.z) + nn[6] * bflo(qa.w) + nn[7] * bfhi(qa.w)
             + nn[8] * bflo(qb.x) + nn[9] * bfhi(qb.x) + nn[10] * bflo(qb.y) + nn[11] * bfhi(qb.y) + nn[12] * bflo(qb.z) + nn[13] * bfhi(qb.z) + nn[14] * bflo(qb.w) + nn[15] * bfhi(qb.w); }
        nq += __shfl_xor(nq, 16); nq += __shfl_xor(nq, 32);
        const float den = rowsum + itv[dir * 128 + 16 * tb + fr] * nq;
        const float rdn = 1.f / fmaxf(fabsf(den), emt[dir * 128 + 16 * tb + fr]);
#pragma unroll
        for (int j = 0; j < 4; ++j) { const float r = __shfl(rdn, 4 * fq + j);
#pragma unroll
            for (int vb = 0; vb < 8; ++vb) hs[vb][j] += acc[vb][j] * r; }
    }
    }
    float mu[4], rs[4];
#pragma unroll
    for (int j = 0; j < 4; ++j) { float sm = 0.f;
#pragma unroll
        for (int vb = 0; vb < 8; ++vb) sm += hs[vb][j];
        sm += __shfl_xor(sm, 1); sm += __shfl_xor(sm, 2); sm += __shfl_xor(sm, 4); sm += __shfl_xor(sm, 8);
        mu[j] = sm * (1.f / 128.f); float sq = 0.f;
#pragma unroll
        for (int vb = 0; vb < 8; ++vb) { const float d = hs[vb][j] - mu[j]; sq += d * d; }
        sq += __shfl_xor(sq, 1); sq += __shfl_xor(sq, 2); sq += __shfl_xor(sq, 4); sq += __shfl_xor(sq, 8);
        rs[j] = rsqrtf(sq * (1.f / 128.f) + LN_EPS); }
    const GAS float* mng = (const GAS float*)p.ml_norm_g + h * 128;
    for (int r18_ = 0; r18_ < REPN(18); ++r18_) {
#pragma unroll
    for (int ps = 0; ps < 2; ++ps) {
#pragma unroll
        for (int vb = 0; vb < 8; ++vb) { const float gg = mng[vb * 16 + fr];
#pragma unroll
            for (int jj = 0; jj < 2; ++jj) { const int j = 2 * ps + jj; OST[(2 * fq + jj) * 132 + vb * 16 + fr] = (hs[vb][j] - mu[j]) * rs[j] * gg; } }
        LDS_FENCE();
        { const int rl = lane >> 3, ck = lane & 7, t = 16 * tb + 4 * (rl >> 1) + 2 * ps + (rl & 1);
          const float* src = OST + rl * 132 + ck * 16;
          const f32x4 o0 = *(const f32x4*)src, o1 = *(const f32x4*)(src + 4), o2 = *(const f32x4*)(src + 8), o3 = *(const f32x4*)(src + 12);
          const GAS bf16_t* omp = U + (row0 + t) * DINP + C_OM + h * 128 + ck * 16;
          const u32x4 oa = *(const GAS u32x4*)omp, ob = *(const GAS u32x4*)(omp + 8);
          u32x4 wa, wb;
          wa.x = pk2(o0.x * sigmoidf_(bflo(oa.x)), o0.y * sigmoidf_(bfhi(oa.x))); wa.y = pk2(o0.z * sigmoidf_(bflo(oa.y)), o0.w * sigmoidf_(bfhi(oa.y)));
          wa.z = pk2(o1.x * sigmoidf_(bflo(oa.z)), o1.y * sigmoidf_(bfhi(oa.z))); wa.w = pk2(o1.z * sigmoidf_(bflo(oa.w)), o1.w * sigmoidf_(bfhi(oa.w)));
          wb.x = pk2(o2.x * sigmoidf_(bflo(ob.x)), o2.y * sigmoidf_(bfhi(ob.x))); wb.y = pk2(o2.z * sigmoidf_(bflo(ob.y)), o2.w * sigmoidf_(bfhi(ob.y)));
          wb.z = pk2(o3.x * sigmoidf_(bflo(ob.z)), o3.y * sigmoidf_(bfhi(ob.z))); wb.w = pk2(o3.z * sigmoidf_(bflo(ob.w)), o3.w * sigmoidf_(bfhi(ob.w)));
          GAS bf16_t* dst = MIX + (row0 + t) * 1024 + 512 + h * 128 + ck * 16;
          *(GAS u32x4*)dst = wa; *(GAS u32x4*)(dst + 8) = wb; }
        LDS_FENCE();
    }
    }
    __syncthreads();
}
__device__ __forceinline__ void ph5(const Params& p, unsigned char* lds, int bid, int nblk) {
    MlPre pre; const int tid0 = threadIdx.x;
    if (bid < 32 * 64) ml_out_prefetch(p, bid, tid0, pre);
    for (int it = bid; it < 32 * 64; it += nblk) ml_out_item(p, lds, it, pre, it + nblk < 32 * 64 ? it + nblk : -1);
}


struct TrItem { const GAS float* W; GAS unsigned char* WT; size_t orow0; int N, k0, n0, ldt; float qs; };
__device__ __forceinline__ TrItem tr_decode(const Params& p, int it) {
    TrItem t; const int e = it / (3 * 704), r = it % (3 * 704), which = r / 704, q = r % 704;
    if (which < 2) { const int kb = q / 44, nb = q % 44; t.n0 = nb * 64; t.k0 = kb * 64; t.W = (const GAS float*)(which == 0 ? p.w_eg : p.w_eu) + (size_t)e * 1024 * DFF; t.N = DFF;
        t.WT = (GAS unsigned char*)(p.ws + WS_WGUT) + (size_t)e * 2 * DFF * 1024; t.orow0 = (size_t)((t.n0 >> 7) * 256 + which * 128 + (t.n0 & 127)); t.ldt = 1024; t.qs = 32.f; }
    else { const int kb = q / 16, nb = q % 16; t.n0 = nb * 64; t.k0 = kb * 64; t.W = (const GAS float*)p.w_ed + (size_t)e * DFF * 1024; t.N = 1024;
        t.WT = (GAS unsigned char*)(p.ws + WS_WDT) + (size_t)e * 1024 * DFF; t.orow0 = (size_t)t.n0; t.ldt = DFF; t.qs = 64.f; }
    return t;
}
__device__ __forceinline__ void tr_load(const TrItem& t, int lane, f32x4 (&v)[16]) {
    const int cq = (lane & 15) * 4, rq = lane >> 4;
#pragma unroll
    for (int i = 0; i < 16; ++i) v[i] = __builtin_nontemporal_load((const GAS f32x4*)(t.W + (size_t)(t.k0 + 4 * i + rq) * t.N + t.n0 + cq));
}
__device__ __forceinline__ void tr_to_lds(const TrItem& t, int lane, const f32x4 (&v)[16], float* scr) {
    const int cq = (lane & 15) * 4, rq = lane >> 4;
#pragma unroll
    for (int i = 0; i < 16; ++i) { float* d = scr + (4 * i + rq) * 65 + cq; d[0] = v[i].x * t.qs; d[1] = v[i].y * t.qs; d[2] = v[i].z * t.qs; d[3] = v[i].w * t.qs; }
    LDS_FENCE();
}
__device__ __forceinline__ void tr_store(const TrItem& t, int lane, const float* scr) {
    const int c = lane & 7;
#pragma unroll
    for (int j = 0; j < 8; ++j) {
        const int n = (lane >> 3) + 8 * j; const float* sp = scr + (8 * c) * 65 + n;
        u32x2 o; o.x = pk4_fp8(sp[0 * 65], sp[1 * 65], sp[2 * 65], sp[3 * 65]); o.y = pk4_fp8(sp[4 * 65], sp[5 * 65], sp[6 * 65], sp[7 * 65]);
        *(GAS u32x2*)(t.WT + (t.orow0 + n) * t.ldt + t.k0 + 8 * c) = o;
    }
    LDS_FENCE();
}
__device__ __forceinline__ float reduce16(const float (&lg)[16], int lane) {
    float a8[8], a4[4], a2[2];
    const bool h5 = lane & 32, h4 = lane & 16, h3 = lane & 8, h2 = lane & 4;
#pragma unroll
    for (int i = 0; i < 8; ++i) { const float snd = h5 ? lg[i] : lg[8 + i], kp = h5 ? lg[8 + i] : lg[i]; a8[i] = kp + __shfl_xor(snd, 32); }
#pragma unroll
    for (int i = 0; i < 4; ++i) { const float snd = h4 ? a8[i] : a8[4 + i], kp = h4 ? a8[4 + i] : a8[i]; a4[i] = kp + __shfl_xor(snd, 16); }
#pragma unroll
    for (int i = 0; i < 2; ++i) { const float snd = h3 ? a4[i] : a4[2 + i], kp = h3 ? a4[2 + i] : a4[i]; a2[i] = kp + __shfl_xor(snd, 8); }
    const float snd = h2 ? a2[0] : a2[1], kp = h2 ? a2[1] : a2[0];
    float d = kp + __shfl_xor(snd, 4);
    d += __shfl_xor(d, 2); d += __shfl_xor(d, 1);
    return d;
}
__device__ __forceinline__ void ph7(const Params& p, unsigned char* lds, int bid, int nblk) {
    const int tid = ltid(), lane = tid & 63, wave = tid >> 6;
    const GAS float* MOD = (const GAS float*)(p.ws + WS_MOD); GAS unsigned char* HMOD = (GAS unsigned char*)(p.ws + WS_HMOD); GAS float* AFF = (GAS float*)(p.ws + WS_AFF);
    const GAS bf16_t* Y = (const GAS bf16_t*)(p.ws + WS_Y); const GAS float* ln1g = (const GAS float*)p.ln1_g; const GAS float* ln1b = (const GAS float*)p.ln1_b;
    const int gw = bid * NWAVES + wave, ngw = nblk * NWAVES;
    __syncthreads();
    float* WR = (float*)lds; float* RED = WR + 16 * 1028;
    { const GAS float* wr = (const GAS float*)p.w_router; for (int idx = tid; idx < 16 * 1024; idx += NTHR) { const int k = idx >> 4, e = idx & 15; WR[e * 1028 + k] = wr[idx]; } }
    __syncthreads();
    for (int rep12_ = 0; rep12_ < REPN(12); ++rep12_) {
    u32x2 vn[2][4];
    if (2 * gw < NLAT) {
#pragma unroll
        for (int r = 0; r < 2; ++r)
#pragma unroll
            for (int j = 0; j < 4; ++j) vn[r][j] = *(const GAS u32x2*)(Y + (size_t)(2 * gw + r) * 1024 + j * 256 + lane * 4); }
    for (int m0 = 2 * gw; m0 < NLAT; m0 += 2 * ngw) {
        asm volatile("" ::: "memory");
        const int b = m0 >> 13;
        const GAS float* sh2 = MOD + b * 6144 + 3072; const GAS float* sc2 = sh2 + 1024;
        f32x4 v[2][4]; float mean[2], rstd[2];
#pragma unroll
        for (int r = 0; r < 2; ++r)
#pragma unroll
            for (int j = 0; j < 4; ++j) v[r][j] = (f32x4){hlo(vn[r][j].x), hhi(vn[r][j].x), hlo(vn[r][j].y), hhi(vn[r][j].y)};
        if (m0 + 2 * ngw < NLAT) {
#pragma unroll
            for (int r = 0; r < 2; ++r)
#pragma unroll
                for (int j = 0; j < 4; ++j) vn[r][j] = *(const GAS u32x2*)(Y + (size_t)(m0 + 2 * ngw + r) * 1024 + j * 256 + lane * 4); }
#pragma unroll
        for (int r = 0; r < 2; ++r) { float sm = 0.f;
#pragma unroll
            for (int j = 0; j < 4; ++j) sm += (v[r][j].x + v[r][j].y) + (v[r][j].z + v[r][j].w);
            mean[r] = wave_sum(sm) * (1.f / 1024.f); float s2 = 0.f;
#pragma unroll
            for (int j = 0; j < 4; ++j) { v[r][j] = v[r][j] - mean[r]; s2 += (v[r][j].x * v[r][j].x + v[r][j].y * v[r][j].y) + (v[r][j].z * v[r][j].z + v[r][j].w * v[r][j].w); }
            rstd[r] = rsqrtf(wave_sum(s2) * (1.f / 1024.f) + LN_EPS); }
        f32x4 hm[2][4];
#pragma unroll
        for (int j = 0; j < 4; ++j) {
            const int k = j * 256 + lane * 4;
            const f32x4 g = *(const GAS f32x4*)(ln1g + k), be = *(const GAS f32x4*)(ln1b + k), a = *(const GAS f32x4*)(sc2 + k), sb = *(const GAS f32x4*)(sh2 + k);
#pragma unroll
            for (int r = 0; r < 2; ++r) { hm[r][j] = (v[r][j] * rstd[r] * g + be) * (1.f + a) + sb;
                *(GAS unsigned*)(HMOD + (size_t)(m0 + r) * 1024 + k) = pk4_fp8(hm[r][j].x, hm[r][j].y, hm[r][j].z, hm[r][j].w); }
        }
        float* red = RED + wave * (2 * 64 * 17);
#pragma unroll
        for (int e4 = 0; e4 < 4; ++e4) {
            float a[2][4];
#pragma unroll
            for (int ee = 0; ee < 4; ++ee) {
                f32x4 a0 = {0.f, 0.f, 0.f, 0.f}, a1 = {0.f, 0.f, 0.f, 0.f};
#pragma unroll
                for (int j = 0; j < 4; ++j) { const f32x4 w = *(const f32x4*)(WR + (e4 * 4 + ee) * 1028 + j * 256 + lane * 4);
                    a0 = __builtin_elementwise_fma(hm[0][j], w, a0); a1 = __builtin_elementwise_fma(hm[1][j], w, a1); }
                a[0][ee] = (a0.x + a0.y) + (a0.z + a0.w); a[1][ee] = (a1.x + a1.y) + (a1.z + a1.w);
            }
#pragma unroll
            for (int ee = 0; ee < 4; ++ee) { red[lane * 17 + e4 * 4 + ee] = a[0][ee]; red[64 * 17 + lane * 17 + e4 * 4 + ee] = a[1][ee]; }
            asm volatile("" ::: "memory");
        }
        LDS_FENCE();
        { const int e = lane & 15, r = (lane >> 4) & 1, part = lane >> 5;
          float d = 0.f; const float* src = red + r * (64 * 17) + e + part * 32 * 17;
#pragma unroll 8
          for (int l = 0; l < 32; ++l) d += src[l * 17];
          d += __shfl_xor(d, 32);
          float mx = d; mx = fmaxf(mx, __shfl_xor(mx, 1)); mx = fmaxf(mx, __shfl_xor(mx, 2)); mx = fmaxf(mx, __shfl_xor(mx, 4)); mx = fmaxf(mx, __shfl_xor(mx, 8));
          const float ex = expf(d - mx); float sm = ex; sm += __shfl_xor(sm, 1); sm += __shfl_xor(sm, 2); sm += __shfl_xor(sm, 4); sm += __shfl_xor(sm, 8);
          if (lane < 32) AFF[((size_t)b * 16 + e) * 8192 + ((m0 + r) & 8191)] = ex / sm; }
        LDS_FENCE();
    }
    }
}
__device__ __forceinline__ void ph7_conv(const Params& p, unsigned char* lds, int bid, int nblk) {
    const int tid = ltid(), lane = tid & 63, wave = tid >> 6;
    const int gw = bid * NWAVES + wave, ngw = nblk * NWAVES;
    float* scr = (float*)lds + wave * (64 * 65);
    for (int rep13_ = 0; rep13_ < REPN(13); ++rep13_) {
        f32x4 tv[16]; int it = gw;
        if (it < NE * 3 * 704) { const TrItem c0 = tr_decode(p, it); tr_load(c0, lane, tv); }
        for (; it < NE * 3 * 704; it += ngw) {
            const TrItem cur = tr_decode(p, it);
            tr_to_lds(cur, lane, tv, scr);
            if (it + ngw < NE * 3 * 704) { const TrItem nx = tr_decode(p, it + ngw); tr_load(nx, lane, tv); }
            tr_store(cur, lane, scr);
        }
    }
    __syncthreads();
}

__device__ __forceinline__ void topk_item(const Params& p, unsigned char* lds, int item) {
    const float* AFF = (const float*)(p.ws + WS_AFF); int* IDX = (int*)(p.ws + WS_IDX); float* GSEL = (float*)(p.ws + WS_GSEL); int* INV = (int*)(p.ws + WS_INV);
    const int tid = ltid(), lane = tid & 63, wave = tid >> 6;
    const int b = item >> 4, e = item & 15;
    unsigned* wcnt = (unsigned*)lds;
    const float* a = AFF + ((size_t)b * 16 + e) * 8192;
    unsigned bits[16];
#pragma unroll
    for (int j = 0; j < 16; ++j) bits[j] = __float_as_uint(a[j * 512 + tid]);
    __syncthreads();
    unsigned tau = 0u;
    for (int bit = 30; bit >= 0; --bit) {
        const unsigned cand = tau | (1u << bit);
        unsigned cnt = 0;
#pragma unroll
        for (int j = 0; j < 16; ++j) cnt += (unsigned)__popcll(__ballot(bits[j] >= cand));
        unsigned* slot = wcnt + ((bit & 1) << 3);
        if (lane == 0) slot[wave] = cnt;
        __syncthreads();
        unsigned tot = 0;
#pragma unroll
        for (int w = 0; w < 8; ++w) tot += slot[w];
        if (tot >= (unsigned)CAP) tau = cand;
    }
    unsigned* ctab = wcnt + 32;
    const unsigned long long lt_mask = (1ull << lane) - 1ull;
#pragma unroll
    for (int j = 0; j < 16; ++j) { const unsigned cw = (unsigned)__popcll(__ballot(bits[j] > tau)) | ((unsigned)__popcll(__ballot(bits[j] == tau)) << 16);
        if (lane == 0) ctab[j * 8 + wave] = cw; }
    __syncthreads();
    unsigned ngt = 0;
#pragma unroll
    for (int j = 0; j < 16; ++j)
#pragma unroll
        for (int w = 0; w < 8; ++w) ngt += ctab[j * 8 + w] & 0xffffu;
    const unsigned need = (unsigned)CAP - ngt;
    unsigned base_gt = 0, base_eq = 0;
#pragma unroll
    for (int j = 0; j < 16; ++j) {
        const bool gt = bits[j] > tau, eq = bits[j] == tau;
        const unsigned long long bg = __ballot(gt), be = __ballot(eq);
        unsigned pgt = 0, peq = 0, tgt = 0, teq = 0;
#pragma unroll
        for (int w = 0; w < 8; ++w) { const unsigned cw = ctab[j * 8 + w], cg_ = cw & 0xffffu, ce = cw >> 16; if (w < wave) { pgt += cg_; peq += ce; } tgt += cg_; teq += ce; }
        const unsigned gt_before = base_gt + pgt + (unsigned)__popcll(bg & lt_mask), eq_before = base_eq + peq + (unsigned)__popcll(be & lt_mask);
        const bool sel = gt || (eq && eq_before < need);
        const unsigned slot = gt_before + (eq_before < need ? eq_before : need);
        const int i = j * 512 + tid;
        if (sel) { IDX[(e * 8 + b) * CAP + slot] = i; GSEL[(e * 8 + b) * CAP + slot] = __uint_as_float(bits[j]); }
        INV[((size_t)b * 8192 + i) * 16 + e] = sel ? (int)slot : -1;
        base_gt += tgt; base_eq += teq;
    }
    __syncthreads();
}
__device__ __forceinline__ void ph8(const Params& p, unsigned char* lds, int bid, int nblk) { for (int it = bid; it < 128; it += nblk) topk_item(p, lds, it); }


#define XB_TMO      128
#define XB_XCNT(j)  (256  + 64 * (j))
#define XB_XSUB(j)  (1280 + 64 * (j))
#define XB_XGEN(j)  (2304 + 64 * (j))
#define XB_TOP      3328
#define XB_TOPGEN   3392
#define XCD_BAR_WORDS 3456
#define XB_SPIN_CAP (1u << 18)
__device__ __forceinline__ unsigned xb_ld(unsigned* p)              { return __hip_atomic_load(p, __ATOMIC_RELAXED, __HIP_MEMORY_SCOPE_AGENT); }
__device__ __forceinline__ unsigned xb_add(unsigned* p, unsigned v) { return __hip_atomic_fetch_add(p, v, __ATOMIC_RELAXED, __HIP_MEMORY_SCOPE_AGENT); }
__device__ __forceinline__ unsigned xb_xcc_id() { return (unsigned)__builtin_amdgcn_s_getreg((3 << 11) | 20) & 0xFu; }
#define XB_SPIN(cond, bar) do { unsigned _sp = 0; while (cond) { __builtin_amdgcn_s_sleep(1); \
    if ((++_sp & 255u) == 0u) { if (xb_ld(&(bar)[XB_TMO])) break; if (_sp > XB_SPIN_CAP) { atomicAdd(&(bar)[XB_TMO], 1u); break; } } } } while (0)
struct XcdBarrier { unsigned* bar; unsigned x; volatile LAS unsigned* st; };
__device__ __forceinline__ XcdBarrier xcd_barrier_post(unsigned* bar, volatile LAS unsigned* st) {
    XcdBarrier b; b.bar = bar; b.x = xb_xcc_id(); b.st = st;
    if (threadIdx.x == 0) (void)xb_add(&bar[XB_XCNT(b.x)], 1u);
    return b;
}
__device__ __forceinline__ void xcd_barrier_complete(unsigned* bar, unsigned x, unsigned& nloc, unsigned& nx) {
    const unsigned G = gridDim.x * gridDim.y * gridDim.z;
    unsigned sum, cnt, mine, sp = 0u;
    for (;;) {
        sum = 0u; cnt = 0u; mine = 0u;
#pragma unroll
        for (unsigned j = 0; j < 16; ++j) { const unsigned c = xb_ld(&bar[XB_XCNT(j)]); sum += c; cnt += (c > 0u) ? 1u : 0u; mine = (j == x) ? c : mine; }
        if (sum == G) break;
        __builtin_amdgcn_s_sleep(1);
        if ((++sp & 255u) == 0u) { if (xb_ld(&bar[XB_TMO])) break; if (sp > XB_SPIN_CAP) { atomicAdd(&bar[XB_TMO], 1u); break; } }
    }
    nloc = mine > 0u ? mine : 1u; nx = cnt > 0u ? cnt : 1u;
}
__device__ __forceinline__ void xcd_barrier(const XcdBarrier& b) {
    asm volatile("s_waitcnt vmcnt(0)" ::: "memory");
    __syncthreads();
    if (threadIdx.x == 0) {
        unsigned* bar = b.bar;
        __builtin_amdgcn_s_waitcnt(0);
        unsigned nloc = b.st[0], nx = b.st[1];
        if (nloc == 0u) { xcd_barrier_complete(bar, b.x, nloc, nx); b.st[0] = nloc; b.st[1] = nx; }
        const unsigned old = xb_add(&bar[XB_XSUB(b.x)], 1u);
        const unsigned gen = old / nloc;
        if (old + 1u == (gen + 1u) * nloc) {
            __builtin_amdgcn_fence(__ATOMIC_RELEASE, "agent");
            asm volatile("s_waitcnt vmcnt(0)" ::: "memory");
            const unsigned og = xb_add(&bar[XB_TOP], 1u);
            const unsigned tg = og / nx;
            if (og + 1u == (tg + 1u) * nx) xb_add(&bar[XB_TOPGEN], 1u);
            else XB_SPIN(xb_ld(&bar[XB_TOPGEN]) == tg, bar);
            __builtin_amdgcn_fence(__ATOMIC_ACQUIRE, "agent");
            xb_add(&bar[XB_XGEN(b.x)], 1u);
            asm volatile("s_waitcnt vmcnt(0)" ::: "memory");
        } else {
            XB_SPIN(xb_ld(&bar[XB_XGEN(b.x)]) == gen, bar);
            __builtin_amdgcn_fence(__ATOMIC_ACQUIRE, "agent");
            asm volatile("s_waitcnt vmcnt(0)" ::: "memory");
        }
    }
    __syncthreads();
}

__device__ __forceinline__ pg8::GemmDesc make_desc(const Params& p, int gi) {
    pg8::GemmDesc g{};
    if (gi == 0) { g.A = p.ws + WS_XM; g.Bt = p.ws + WS_WINT; g.O = p.ws + WS_U; g.Kb = 2048; g.nM = MROWS / 256; g.nN = DINP / 256; g.epi = 0; g.ldc = DINP; g.qtiles = 2; }
    else if (gi == 1) { g.A = p.ws + WS_MIX; g.Bt = p.ws + WS_WOUTG; g.bEstride = (size_t)D_ * D_ * 2; g.O = p.ws + WS_Y; g.x = p.x; g.Kb = 2048; g.nM = NLAT / 256; g.nN = 4; g.epi = 2; g.ldc = 1024; }
    else if (gi == 2) { g.A = p.ws + WS_HMOD; g.Bt = p.ws + WS_WGUT; g.IDX = (const int*)(p.ws + WS_IDX); g.O = p.ws + WS_ACT; g.bEstride = (size_t)2 * DFF * 1024; g.Kb = 1024; g.nM = NE * 32; g.nN = 22; g.epi = 1; g.ldc = DFF; }
    else { g.A = p.ws + WS_ACT; g.Bt = p.ws + WS_WDT; g.O = p.ws + WS_EO; g.bEstride = (size_t)1024 * DFF; g.Kb = DFF; g.nM = NE * 32; g.nN = 4; g.epi = 3; g.ldc = 1024; }
    return g;
}

__device__ __forceinline__ void ph_final(const Params& p, int bid, int nblk) {
    const int tid = ltid(), lane = tid & 63, wave = tid >> 6;
    const GAS float* MOD = (const GAS float*)(p.ws + WS_MOD); const GAS bf16_t* EO = (const GAS bf16_t*)(p.ws + WS_EO); const GAS float* GSEL = (const GAS float*)(p.ws + WS_GSEL); const GAS int* INV = (const GAS int*)(p.ws + WS_INV);
    const GAS bf16_t* Y = (const GAS bf16_t*)(p.ws + WS_Y); GAS float* OUT = (GAS float*)p.out; const GAS float* ln1g = (const GAS float*)p.ln1_g; const GAS float* ln1b = (const GAS float*)p.ln1_b; const GAS float* ln2g = (const GAS float*)p.ln2_g; const GAS float* ln2b = (const GAS float*)p.ln2_b;
    constexpr int NPF = 3;
    const int mstride = nblk * NWAVES;
    int m = bid * NWAVES + wave;
    u32x2 vn[4]; int inv1 = -1, inv2 = -1;
    u32x2 pe[NPF][4]; float pg[NPF];
#define FIN_PREFETCH(row_, inv_) do { unsigned _em = (unsigned)__ballot((inv_) >= 0); const int _bb = (row_) >> 13; \
        _Pragma("unroll") for (int _t = 0; _t < NPF; ++_t) { \
            if (_em) { const int _e = __builtin_ctz(_em); _em &= _em - 1u; const int _slot = __builtin_amdgcn_readlane((inv_), _e); \
                pg[_t] = GSEL[(_e * 8 + _bb) * CAP + _slot]; const GAS bf16_t* _rp = EO + ((size_t)_e * 8192 + _bb * 1024 + _slot) * 1024; \
                _Pragma("unroll") for (int j = 0; j < 4; ++j) pe[_t][j] = *(const GAS u32x2*)(_rp + j * 256 + lane * 4); } \
            else { pg[_t] = 0.f; _Pragma("unroll") for (int j = 0; j < 4; ++j) pe[_t][j] = (u32x2){0u, 0u}; } } } while (0)
    if (m < NLAT) { inv1 = lane < 16 ? INV[(size_t)m * 16 + lane] : -1;
#pragma unroll
        for (int j = 0; j < 4; ++j) vn[j] = *(const GAS u32x2*)(Y + (size_t)m * 1024 + j * 256 + lane * 4);
        if (m + mstride < NLAT) inv2 = lane < 16 ? INV[(size_t)(m + mstride) * 16 + lane] : -1;
        FIN_PREFETCH(m, inv1); }
    for (; m < NLAT; m += mstride) {
        const int b = m >> 13;
        GAS float* y = OUT + (size_t)m * 1024; const GAS float* g2 = MOD + b * 6144 + 5120;
        const int myinv = inv1;
        f32x4 v[4]; float s = 0.f;
#pragma unroll
        for (int j = 0; j < 4; ++j) { v[j] = (f32x4){hlo(vn[j].x), hhi(vn[j].x), hlo(vn[j].y), hhi(vn[j].y)}; s += (v[j].x + v[j].y) + (v[j].z + v[j].w); }
        f32x4 moe[4];
#pragma unroll
        for (int j = 0; j < 4; ++j) moe[j] = (f32x4){0.f, 0.f, 0.f, 0.f};
        unsigned emask = (unsigned)__ballot(myinv >= 0);
#pragma unroll
        for (int t = 0; t < NPF; ++t) { if (emask) { emask &= emask - 1u; const float g = pg[t];
#pragma unroll
            for (int j = 0; j < 4; ++j) { const u32x2 w = pe[t][j]; moe[j].x += g * bflo(w.x); moe[j].y += g * bfhi(w.x); moe[j].z += g * bflo(w.y); moe[j].w += g * bfhi(w.y); } } }
        { const int mn = m + mstride; inv1 = inv2;
          if (mn < NLAT) {
#pragma unroll
              for (int j = 0; j < 4; ++j) vn[j] = *(const GAS u32x2*)(Y + (size_t)mn * 1024 + j * 256 + lane * 4);
              inv2 = (mn + mstride < NLAT && lane < 16) ? INV[(size_t)(mn + mstride) * 16 + lane] : -1;
              FIN_PREFETCH(mn, inv1); } }
        while (emask) {
            const int e = __builtin_ctz(emask); emask &= emask - 1u;
            const int slot = __builtin_amdgcn_readlane(myinv, e);
            const float g = GSEL[(e * 8 + b) * CAP + slot];
            const GAS bf16_t* row = EO + ((size_t)e * 8192 + b * 1024 + slot) * 1024;
#pragma unroll
            for (int j = 0; j < 4; ++j) { const u32x2 w = *(const GAS u32x2*)(row + j * 256 + lane * 4); moe[j].x += g * bflo(w.x); moe[j].y += g * bfhi(w.x); moe[j].z += g * bflo(w.y); moe[j].w += g * bfhi(w.y); }
        }
        const float mean = wave_sum(s) * (1.f / 1024.f); float s2 = 0.f;
#pragma unroll
        for (int j = 0; j < 4; ++j) { v[j] = v[j] - mean; s2 += (v[j].x * v[j].x + v[j].y * v[j].y) + (v[j].z * v[j].z + v[j].w * v[j].w); }
        const float rstd = rsqrtf(wave_sum(s2) * (1.f / 1024.f) + LN_EPS);
        float s3 = 0.f;
#pragma unroll
        for (int j = 0; j < 4; ++j) { const int k = j * 256 + lane * 4;
            const f32x4 g = *(const GAS f32x4*)(ln1g + k), be = *(const GAS f32x4*)(ln1b + k), gg = *(const GAS f32x4*)(g2 + k);
            v[j] = ALPHA * (v[j] * rstd * g + be) + gg * moe[j]; s3 += (v[j].x + v[j].y) + (v[j].z + v[j].w); }
        const float mean2 = wave_sum(s3) * (1.f / 1024.f); float s4 = 0.f;
#pragma unroll
        for (int j = 0; j < 4; ++j) { v[j] = v[j] - mean2; s4 += (v[j].x * v[j].x + v[j].y * v[j].y) + (v[j].z * v[j].z + v[j].w * v[j].w); }
        const float rstd2 = rsqrtf(wave_sum(s4) * (1.f / 1024.f) + LN_EPS);
#pragma unroll
        for (int j = 0; j < 4; ++j) { const int k = j * 256 + lane * 4; const f32x4 g = *(const GAS f32x4*)(ln2g + k), be = *(const GAS f32x4*)(ln2b + k);
            __builtin_nontemporal_store(v[j] * rstd2 * g + be, (GAS f32x4*)(y + k)); }
    }
}

constexpr int NPHASE = 12;
#ifndef ONLY_PH
#define ONLY_PH -1
#endif
#define PH_EN(n) (ONLY_PH < 0 || ONLY_PH == (n))
__global__ void __launch_bounds__(NTHR, 2) mk_fwd(Params p) {
    extern __shared__ __attribute__((aligned(16))) unsigned char lds[];
    const int bid = blockIdx.x, nblk = gridDim.x;
    volatile LAS unsigned* MISC = (volatile LAS unsigned*)((LAS unsigned char*)lds + (LDS_BYTES - 16));
    if (threadIdx.x < 4) MISC[threadIdx.x] = 0u;
    __syncthreads();
    const XcdBarrier xbar = xcd_barrier_post((unsigned*)(p.ws + WS_CTL) + 4096, MISC);
#ifndef PHMASK
#define PHMASK 0xffff
#endif
#define IN(k) ((((PHMASK) >> (k)) & 1) && p.ph_lo <= (k) && (k) < p.ph_hi)
#define LOADP() load_params()
#define LAUNDER() const int bid_ = bid, nblk_ = nblk; unsigned char* const lds_ = lds
#define SEAM(k) do { if (IN(k) && IN((k) + 1)) xcd_barrier(xbar); } while (0)
    if (IN(0)) for (int rep_ = 0; rep_ < REPN(0); ++rep_) { const Params q = LOADP(); LAUNDER(); ph0(q, lds_, bid_, nblk_); }
    SEAM(0);
    if (IN(1)) for (int rep_ = 0; rep_ < REPN(1); ++rep_) { const Params q = LOADP(); LAUNDER(); ph1(q, bid_, nblk_); }
    SEAM(1);
    if (IN(2)) for (int rep_ = 0; rep_ < REPN(2); ++rep_) { const Params q = load_params_s(); LAUNDER(); const pg8::GemmDesc g = make_desc(q, 0); pg8::gemm_phase<false, false>((LAS unsigned char*)lds, g, nblk_, bid_); }
    SEAM(2);
    if (IN(3)) for (int rep_ = 0; rep_ < REPN(3); ++rep_) { const Params q = LOADP(); LAUNDER(); ph3(q, lds_, bid_, nblk_); }
    SEAM(3);
    if (IN(4)) for (int rep_ = 0; rep_ < REPN(4); ++rep_) { const Params q = LOADP(); LAUNDER(); ph4(q, bid_, nblk_); }
    SEAM(4);
    if (IN(5)) for (int rep_ = 0; rep_ < REPN(5); ++rep_) { const Params q = LOADP(); LAUNDER(); ph5(q, lds_, bid_, nblk_); }
    SEAM(5);
    if (IN(6)) for (int rep_ = 0; rep_ < REPN(6); ++rep_) { const Params q = load_params_s(); LAUNDER(); const int grp_ = (bid_ >> 5) & 1;
        if (grp_ == 0) ph7_conv(q, lds_, bid_, nblk_);
        { const pg8::GemmDesc g = make_desc(q, 1); pg8::gemm_phase<false, false>((LAS unsigned char*)lds, g, nblk_, bid_); }
        if (grp_ != 0) { const Params q2 = LOADP(); ph7_conv(q2, lds_, bid_, nblk_); } }
    SEAM(6);
    if (IN(7)) for (int rep_ = 0; rep_ < REPN(7); ++rep_) { const Params q = LOADP(); LAUNDER(); ph7(q, lds_, bid_, nblk_); }
    SEAM(7);
    if (IN(8)) for (int rep_ = 0; rep_ < REPN(8); ++rep_) { const Params q = LOADP(); LAUNDER(); ph8(q, lds_, bid_, nblk_); }
    SEAM(8);
#pragma unroll 1
    for (int st = 2; st < 4; ++st) {
        if (IN(7 + st)) for (int rep_ = 0; rep_ < REPN(9); ++rep_) { const Params q = load_params_s(); LAUNDER(); const pg8::GemmDesc g = make_desc(q, st); pg8::gemm_phase<true, true>((LAS unsigned char*)lds, g, nblk_, bid_); }
        SEAM(7 + st);
    }
    if (IN(11)) for (int rep_ = 0; rep_ < REPN(11); ++rep_) { const Params q = LOADP(); LAUNDER(); ph_final(q, bid_, nblk_); }
#undef IN
#undef SEAM
}

extern "C" void kernel_launch(void* const* d_in, const int* in_sizes, int n_in, void* d_out, int out_size, void* d_ws, size_t ws_size, hipStream_t stream) {
    static int grid_blocks = 0;
    if (grid_blocks == 0) {
        if (n_in != 20 || out_size != NLAT * D_ || ws_size < WS_WOUTG + (size_t)NB * D_ * D_ * 2 || ws_size < WS_END) { fprintf(stderr, "kernel_launch: unexpected shapes (n_in %d out %d ws %zu need %zu)\n", n_in, out_size, ws_size, (size_t)WS_END); grid_blocks = -1; return; }
        int dev = 0, cus = 0, per_cu = 0;
        if (hipGetDevice(&dev) != hipSuccess || hipDeviceGetAttribute(&cus, hipDeviceAttributeMultiprocessorCount, dev) != hipSuccess) { grid_blocks = -1; return; }
        if (hipFuncSetAttribute((const void*)mk_fwd, hipFuncAttributeMaxDynamicSharedMemorySize, LDS_BYTES) != hipSuccess) { fprintf(stderr, "kernel_launch: hipFuncSetAttribute failed\n"); grid_blocks = -1; return; }
        if (hipOccupancyMaxActiveBlocksPerMultiprocessor(&per_cu, (const void*)mk_fwd, NTHR, LDS_BYTES) != hipSuccess || per_cu < 1) { fprintf(stderr, "kernel_launch: occupancy query failed (%d)\n", per_cu); grid_blocks = -1; return; }
        grid_blocks = cus * per_cu;
    }
    if (grid_blocks < 0) return;
    if (hipMemsetAsync((char*)d_ws + WS_CTL, 0, 65536, stream) != hipSuccess) { fprintf(stderr, "kernel_launch: hipMemsetAsync failed\n"); return; }
    Params p{};
    const float** pp = (const float**)&p;
    for (int i = 0; i < 20; ++i) pp[i] = (const float*)d_in[i];
    p.out = (float*)d_out; p.ws = (unsigned char*)d_ws;
    p.ph_lo = 0; p.ph_hi = NPHASE;
    void* args[] = {&p};
    hipError_t e = hipLaunchCooperativeKernel((const void*)mk_fwd, dim3(grid_blocks), dim3(NTHR), args, LDS_BYTES, stream);
    if (e != hipSuccess) fprintf(stderr, "cooperative launch failed: %s (grid %d)\n", hipGetErrorString(e), grid_blocks);
}
```

```cpp
#include <hip/hip_runtime.h>
#include <hip/hip_cooperative_groups.h>
#include <cstdio>
#include <cstdint>
namespace cg = cooperative_groups;
#ifndef REPMASK
#define REPMASK 0
#endif
#define REPN(k) ((((REPMASK) >> (k)) & 1) ? 2 : 1)

typedef unsigned short bf16_t;
#define GAS __attribute__((address_space(1)))
typedef float f32x4 __attribute__((ext_vector_type(4)));
typedef unsigned u32x4 __attribute__((ext_vector_type(4)));
typedef unsigned u32x2 __attribute__((ext_vector_type(2)));

constexpr int NB = 8, T_ = 8192, D_ = 1024, LC = 256;
constexpr int NLAT = NB * T_, NCTX = NB * LC, MROWS = NLAT + NCTX;
constexpr int DIN = 3088, DINP = 3328;
constexpr int NE = 16, CAP = 1024, DFF = 2816;
constexpr int C_QA = 0, C_KA = 512, C_VA = 1024, C_QM = 1536, C_KM = 1792, C_VM = 2048, C_OM = 2560, C_GT = 3072;
constexpr int NCH = 66;
constexpr float LN_EPS = 1e-5f;
constexpr float ALPHA = 1.189207115002721f;
constexpr int NGROUPS = 1, EPG = NE / NGROUPS;

constexpr int NTHR = 512, NWAVES = 8;
constexpr int LDS_BYTES = 163840;

constexpr size_t MiB = 1u << 20;
constexpr size_t WS_CTL = 0;
constexpr size_t WS_MOD = 1 * MiB;
constexpr size_t WS_ROPE = 1 * MiB + 256 * 1024;
constexpr size_t WS_BLAST = 1 * MiB + 512 * 1024;
constexpr size_t WS_MLOC = WS_BLAST + 32 * 1024;
constexpr size_t WS_MIN = WS_MLOC + 32 * 1024;
constexpr size_t WS_NLOC = 2 * MiB;
constexpr size_t WS_IDX = 4 * MiB;
constexpr size_t WS_GSEL = 4 * MiB + 512 * 1024;
constexpr size_t WS_AFF = 5 * MiB;
constexpr size_t WS_INV = 9 * MiB;
constexpr size_t WS_WINT = 16 * MiB;
constexpr size_t WS_WOUTT = 23 * MiB;
constexpr size_t WS_XM = 32 * MiB;
constexpr size_t WS_U = 164 * MiB;
constexpr size_t WS_QP = 593 * MiB;
constexpr size_t WS_KP = 625 * MiB;
constexpr size_t WS_CLOC = 658 * MiB;
constexpr size_t WS_MIX = 32 * MiB;
constexpr size_t WS_WOUTG = 948 * MiB;
constexpr size_t WS_Y = 820 * MiB;
constexpr size_t WS_HMOD = 16 * MiB;
constexpr size_t WS_WGUT = 688 * MiB;
constexpr size_t WS_WDT = 776 * MiB;
constexpr size_t WS_EO = 80 * MiB;
constexpr size_t WS_ACT = 336 * MiB;
constexpr size_t WS_END = WS_WDT + (size_t)NE * D_ * DFF;
static_assert(WS_XM + (size_t)MROWS * D_ * 2 <= WS_U, "map");
static_assert(WS_U + (size_t)MROWS * DINP * 2 <= WS_QP, "map");
static_assert(WS_KP + (size_t)MROWS * 256 * 2 <= WS_CLOC, "map");
static_assert(WS_CLOC + (size_t)64 * NCH * 8192 * 4 <= WS_Y, "map");
static_assert(WS_MIX + (size_t)NLAT * D_ * 2 <= WS_U, "map");
static_assert(WS_Y + (size_t)NLAT * D_ * 2 <= WS_WOUTG && WS_WOUTG + (size_t)NB * D_ * D_ * 2 <= 1024 * MiB, "map");
static_assert(WS_HMOD + (size_t)NLAT * D_ <= WS_EO && WS_EO + (size_t)NE * 8192 * D_ * 2 <= WS_ACT, "map");
static_assert(WS_ACT + (size_t)NE * 8192 * DFF <= WS_WGUT && WS_WGUT + (size_t)NE * 2 * DFF * D_ <= WS_WDT, "map");
static_assert(WS_MIX + (size_t)NLAT * D_ * 2 <= WS_WGUT && WS_CLOC <= WS_WGUT, "map");
static_assert(WS_END <= WS_Y, "map");

struct Params {
    const float *x, *c, *ctx, *c_ctx, *w_ada, *b_ada, *w_in, *b_gate, *conv_qk, *na_bias, *ml_norm_g, *w_out,
        *ln1_g, *ln1_b, *w_router, *w_eg, *w_eu, *w_ed, *ln2_g, *ln2_b;
    float* out; unsigned char* ws;
    int ph_lo, ph_hi;
};


template <class T> __device__ __forceinline__ T* as_global(T* p) { return (T*)(__attribute__((address_space(1))) T*)p; }
__device__ __forceinline__ Params load_params_s() {
    const Params* kp = (const Params*)__builtin_amdgcn_kernarg_segment_ptr(); asm volatile("" : "+s"(kp));
    const __attribute__((address_space(4))) unsigned long long* kc = (const __attribute__((address_space(4))) unsigned long long*)(unsigned long long)kp;
    Params q;
    q.x = (const float*)kc[0]; q.c = (const float*)kc[1]; q.ctx = (const float*)kc[2]; q.c_ctx = (const float*)kc[3]; q.w_ada = (const float*)kc[4]; q.b_ada = (const float*)kc[5]; q.w_in = (const float*)kc[6];
    q.b_gate = (const float*)kc[7]; q.conv_qk = (const float*)kc[8]; q.na_bias = (const float*)kc[9]; q.ml_norm_g = (const float*)kc[10]; q.w_out = (const float*)kc[11];
    q.ln1_g = (const float*)kc[12]; q.ln1_b = (const float*)kc[13]; q.w_router = (const float*)kc[14]; q.w_eg = (const float*)kc[15]; q.w_eu = (const float*)kc[16]; q.w_ed = (const float*)kc[17];
    q.ln2_g = (const float*)kc[18]; q.ln2_b = (const float*)kc[19]; q.out = (float*)kc[20]; q.ws = (unsigned char*)kc[21];
    { const unsigned long long ph = kc[22]; q.ph_lo = (int)(unsigned)ph; q.ph_hi = (int)(unsigned)(ph >> 32); }
    q.x = as_global(q.x); q.c = as_global(q.c); q.ctx = as_global(q.ctx); q.c_ctx = as_global(q.c_ctx); q.w_ada = as_global(q.w_ada); q.b_ada = as_global(q.b_ada); q.w_in = as_global(q.w_in);
    q.b_gate = as_global(q.b_gate); q.conv_qk = as_global(q.conv_qk); q.na_bias = as_global(q.na_bias); q.ml_norm_g = as_global(q.ml_norm_g); q.w_out = as_global(q.w_out);
    q.ln1_g = as_global(q.ln1_g); q.ln1_b = as_global(q.ln1_b); q.w_router = as_global(q.w_router); q.w_eg = as_global(q.w_eg); q.w_eu = as_global(q.w_eu); q.w_ed = as_global(q.w_ed);
    q.ln2_g = as_global(q.ln2_g); q.ln2_b = as_global(q.ln2_b); q.out = as_global(q.out); q.ws = as_global(q.ws);
    return q;
}
__device__ __forceinline__ Params load_params() {
    const Params* kp = (const Params*)__builtin_amdgcn_kernarg_segment_ptr(); asm volatile("" : "+s"(kp));
    Params q = *kp;
    q.x = as_global(q.x); q.c = as_global(q.c); q.ctx = as_global(q.ctx); q.c_ctx = as_global(q.c_ctx); q.w_ada = as_global(q.w_ada); q.b_ada = as_global(q.b_ada); q.w_in = as_global(q.w_in);
    q.b_gate = as_global(q.b_gate); q.conv_qk = as_global(q.conv_qk); q.na_bias = as_global(q.na_bias); q.ml_norm_g = as_global(q.ml_norm_g); q.w_out = as_global(q.w_out);
    q.ln1_g = as_global(q.ln1_g); q.ln1_b = as_global(q.ln1_b); q.w_router = as_global(q.w_router); q.w_eg = as_global(q.w_eg); q.w_eu = as_global(q.w_eu); q.w_ed = as_global(q.w_ed);
    q.ln2_g = as_global(q.ln2_g); q.ln2_b = as_global(q.ln2_b); q.out = as_global(q.out); q.ws = as_global(q.ws);
    return q;
}
__device__ __forceinline__ float bf2f(bf16_t v) { return __uint_as_float((unsigned)v << 16); }
__device__ __forceinline__ unsigned f2bf(float f) { unsigned u = __float_as_uint(f); return (u + 0x7fffu + ((u >> 16) & 1u)) >> 16; }
__device__ __forceinline__ unsigned pk2(float lo, float hi) { return f2bf(lo) | (f2bf(hi) << 16); }
__device__ __forceinline__ float bflo(unsigned w) { return __uint_as_float(w << 16); }
__device__ __forceinline__ float bfhi(unsigned w) { return __uint_as_float(w & 0xffff0000u); }
typedef _Float16 f16x2 __attribute__((ext_vector_type(2)));
typedef float f32x2_ __attribute__((ext_vector_type(2)));
__device__ __forceinline__ unsigned pk_f16(float lo, float hi) {
    const f32x2_ v = {__builtin_amdgcn_fmed3f(lo, -65504.f, 65504.f), __builtin_amdgcn_fmed3f(hi, -65504.f, 65504.f)};
    const f16x2 h = __builtin_convertvector(v, f16x2); return __builtin_bit_cast(unsigned, h); }
__device__ __forceinline__ float hlo(unsigned w) { const f16x2 h = __builtin_bit_cast(f16x2, w); return (float)h.x; }
__device__ __forceinline__ float hhi(unsigned w) { const f16x2 h = __builtin_bit_cast(f16x2, w); return (float)h.y; }
template <int CTRL> __device__ __forceinline__ float dpp_mov(float v) { return __int_as_float(__builtin_amdgcn_update_dpp(0, __float_as_int(v), CTRL, 0xF, 0xF, true)); }
__device__ __forceinline__ float lane_bcast(float v, int l) { return __int_as_float(__builtin_amdgcn_readlane(__float_as_int(v), l)); }
__device__ __forceinline__ float wave_sum(float v) {
    v += dpp_mov<0xB1>(v);
    v += dpp_mov<0x4E>(v);
    v += dpp_mov<0x141>(v);
    v += dpp_mov<0x140>(v);
    return (lane_bcast(v, 0) + lane_bcast(v, 16)) + (lane_bcast(v, 32) + lane_bcast(v, 48));
}
__device__ __forceinline__ float wave_max(float v) {
    v = fmaxf(v, dpp_mov<0xB1>(v)); v = fmaxf(v, dpp_mov<0x4E>(v)); v = fmaxf(v, dpp_mov<0x141>(v)); v = fmaxf(v, dpp_mov<0x140>(v));
    return fmaxf(fmaxf(lane_bcast(v, 0), lane_bcast(v, 16)), fmaxf(lane_bcast(v, 32), lane_bcast(v, 48)));
}

__device__ __forceinline__ float wscan_add(float v, int lane) {
#pragma unroll
    for (int o = 1; o < 64; o <<= 1) { const float t = __shfl_up(v, o); if (lane >= o) v += t; }
    return v;
}
__device__ __forceinline__ float wscan_max(float v, int lane) {
#pragma unroll
    for (int o = 1; o < 64; o <<= 1) { const float t = __shfl_up(v, o); if (lane >= o) v = fmaxf(v, t); }
    return v;
}
typedef short bf16x8_t __attribute__((ext_vector_type(8)));
typedef short bf16x4_t __attribute__((ext_vector_type(4)));
typedef float f32x2_t __attribute__((ext_vector_type(2)));
typedef __bf16 bf16x2_t __attribute__((ext_vector_type(2)));
__device__ __forceinline__ unsigned cvtpk(float lo, float hi) { const f32x2_t v = {lo, hi}; const bf16x2_t b = __builtin_convertvector(v, bf16x2_t); return __builtin_bit_cast(unsigned, b); }
__device__ __forceinline__ float siluf(float v) { return v * __builtin_amdgcn_rcpf(1.f + __expf(-v)); }
__device__ __forceinline__ float sigmoidf_(float v) { return __builtin_amdgcn_rcpf(1.f + __expf(-v)); }
__device__ __forceinline__ float logsigf(float v) { return fminf(v, 0.f) - log1pf(__expf(-fabsf(v))); }
__device__ __forceinline__ int ltid() { int t = threadIdx.x; asm volatile("" : "+v"(t)); return t; }
#define FP8EMU 0
__device__ __forceinline__ float q8(float x) { const int p = __builtin_amdgcn_cvt_pk_fp8_f32(x, x, 0, false); return __builtin_amdgcn_cvt_f32_fp8(p, 0); }
__device__ __forceinline__ unsigned pk4_fp8(float a, float b, float c, float d) { int w = __builtin_amdgcn_cvt_pk_fp8_f32(a, b, 0, false); w = __builtin_amdgcn_cvt_pk_fp8_f32(c, d, w, true); return (unsigned)w; }
#define LDS_FENCE() asm volatile("s_waitcnt lgkmcnt(0)" ::: "memory")

__device__ __forceinline__ void ph_ada_item(const Params& p, unsigned char* lds, int item) {
    float* sc = (float*)lds;
    float* red = sc + 9 * 1024;
    const int tid = ltid();
    float* MOD = (float*)(p.ws + WS_MOD);
    for (int i = tid; i < 9 * 1024; i += NTHR) { const int r = i >> 10, k = i & 1023; const float v = r < 8 ? p.c[r * 1024 + k] : p.c_ctx[k]; sc[i] = v / (1.f + expf(-v)); }
    __syncthreads();
    const int col = item * 64 + (tid & 63), ks = tid >> 6;
    float acc[9];
#pragma unroll
    for (int r = 0; r < 9; ++r) acc[r] = 0.f;
    { const GAS float* wa = (const GAS float*)p.w_ada + col;
      for (int k = ks * 128; k < ks * 128 + 128; k += 16) {
          float w[16];
#pragma unroll
          for (int u = 0; u < 16; ++u) w[u] = wa[(size_t)(k + u) * 6144];
#pragma unroll
          for (int u = 0; u < 16; ++u)
#pragma unroll
              for (int r = 0; r < 9; ++r) acc[r] += sc[r * 1024 + k + u] * w[u];
      } }
#pragma unroll
    for (int r = 0; r < 9; ++r) red[(ks * 64 + (tid & 63)) * 9 + r] = acc[r];
    __syncthreads();
    if (tid < 64) {
#pragma unroll
        for (int r = 0; r < 9; ++r) { float s = p.b_ada[col]; for (int k2 = 0; k2 < 8; ++k2) s += red[(k2 * 64 + tid) * 9 + r]; MOD[r * 6144 + col] = s; }
    }
    __syncthreads();
}
__device__ __forceinline__ void transpose_item(const float* W, int N, int k0, int n0, int nvalid, bf16_t* WT, size_t orow0, int ldt, float* scr, int lane) {
#pragma unroll 8
    for (int i = 0; i < 32; ++i) { const int kk = 2 * i + (lane >> 5), nn = lane & 31; scr[kk * 33 + nn] = nn < nvalid ? W[(size_t)(k0 + kk) * N + n0 + nn] : 0.f; }
    LDS_FENCE();
    const int c = lane & 7;
#pragma unroll
    for (int j = 0; j < 4; ++j) {
        const int n = (lane >> 3) + 8 * j; const float* s = scr + (8 * c) * 33 + n;
        u32x4 o; o.x = pk2(s[0 * 33], s[1 * 33]); o.y = pk2(s[2 * 33], s[3 * 33]); o.z = pk2(s[4 * 33], s[5 * 33]); o.w = pk2(s[6 * 33], s[7 * 33]);
        *(u32x4*)(WT + (orow0 + n) * ldt + k0 + 8 * c) = o;
    }
    LDS_FENCE();
}
__device__ __forceinline__ void ph0(const Params& p, unsigned char* lds, int bid, int nblk) {
    __syncthreads();
    for (int it = bid; it < 96; it += nblk) ph_ada_item(p, lds, it);
    const int tid = ltid(), lane = tid & 63, wave = tid >> 6;
    float* scr = (float*)lds + wave * (64 * 33);
    bf16_t* WINT = (bf16_t*)(p.ws + WS_WINT); bf16_t* WOUTT = (bf16_t*)(p.ws + WS_WOUTT);
    const int gw = bid * NWAVES + wave, ngw = nblk * NWAVES;
    constexpr int I_IN = 16 * 97, I_OUT = 16 * 32;
    for (int it = gw; it < I_IN + I_OUT; it += ngw) {
        if (it < I_IN) { const int kb = it / 97, nb = it % 97; const int n0 = nb * 32; const int nv = (DIN - n0) < 32 ? (DIN - n0) : 32; transpose_item(p.w_in, DIN, kb * 64, n0, nv, WINT, (size_t)n0, 1024, scr, lane); }
        else { const int r = it - I_IN; const int kb = r / 32, nb = r % 32; transpose_item(p.w_out, 1024, kb * 64, nb * 32, 32, WOUTT, (size_t)nb * 32, 1024, scr, lane); }
    }
    { float* ROPE = (float*)(p.ws + WS_ROPE); for (int idx = bid * NTHR + tid; idx < 2048; idx += nblk * NTHR) { const int pos = idx >> 4, i = idx & 15;
        const float inv = exp2f(-(float)i * (13.287712379549449f / 16.f)); float sn, cs_; sincosf((float)pos * inv, &sn, &cs_); ROPE[idx * 2] = cs_; ROPE[idx * 2 + 1] = sn; } }
    { const size_t n16 = (size_t)(DINP - 3104) * 1024 * 2 / 16; u32x4* z = (u32x4*)(WINT + (size_t)3104 * 1024);
      for (size_t i = (size_t)bid * NTHR + tid; i < n16; i += (size_t)nblk * NTHR) z[i] = (u32x4){0u, 0u, 0u, 0u}; }
}

__device__ __forceinline__ void ph1(const Params& p, int bid, int nblk) {
    const int tid = ltid(), lane = tid & 63, wave = tid >> 6;
    const GAS float* MOD = (const GAS float*)(p.ws + WS_MOD); GAS bf16_t* XM = (GAS bf16_t*)(p.ws + WS_XM);
    const GAS float* xs = (const GAS float*)p.x; const GAS float* cs = (const GAS float*)p.ctx;
    const int nw = nblk * NWAVES, gw = bid * NWAVES + wave, per = (MROWS + nw - 1) / nw, m_beg = gw * per, m_end = min(m_beg + per, MROWS);
    { const GAS bf16_t* WT = (const GAS bf16_t*)(p.ws + WS_WOUTT); GAS bf16_t* WG = (GAS bf16_t*)(p.ws + WS_WOUTG);
      for (int i = bid * NTHR + tid; i < NB * 1024 * 128; i += nblk * NTHR) { const int b = i >> 17, n = (i >> 7) & 1023, k8 = (i & 127) * 8;
          const float g = MOD[b * 6144 + 2048 + n]; const u32x4 w = *(const GAS u32x4*)(WT + (size_t)n * 1024 + k8); u32x4 o;
          o.x = pk2(g * bflo(w.x), g * bfhi(w.x)); o.y = pk2(g * bflo(w.y), g * bfhi(w.y)); o.z = pk2(g * bflo(w.z), g * bfhi(w.z)); o.w = pk2(g * bflo(w.w), g * bfhi(w.w));
          *(GAS u32x4*)(WG + ((size_t)b * 1024 + n) * 1024 + k8) = o; } }
    int rcur = -1; f32x4 sa[4], sb[4];
    for (int m0 = m_beg; m0 < m_end; m0 += 4) {
        f32x4 v[4][4]; int rr_[4];
#pragma unroll
        for (int i = 0; i < 4; ++i) { const int m = min(m0 + i, m_end - 1); rr_[i] = m < NLAT ? (m >> 13) : 8;
            const GAS float* src = m < NLAT ? xs + (size_t)m * 1024 : cs + (size_t)(m - NLAT) * 1024;
#pragma unroll
            for (int j = 0; j < 4; ++j) v[i][j] = __builtin_nontemporal_load((const GAS f32x4*)(src + j * 256 + lane * 4)); }
#pragma unroll
        for (int i = 0; i < 4; ++i) { if (m0 + i < m_end) {
            if (rr_[i] != rcur) { rcur = rr_[i];
#pragma unroll
                for (int j = 0; j < 4; ++j) { sb[j] = *(const GAS f32x4*)(MOD + rcur * 6144 + j * 256 + lane * 4); sa[j] = *(const GAS f32x4*)(MOD + rcur * 6144 + 1024 + j * 256 + lane * 4) + 1.f; } }
#pragma unroll
            for (int j = 0; j < 4; ++j) { const f32x4 r = v[i][j] * sa[j] + sb[j]; u32x2 o; o.x = pk2(r.x, r.y); o.y = pk2(r.z, r.w);
                *(GAS u32x2*)(XM + (size_t)(m0 + i) * 1024 + j * 256 + lane * 4) = o; } } }
    }
}


#define LAS __attribute__((address_space(3)))
typedef short bf16x8 __attribute__((ext_vector_type(8)));
typedef int i32x8 __attribute__((ext_vector_type(8)));
constexpr float NA_C2 = 0.125f * 1.4426950408889634f;
namespace pg8 {
constexpr int BM = 256, BK = 64, HALF = 128, HTB = HALF * BK * 2, STAGE_BYTES = 8 * HTB, NXCD = 8, WGM = 8;
constexpr int TAB_OFF = STAGE_BYTES;
__device__ __forceinline__ int lds_byte(int r, int c) { const int st = (r >> 4) * 2 + (c >> 5), rr = r & 15, cc = c & 31, ob = rr * 64 + cc * 2; return st * 1024 + (ob ^ (((ob >> 9) & 1) << 5)); }
__device__ __forceinline__ void stage_rc(int b, int& R, int& C) { const int st = b / 1024, sb = b % 1024, swz = sb ^ (((sb >> 9) & 1) << 5); R = (st >> 1) * 16 + swz / 64; C = (st & 1) * 32 + (swz % 64) / 2; }
__device__ __forceinline__ int perm32(int rho) { const int n = rho >> 4, i = rho & 15; return 8 * (i >> 2) + 4 * n + (i & 3); }
struct Unit { int pm, pn; };
struct StaticOrder {
    int nM, nN, nwg, G, c;
    __device__ void init(int nM_, int nN_, int G_, int c_) { nM = nM_; nN = nN_; nwg = nM * nN; G = G_; c = c_; }
    __device__ bool next(int i, Unit& u) const {
        const long L = (long)i * G + c; if (L >= nwg) return false;
        int wgid = (int)L; { const int q = nwg / NXCD, r = nwg % NXCD, xcd = wgid % NXCD, off = wgid / NXCD; wgid = (xcd < r ? xcd * (q + 1) : r * (q + 1) + (xcd - r) * q) + off; }
        const int nig = WGM * nN, gid = wgid / nig, fm = gid * WGM, gsz = (nM - fm) < WGM ? (nM - fm) : WGM;
        u.pm = fm + ((wgid % nig) % gsz); u.pn = (wgid % nig) / gsz; return true;
    }
};
__device__ __forceinline__ unsigned cvt_pk_bf16(float lo, float hi) { return cvtpk(lo, hi); }
struct GemmDesc { const void* A; const void* Bt; const int* IDX; void* O; const float* x; const float* MOD; size_t bEstride  ; int Kb  , egrp0, nM, nN, epi, ldc, qtiles  ; };

__device__ __forceinline__ void epilogue(const GemmDesc& g, const f32x4 (&acc)[2][2][4][2], const Unit& u, int wr, int wc, int fr, int fq) {
    if (g.epi == 0 || g.epi == 3) {
        const float sc = g.epi == 3 ? (1.f / 64.f) : (u.pn < g.qtiles ? NA_C2 : 1.f);
        GAS bf16_t* O = (GAS bf16_t*)g.O; const int row0 = u.pm * BM + wr * 64 + fr, col0 = u.pn * BM + wc * 32 + 8 * fq;
#pragma unroll
        for (int ai = 0; ai < 2; ++ai)
#pragma unroll
            for (int m = 0; m < 4; ++m) { GAS bf16_t* rowp = O + (size_t)(row0 + ai * HALF + m * 16) * g.ldc + col0;
#pragma unroll
                for (int bj = 0; bj < 2; ++bj) { const f32x4 v0 = acc[ai][bj][m][0] * sc, v1 = acc[ai][bj][m][1] * sc;
                    u32x4 w; w.x = cvt_pk_bf16(v0[0], v0[1]); w.y = cvt_pk_bf16(v0[2], v0[3]); w.z = cvt_pk_bf16(v1[0], v1[1]); w.w = cvt_pk_bf16(v1[2], v1[3]);
                    *(GAS u32x4*)(rowp + bj * HALF) = w; } }
    } else if (g.epi == 1) {
        GAS unsigned char* O = (GAS unsigned char*)g.O; const int row0 = u.pm * BM + wr * 64 + fr, col0 = u.pn * HALF + wc * 32 + 8 * fq;
#pragma unroll
        for (int ai = 0; ai < 2; ++ai)
#pragma unroll
            for (int m = 0; m < 4; ++m) { GAS unsigned char* rowp = O + (size_t)(row0 + ai * HALF + m * 16) * DFF + col0;
                float r[8];
#pragma unroll
                for (int n = 0; n < 2; ++n)
#pragma unroll
                    for (int jp = 0; jp < 2; ++jp) { const f32x2_ gg = {acc[ai][0][m][n][2 * jp], acc[ai][0][m][n][2 * jp + 1]}, uu = {acc[ai][1][m][n][2 * jp], acc[ai][1][m][n][2 * jp + 1]};
                        const f32x2_ a = gg * (-(1.f / 32.f) * 1.4426950408889634f); f32x2_ e = {__builtin_amdgcn_exp2f(a.x), __builtin_amdgcn_exp2f(a.y)};
                        e = e * 1024.f + 1024.f; const f32x2_ rc = {__builtin_amdgcn_rcpf(e.x), __builtin_amdgcn_rcpf(e.y)}; const f32x2_ rr = (gg * uu) * rc;
                        r[n * 4 + 2 * jp] = rr.x; r[n * 4 + 2 * jp + 1] = rr.y; }
                u32x2 w; w.x = pk4_fp8(r[0], r[1], r[2], r[3]); w.y = pk4_fp8(r[4], r[5], r[6], r[7]);
                *(GAS u32x2*)rowp = w; }
    } else {
        GAS bf16_t* Yo = (GAS bf16_t*)g.O; const int row0 = u.pm * BM + wr * 64 + fr, col0 = u.pn * BM + wc * 32 + 8 * fq;
#pragma unroll
        for (int ai = 0; ai < 2; ++ai)
#pragma unroll
            for (int m = 0; m < 4; ++m) { GAS bf16_t* rowp = Yo + (size_t)(row0 + ai * HALF + m * 16) * 1024 + col0;
#pragma unroll
                for (int bj = 0; bj < 2; ++bj) { const f32x4 y0 = acc[ai][bj][m][0], y1 = acc[ai][bj][m][1];
                    u32x4 w; w.x = pk_f16(y0[0], y0[1]); w.y = pk_f16(y0[2], y0[3]); w.z = pk_f16(y1[0], y1[1]); w.w = pk_f16(y1[2], y1[3]);
                    *(GAS u32x4*)(rowp + bj * HALF) = w; } }
    }
}

template <bool MAYGATHER, bool FP8>
__device__ __forceinline__ void gemm_phase(LAS unsigned char* lds, const GemmDesc g, int G, int c) {
    const int tid = ltid(), wid = __builtin_amdgcn_readfirstlane(tid >> 6), lane = tid & 63, wr = wid >> 2, wc = wid & 3, fr = lane & 15, fq = lane >> 4;
    const int Kb = g.Kb, nt = Kb / (BK * 2);
    const bool perm = true, gather = MAYGATHER && g.IDX != nullptr;
    StaticOrder S; S.init(g.nM, g.nN, G, c);
    unsigned voffB[2];
#pragma unroll
    for (int i = 0; i < 2; ++i) { int R, C; stage_rc(tid * 16 + i * 8192, R, C); const int Rb = perm ? ((R & ~31) + perm32(R & 31)) : R; voffB[i] = (unsigned)(Rb * Kb + C * 2); }
    const size_t kstep = (size_t)(BK * 2), hstep = (size_t)HALF * Kb, tstep = 2 * hstep;
    const unsigned ldsw = (unsigned)wid * 1024u;
    const int aoff = lds_byte(wr * 64 + fr, fq * 8), boff = lds_byte(wc * 32 + fr, fq * 8);
    LAS int* tab = (LAS int*)(lds + TAB_OFF);
#define PG8_SA(b, h) (((b) * 2 + (h)) * HTB)
#define PG8_SB(b, h) ((4 + (b) * 2 + (h)) * HTB)
#define PG8_UNI(p_) ({ const unsigned long long _v = (unsigned long long)(p_); (const GAS char*)(((unsigned long long)(unsigned)__builtin_amdgcn_readfirstlane((int)(_v >> 32)) << 32) | (unsigned)__builtin_amdgcn_readfirstlane((int)_v)); })
#define PG8_GLDS(gptr, ldsoff) __builtin_amdgcn_global_load_lds((const GAS unsigned*)(gptr), (LAS unsigned*)(lds + (ldsoff)), 16, 0, 0)
#define PG8_STAGE_B(bufoff, gbase) do { const GAS char* _gb = (const GAS char*)(gbase); _Pragma("unroll") for (int _i = 0; _i < 2; ++_i) { asm volatile("" : "+v"(voffB[_i])); PG8_GLDS(_gb + voffB[_i], (bufoff) + ldsw + _i * 8192); } } while (0)
#define PG8_STAGE_A(bufoff, kt, v0_, v1_) do { const GAS char* _b = (const GAS char*)g.A + (size_t)(kt) * kstep; asm volatile("" : "+v"(v0_), "+v"(v1_)); PG8_GLDS(_b + (v0_), (bufoff) + ldsw); PG8_GLDS(_b + (v1_), (bufoff) + ldsw + 8192); } while (0)
#define PG8_LDA(dst, b, h) do { _Pragma("unroll") for (int m = 0; m < 4; ++m) _Pragma("unroll") for (int k = 0; k < 2; ++k) dst[m][k] = *(const LAS bf16x8*)(lds + PG8_SA(b, h) + aoff + m * 2048 + k * 1024); } while (0)
#define PG8_LDB(dst, b, h) do { _Pragma("unroll") for (int n = 0; n < 2; ++n) _Pragma("unroll") for (int k = 0; k < 2; ++k) dst[n][k] = *(const LAS bf16x8*)(lds + PG8_SB(b, h) + boff + n * 2048 + k * 1024); } while (0)
#define PG8_MMA(ai, bj, At, Bt) do { __builtin_amdgcn_s_setprio(1); \
        if constexpr (FP8) { _Pragma("unroll") for (int m = 0; m < 4; ++m) _Pragma("unroll") for (int n = 0; n < 2; ++n) { \
            const bf16x8 _b0 = Bt[n][0], _b1 = Bt[n][1], _a0 = At[m][0], _a1 = At[m][1]; \
            const i32x8 _bw = __builtin_bit_cast(i32x8, __builtin_shufflevector(_b0, _b1, 0, 1, 2, 3, 4, 5, 6, 7, 8, 9, 10, 11, 12, 13, 14, 15)); \
            const i32x8 _aw = __builtin_bit_cast(i32x8, __builtin_shufflevector(_a0, _a1, 0, 1, 2, 3, 4, 5, 6, 7, 8, 9, 10, 11, 12, 13, 14, 15)); \
            acc[ai][bj][m][n] = __builtin_amdgcn_mfma_scale_f32_16x16x128_f8f6f4(_bw, _aw, acc[ai][bj][m][n], 0, 0, 0, 0x7f7f7f7f, 0, 0x7f7f7f7f); } } \
        else { _Pragma("unroll") for (int m = 0; m < 4; ++m) _Pragma("unroll") for (int n = 0; n < 2; ++n) _Pragma("unroll") for (int k = 0; k < 2; ++k) \
            acc[ai][bj][m][n] = __builtin_amdgcn_mfma_f32_16x16x32_bf16(Bt[n][k], At[m][k], acc[ai][bj][m][n], 0, 0, 0); } \
        __builtin_amdgcn_s_setprio(0); } while (0)
#define PG8_WAIT_V(n) asm volatile("s_waitcnt vmcnt(" #n ")" ::: "memory")
#define PG8_WAIT_L(n) asm volatile("s_waitcnt lgkmcnt(" #n ")" ::: "memory")
#define PG8_BAR __builtin_amdgcn_s_barrier()
#define PG8_SCHED __builtin_amdgcn_sched_barrier(0)
#define PG8_TAB_FILL(u, s) do { if (wid < 4) { const int _e = g.egrp0 + ((u).pm >> 5), _m0 = ((u).pm & 31) * 256, _b = _m0 >> 10, _s0 = _m0 & 1023; \
        __builtin_amdgcn_global_load_lds((const unsigned*)(g.IDX + (_e * 8 + _b) * CAP + _s0 + wid * 64 + lane), (LAS unsigned*)(lds + TAB_OFF + (s) * 1024 + wid * 256), 4, 0, 0); } } while (0)
#define PG8_ROWS(u, s, v) do { int _t = tid; asm volatile("" : "+v"(_t)); _Pragma("unroll") for (int _i = 0; _i < 2; ++_i) { int _R, _C; stage_rc(_t * 16 + _i * 8192, _R, _C); \
        _Pragma("unroll") for (int _h = 0; _h < 2; ++_h) { \
            if (gather) { const int _b = (((u).pm & 31) * 256) >> 10; const int _ix = tab[(s) * 256 + _h * 128 + _R]; v[_h][_i] = (unsigned)((_b * 8192 + _ix) * Kb + _C * 2); } \
            else v[_h][_i] = (unsigned)(((u).pm * 256 + _h * 128 + _R) * Kb + _C * 2); } } } while (0)
    Unit cur, nxt; int ui = 0;
    if (!S.next(0, cur)) return;
    cur.pm = __builtin_amdgcn_readfirstlane(cur.pm); cur.pn = __builtin_amdgcn_readfirstlane(cur.pn);
    f32x4 acc[2][2][4][2];
#define PG8_ACC_INIT(u) do { if (g.epi == 2) { const GAS float* _x = (const GAS float*)g.x + (size_t)((u).pm * BM + wr * 64 + fr) * 1024 + (u).pn * BM + wc * 32 + 8 * fq; \
        _Pragma("unroll") for (int a = 0; a < 2; ++a) _Pragma("unroll") for (int m = 0; m < 4; ++m) _Pragma("unroll") for (int b = 0; b < 2; ++b) _Pragma("unroll") for (int n = 0; n < 2; ++n) \
            acc[a][b][m][n] = *(const GAS f32x4*)(_x + (size_t)(a * HALF + m * 16) * 1024 + b * HALF + n * 4); \
        _Pragma("unroll") for (int a = 0; a < 2; ++a) _Pragma("unroll") for (int m = 0; m < 4; ++m) _Pragma("unroll") for (int b = 0; b < 2; ++b) _Pragma("unroll") for (int n = 0; n < 2; ++n) \
            acc[a][b][m][n] = acc[a][b][m][n] * ALPHA; } \
      else { float z = 0.f; asm volatile("" : "+v"(z));                   \
        _Pragma("unroll") for (int a = 0; a < 2; ++a) _Pragma("unroll") for (int b = 0; b < 2; ++b) _Pragma("unroll") for (int m = 0; m < 4; ++m) _Pragma("unroll") for (int n = 0; n < 2; ++n) \
            acc[a][b][m][n] = (f32x4){z, z, z, z}; } } while (0)
    PG8_ACC_INIT(cur);
    bf16x8 At[4][2], B0[2][2], B1[2][2];
    unsigned vc[2][2];
    const char* cB = (const char*)g.Bt + (size_t)(g.egrp0 + (cur.pm >> 5)) * g.bEstride + (size_t)cur.pn * tstep;
    const char* nB = cB;
    if (gather) { PG8_TAB_FILL(cur, 0); PG8_WAIT_V(0); PG8_BAR; }
    PG8_ROWS(cur, 0, vc);
    PG8_STAGE_B(PG8_SB(0, 0), cB); PG8_STAGE_B(PG8_SB(0, 1), cB + hstep); PG8_STAGE_A(PG8_SA(0, 0), 0, vc[0][0], vc[0][1]); PG8_STAGE_A(PG8_SA(0, 1), 0, vc[1][0], vc[1][1]);
    if (wr == 1) PG8_BAR;
    PG8_WAIT_V(2); PG8_BAR;
    PG8_STAGE_B(PG8_SB(1, 0), cB + kstep); PG8_STAGE_A(PG8_SA(1, 0), 1, vc[0][0], vc[0][1]); PG8_STAGE_B(PG8_SB(1, 1), cB + hstep + kstep);
    PG8_WAIT_V(6); PG8_BAR;
    for (;;) {
        const bool has_next = S.next(ui + 1, nxt);
        nxt.pm = __builtin_amdgcn_readfirstlane(nxt.pm); nxt.pn = __builtin_amdgcn_readfirstlane(nxt.pn);
        if (has_next) nB = (const char*)g.Bt + (size_t)(g.egrp0 + (nxt.pm >> 5)) * g.bEstride + (size_t)nxt.pn * tstep; else nB = cB;
        if (gather && has_next) PG8_TAB_FILL(nxt, (ui + 1) & 1);
        for (int t = 0; t < nt; t += 2) {
            const bool last = (t == nt - 2);
            const int k2 = last ? 0 : t + 2, k3 = k2 + 1;
            const char* b2 = last ? nB : cB + (size_t)(t + 2) * kstep; const char* b3 = b2 + kstep;
            PG8_LDB(B0, 0, 0); PG8_LDB(B1, 0, 1); PG8_SCHED; PG8_LDA(At, 0, 0); PG8_STAGE_A(PG8_SA(1, 1), t + 1, vc[1][0], vc[1][1]);
            if (last && has_next) PG8_ROWS(nxt, (ui + 1) & 1, vc);
            PG8_WAIT_V(8); PG8_WAIT_L(0); PG8_BAR; PG8_MMA(0, 0, At, B0); PG8_MMA(0, 1, At, B1); PG8_BAR; PG8_SCHED;
            PG8_LDA(At, 0, 1); PG8_STAGE_B(PG8_SB(0, 0), b2); PG8_STAGE_B(PG8_SB(0, 1), b2 + hstep); PG8_STAGE_A(PG8_SA(0, 0), k2, vc[0][0], vc[0][1]);
            PG8_WAIT_V(8); PG8_WAIT_L(0); PG8_BAR; PG8_MMA(1, 0, At, B0); PG8_MMA(1, 1, At, B1); PG8_BAR; PG8_SCHED;
            PG8_LDB(B0, 1, 0); PG8_LDB(B1, 1, 1); PG8_SCHED; PG8_LDA(At, 1, 0); PG8_STAGE_A(PG8_SA(0, 1), k2, vc[1][0], vc[1][1]);
            PG8_WAIT_V(8); PG8_WAIT_L(0); PG8_BAR; PG8_MMA(0, 0, At, B0); PG8_MMA(0, 1, At, B1); PG8_BAR; PG8_SCHED;
            PG8_LDA(At, 1, 1); PG8_STAGE_B(PG8_SB(1, 0), b3); PG8_STAGE_B(PG8_SB(1, 1), b3 + hstep); PG8_STAGE_A(PG8_SA(1, 0), k3, vc[0][0], vc[0][1]);
            PG8_WAIT_V(8); PG8_WAIT_L(0); PG8_BAR; PG8_MMA(1, 0, At, B0); PG8_MMA(1, 1, At, B1); PG8_BAR; PG8_SCHED;
        }
        if (wr == 0) PG8_BAR;
        epilogue(g, acc, cur, wr, wc, fr, fq);
        if (!has_next) break;
        cur = nxt; cB = nB; ++ui;
        PG8_ACC_INIT(cur);
        if (wr == 1) PG8_BAR;
    }
    PG8_WAIT_V(0);
    PG8_BAR;
#undef PG8_SA
#undef PG8_SB
#undef PG8_GLDS
#undef PG8_STAGE_A
#undef PG8_STAGE_B
#undef PG8_LDA
#undef PG8_LDB
#undef PG8_MMA
#undef PG8_WAIT_V
#undef PG8_WAIT_L
#undef PG8_BAR
#undef PG8_ACC_INIT
#undef PG8_SCHED
#undef PG8_TAB_FILL
#undef PG8_ROWS
}
}


constexpr int NA_SLOTS = 9, NA_SLOT_EL = 64 * 72;
__device__ __forceinline__ int vtl_off(int d, int key) { return d * 72 + key; }
__device__ __forceinline__ int vtc_off(int d, int key) { return d * 264 + key; }
__device__ __forceinline__ void na_item(const Params& p, unsigned char* lds, int item) {
    const GAS bf16_t* U = (const GAS bf16_t*)(p.ws + WS_U); GAS bf16_t* MIX = (GAS bf16_t*)(p.ws + WS_MIX);
    const int tid = ltid(), lane = tid & 63, wave = __builtin_amdgcn_readfirstlane(tid >> 6), fr = lane & 15, fq = lane >> 4;
    const int seg = item & 3, bh = item >> 2, h = bh & 7, b = bh >> 3;
    bf16_t* VTL = (bf16_t*)lds;
    bf16_t* VTC = VTL + NA_SLOTS * NA_SLOT_EL;
    bf16_t* KC = VTC + 64 * 264;
    float* BIAS = (float*)(KC + 256 * 72);
    const size_t lat0 = (size_t)b * 8192, ctx0 = (size_t)NLAT + b * 256;
    const GAS bf16_t* Uv = U + C_VA + h * 64 + wave * 8;
#pragma unroll
    for (int i = 0; i < 2; ++i) { const int kp = lane + 64 * i;
        const u32x4 w0 = *(const GAS u32x4*)(Uv + (ctx0 + 2 * kp) * DINP), w1 = *(const GAS u32x4*)(Uv + (ctx0 + 2 * kp + 1) * DINP);
        const unsigned ws_[8] = {(w0.x & 0xffffu) | (w1.x << 16), (w0.x >> 16) | (w1.x & 0xffff0000u), (w0.y & 0xffffu) | (w1.y << 16), (w0.y >> 16) | (w1.y & 0xffff0000u),
                                 (w0.z & 0xffffu) | (w1.z << 16), (w0.z >> 16) | (w1.z & 0xffff0000u), (w0.w & 0xffffu) | (w1.w << 16), (w0.w >> 16) | (w1.w & 0xffff0000u)};
#pragma unroll
        for (int e = 0; e < 8; ++e) *(unsigned*)(VTC + vtc_off(wave * 8 + e, 2 * kp)) = ws_[e]; }
    for (int idx = tid; idx < 256 * 8; idx += NTHR) { const int key = idx >> 3, ck = idx & 7;
        *(u32x4*)(KC + key * 72 + ck * 8) = *(const GAS u32x4*)(U + (ctx0 + key) * DINP + C_KA + h * 64 + ck * 8); }
    if (tid < 512) BIAS[tid] = tid < 465 ? p.na_bias[h * 465 + tid] * 1.4426950408889634f : 0.f;
    const int cg = wave & 3, rr = wave >> 2, c0 = 16 * cg, kb = cg == 0 ? 0 : (cg == 1 ? 8 : (cg == 2 ? 24 : 32));
    const int c = c0 + fr, cs = min(max(c - 8, 0), 48);
    const int r00 = 32 * seg;
#define NA_VFILL(kra_, w0_, w1_) do { const unsigned ws_[8] = {(w0_.x & 0xffffu) | (w1_.x << 16), (w0_.x >> 16) | (w1_.x & 0xffff0000u), (w0_.y & 0xffffu) | (w1_.y << 16), (w0_.y >> 16) | (w1_.y & 0xffff0000u), \
            (w0_.z & 0xffffu) | (w1_.z << 16), (w0_.z >> 16) | (w1_.z & 0xffff0000u), (w0_.w & 0xffffu) | (w1_.w << 16), (w0_.w >> 16) | (w1_.w & 0xffff0000u)}; \
        bf16_t* sl_ = VTL + ((kra_) % NA_SLOTS) * NA_SLOT_EL; _Pragma("unroll") for (int e_ = 0; e_ < 8; ++e_) *(unsigned*)(sl_ + vtl_off(wave * 8 + e_, 2 * (lane & 31))) = ws_[e_]; } while (0)
    { const int lo = min(max(r00 - 4, 0), 120), hi = min(max(r00 + 1 - 4, 0), 120) + 7;
      for (int kra = lo + (lane >> 5); kra <= hi; kra += 2) { const size_t k0 = lat0 + kra * 64 + 2 * (lane & 31);
          const u32x4 w0 = *(const GAS u32x4*)(Uv + k0 * DINP), w1 = *(const GAS u32x4*)(Uv + (k0 + 1) * DINP);
          NA_VFILL(kra, w0, w1); } }
#define NA_LOADK(kf_, ch, rw_) do { const int rs_ = min(max((rw_) - 4, 0), 120); unsigned koff_ = koff; asm volatile("" : "+v"(koff_));     \
        _Pragma("unroll") for (int t_ = 0; t_ < 4; ++t_) { \
        const size_t krow_ = lat0 + (rs_ + 2 * (ch) + (t_ >> 1)) * 64 + kb + 16 * (t_ & 1); \
        const GAS char* bp_ = Ub + krow_ * (DINP * 2); \
        kf_[2 * t_] = *(const GAS bf16x8_t*)(bp_ + koff_); kf_[2 * t_ + 1] = *(const GAS bf16x8_t*)(bp_ + koff_ + 64); } } while (0)
    const GAS char* Ub = (const GAS char*)U;
    const unsigned koff = (unsigned)((fr * DINP + C_KA + h * 64 + 8 * fq) * 2);
    bf16x8_t kfa[8], kfb[8], qf[2];
    { const int rw0 = r00 + rr; const size_t qrow = lat0 + rw0 * 64 + c0 + fr;
      qf[0] = *(const GAS bf16x8_t*)(U + qrow * DINP + C_QA + h * 64 + 8 * fq); qf[1] = *(const GAS bf16x8_t*)(U + qrow * DINP + C_QA + h * 64 + 32 + 8 * fq);
      NA_LOADK(kfa, 0, rw0); NA_LOADK(kfb, 1, rw0); }
    __syncthreads();
#pragma unroll 1
    for (int step = 0; step < 16; ++step) {
        const int r = r00 + 2 * step, rw = r + rr, rsw = min(max(rw - 4, 0), 120);
        const int nhi_cur = min(max(r + 1 - 4, 0), 120) + 7, nhi_nxt = min(max(r + 3 - 4, 0), 120) + 7;
        const int vkra = nhi_cur + 1 + (lane >> 5); const bool vld = step < 15 && vkra <= nhi_nxt;
        u32x4 vw0 = (u32x4){0u, 0u, 0u, 0u}, vw1 = (u32x4){0u, 0u, 0u, 0u};
        float m_run = -INFINITY, l_run = 0.f;
        f32x4 o[4];
#pragma unroll
        for (int db = 0; db < 4; ++db) o[db] = (f32x4){0.f, 0.f, 0.f, 0.f};
#pragma unroll
        for (int ch = 0; ch < 8; ++ch) {
            f32x4 sc[4];
            if (ch < 4) {
#pragma unroll
                for (int t = 0; t < 4; ++t) { f32x4 a = (f32x4){0.f, 0.f, 0.f, 0.f};
                    if (ch & 1) { a = __builtin_amdgcn_mfma_f32_16x16x32_bf16(kfb[2 * t], qf[0], a, 0, 0, 0); a = __builtin_amdgcn_mfma_f32_16x16x32_bf16(kfb[2 * t + 1], qf[1], a, 0, 0, 0); }
                    else { a = __builtin_amdgcn_mfma_f32_16x16x32_bf16(kfa[2 * t], qf[0], a, 0, 0, 0); a = __builtin_amdgcn_mfma_f32_16x16x32_bf16(kfa[2 * t + 1], qf[1], a, 0, 0, 0); }
                    sc[t] = a; }
                __builtin_amdgcn_sched_barrier(0);
                if (ch < 2) { if (ch & 1) { NA_LOADK(kfb, ch + 2, rw); } else { NA_LOADK(kfa, ch + 2, rw); } }
                else if (step < 15) { if (ch & 1) { NA_LOADK(kfb, 1, rw + 2); } else { NA_LOADK(kfa, 0, rw + 2); } }
            } else {
#pragma unroll
                for (int t = 0; t < 4; ++t) { const bf16_t* kp = KC + (64 * (ch - 4) + 16 * t + fr) * 72 + 8 * fq;
                    const bf16x8_t k0 = *(const bf16x8_t*)kp, k1 = *(const bf16x8_t*)(kp + 32);
                    f32x4 a = (f32x4){0.f, 0.f, 0.f, 0.f};
                    a = __builtin_amdgcn_mfma_f32_16x16x32_bf16(k0, qf[0], a, 0, 0, 0); a = __builtin_amdgcn_mfma_f32_16x16x32_bf16(k1, qf[1], a, 0, 0, 0); sc[t] = a; }
                __builtin_amdgcn_sched_barrier(0);
                if (ch == 7 && step < 15) { const size_t qrow = lat0 + (rw + 2) * 64 + c0 + fr;
                    qf[0] = *(const GAS bf16x8_t*)(U + qrow * DINP + C_QA + h * 64 + 8 * fq); qf[1] = *(const GAS bf16x8_t*)(U + qrow * DINP + C_QA + h * 64 + 32 + 8 * fq); }
                if (ch == 4 && vld) { const size_t k0 = lat0 + vkra * 64 + 2 * (lane & 31); vw0 = *(const GAS u32x4*)(Uv + k0 * DINP); vw1 = *(const GAS u32x4*)(Uv + (k0 + 1) * DINP); }
            }
            u32x2 vfr[2][4][2];
#pragma unroll
            for (int t = 0; t < 2; ++t)
#pragma unroll
                for (int db = 0; db < 4; ++db) {
                    if (ch < 4) { const bf16_t* sl = VTL + ((rsw + 2 * ch + t) % NA_SLOTS) * NA_SLOT_EL;
                        vfr[t][db][0] = *(const u32x2*)(sl + vtl_off(db * 16 + fr, kb + 4 * fq)); vfr[t][db][1] = *(const u32x2*)(sl + vtl_off(db * 16 + fr, kb + 16 + 4 * fq)); }
                    else { vfr[t][db][0] = *(const u32x2*)(VTC + vtc_off(db * 16 + fr, 64 * (ch - 4) + 32 * t + 4 * fq)); vfr[t][db][1] = *(const u32x2*)(VTC + vtc_off(db * 16 + fr, 64 * (ch - 4) + 32 * t + 16 + 4 * fq)); }
                }
            float bv[4][4];
            if (ch < 4) {
#pragma unroll
                for (int t = 0; t < 4; ++t) { const int kr = 2 * ch + (t >> 1), cb = t & 1;
                    const float* brow = BIAS + (rsw + kr - rw + 7) * 31;
#pragma unroll
                    for (int j = 0; j < 4; ++j) bv[t][j] = brow[kb + 16 * cb + 4 * fq + j - c + 15]; }
                asm volatile("" : "+v"(bv[0][0]), "+v"(bv[0][1]), "+v"(bv[0][2]), "+v"(bv[0][3]), "+v"(bv[1][0]), "+v"(bv[1][1]), "+v"(bv[1][2]), "+v"(bv[1][3]),
                                  "+v"(bv[2][0]), "+v"(bv[2][1]), "+v"(bv[2][2]), "+v"(bv[2][3]), "+v"(bv[3][0]), "+v"(bv[3][1]), "+v"(bv[3][2]), "+v"(bv[3][3]));
            }
            __builtin_amdgcn_sched_barrier(0);
            if (ch < 4) {
#pragma unroll
                for (int t = 0; t < 4; ++t) { const int cb = t & 1;
#pragma unroll
                    for (int j = 0; j < 4; ++j) { const int col = kb + 16 * cb + 4 * fq + j; const bool valid = (col >= cs) && (col < cs + 16);
                        sc[t][j] = valid ? sc[t][j] + bv[t][j] : -INFINITY; } }
            }
            float cm = -INFINITY;
#pragma unroll
            for (int t = 0; t < 4; ++t) cm = fmaxf(cm, fmaxf(fmaxf(sc[t][0], sc[t][1]), fmaxf(sc[t][2], sc[t][3])));
            if (__any(cm > m_run + 11.5f)) {
                cm = fmaxf(cm, __shfl_xor(cm, 16)); cm = fmaxf(cm, __shfl_xor(cm, 32));
                const float m_new = fmaxf(m_run, cm), alpha = __builtin_amdgcn_exp2f(m_run - m_new);
                m_run = m_new; l_run *= alpha;
#pragma unroll
                for (int j = 0; j < 4; ++j) { const float aj = __shfl(alpha, 4 * fq + j);
#pragma unroll
                    for (int db = 0; db < 4; ++db) o[db][j] *= aj; }
            }
            const float m_new = m_run;
            float psum = 0.f;
            u32x4 pw[2];
#pragma unroll
            for (int t = 0; t < 2; ++t) {
                f32x4 e0, e1;
#pragma unroll
                for (int j = 0; j < 4; ++j) { e0[j] = __builtin_amdgcn_exp2f(sc[2 * t][j] - m_new); e1[j] = __builtin_amdgcn_exp2f(sc[2 * t + 1][j] - m_new); }
                psum += (e0[0] + e0[1]) + (e0[2] + e0[3]) + (e1[0] + e1[1]) + (e1[2] + e1[3]);
                pw[t].x = cvtpk(e0[0], e0[1]); pw[t].y = cvtpk(e0[2], e0[3]); pw[t].z = cvtpk(e1[0], e1[1]); pw[t].w = cvtpk(e1[2], e1[3]);
            }
            l_run += psum;
#pragma unroll
            for (int t = 0; t < 2; ++t)
#pragma unroll
                for (int db = 0; db < 4; ++db) { const u32x4 vw = (u32x4){vfr[t][db][0].x, vfr[t][db][0].y, vfr[t][db][1].x, vfr[t][db][1].y};
                    o[db] = __builtin_amdgcn_mfma_f32_16x16x32_bf16(__builtin_bit_cast(bf16x8_t, pw[t]), __builtin_bit_cast(bf16x8_t, vw), o[db], 0, 0, 0); }
            __builtin_amdgcn_sched_barrier(0);
        }
        float lsum = l_run; lsum += __shfl_xor(lsum, 16); lsum += __shfl_xor(lsum, 32);
        const float rinv = 1.f / lsum;
#pragma unroll
        for (int j = 0; j < 4; ++j) { const float rj = __shfl(rinv, 4 * fq + j);
            GAS bf16_t* orow = MIX + (lat0 + rw * 64 + c0 + 4 * fq + j) * 1024 + h * 64 + fr;
#pragma unroll
            for (int db = 0; db < 4; ++db) orow[db * 16] = (bf16_t)f2bf(o[db][j] * rj); }
        __syncthreads();
        if (vld) NA_VFILL(vkra, vw0, vw1);
        __syncthreads();
    }
#undef NA_LOADK
#undef NA_VFILL
}

__device__ __forceinline__ float rope_elem(const float* xr, int d, int t, const GAS float* ROPE) {
    const int half = d >> 5, dd = d & 31, i = dd & 15;
    const int pos = half == 0 ? (t >> 6) : (t & 63);
    const float cs_ = ROPE[(pos * 16 + i) * 2], sn = ROPE[(pos * 16 + i) * 2 + 1];
    const float x1 = xr[half * 32 + i], x2 = xr[half * 32 + 16 + i];
    return dd < 16 ? x1 * cs_ - x2 * sn : x1 * sn + x2 * cs_;
}

struct StPre { u32x4 raw[5]; u32x4 v[4]; };
__device__ __forceinline__ void ml_stats_prefetch(const Params& p, int item, int tid, StPre& r) {
    const GAS bf16_t* U = (const GAS bf16_t*)(p.ws + WS_U);
    const int ch = item % NCH, bh = item / NCH, h = bh & 3, b = bh >> 2;
    const bool is_ctx = ch >= 64; const int Tseq = is_ctx ? 256 : 8192, t0 = (is_ctx ? ch - 64 : ch) * 128;
    const size_t rowbase = is_ctx ? (size_t)NLAT + b * 256 : (size_t)b * 8192;
#pragma unroll
    for (int i = 0; i < 5; ++i) { const int idx = tid + i * NTHR, tt = idx >> 4, ck = idx & 15, t = t0 - 2 + tt;
        u32x4 w = (u32x4){0u, 0u, 0u, 0u};
        if (idx < 132 * 16 && t >= 0 && t < Tseq) w = *(const GAS u32x4*)(U + (rowbase + t) * DINP + (ck < 8 ? C_QM : C_KM) + h * 64 + (ck & 7) * 8);
        r.raw[i] = w; }
#pragma unroll
    for (int i = 0; i < 4; ++i) { const int idx = tid + i * NTHR, l = idx & 127, ck = idx >> 7; r.v[i] = *(const GAS u32x4*)(U + (rowbase + t0 + l) * DINP + C_VM + h * 128 + ck * 8); }
}
__device__ __forceinline__ void ml_stats_item(const Params& p, unsigned char* lds, int item, StPre& pre, int next_item) {
    const GAS bf16_t* U = (const GAS bf16_t*)(p.ws + WS_U); GAS bf16_t* QP = (GAS bf16_t*)(p.ws + WS_QP); GAS bf16_t* KP = (GAS bf16_t*)(p.ws + WS_KP);
    GAS bf16_t* CLOC = (GAS bf16_t*)(p.ws + WS_CLOC); GAS float* NLOC = (GAS float*)(p.ws + WS_NLOC); GAS float* MLOC = (GAS float*)(p.ws + WS_MLOC); GAS float* BLAST = (GAS float*)(p.ws + WS_BLAST);
    const GAS float* ROPE = (const GAS float*)(p.ws + WS_ROPE); const GAS float* convw = (const GAS float*)p.conv_qk;
    const int tid = ltid(), lane = tid & 63, wave = __builtin_amdgcn_readfirstlane(tid >> 6), fr = lane & 15, fq = lane >> 4;
    const int ch = item % NCH, bh = item / NCH, h = bh & 3, b = bh >> 2;
    const bool is_ctx = ch >= 64; const int Tseq = is_ctx ? 256 : 8192, cl = is_ctx ? ch - 64 : ch, t0 = cl * 128;
    const size_t rowbase = is_ctx ? (size_t)NLAT + b * 256 : (size_t)b * 8192;
    bf16_t* KT = (bf16_t*)lds;
    bf16_t* RAW = KT + 64 * 136;
    float* TMP = (float*)(RAW + 132 * 128);
    bf16_t* WV = RAW;
    float* gl = TMP + 128 * 129;
    float* wgt = gl + 512;
    const float* RT = wgt + 256;
#pragma unroll
    for (int i = 0; i < 5; ++i) { const int idx = tid + i * NTHR; if (idx < 132 * 16) *(u32x4*)(RAW + (idx >> 4) * 128 + (idx & 15) * 8) = pre.raw[i]; }
    { const int g = tid >> 7, l = tid & 127; gl[tid] = bf2f(U[(rowbase + t0 + l) * DINP + C_GT + g * 4 + h]) + p.b_gate[g * 4 + h]; }
    __syncthreads();
    for (int rr19_ = 0; rr19_ < REPN(19); ++rr19_) {
    { const int chn = tid & 127, wofs = (chn < 64 ? 0 : 256) + h * 64 + (chn & 63);
      float cw[5];
#pragma unroll
      for (int j = 0; j < 5; ++j) cw[j] = convw[j * 512 + wofs];
      const int l0 = (tid >> 7) * 32;
      float w0 = bf2f(RAW[(l0 + 0) * 128 + chn]), w1 = bf2f(RAW[(l0 + 1) * 128 + chn]), w2 = bf2f(RAW[(l0 + 2) * 128 + chn]), w3 = bf2f(RAW[(l0 + 3) * 128 + chn]);
#pragma unroll 8
      for (int i = 0; i < 32; ++i) { const float w4 = bf2f(RAW[(l0 + i + 4) * 128 + chn]);
          const float a = cw[0] * w0 + cw[1] * w1 + cw[2] * w2 + cw[3] * w3 + cw[4] * w4;
          TMP[(l0 + i) * 129 + chn] = siluf(a); w0 = w1; w1 = w2; w2 = w3; w3 = w4; } }
    if (wave < 2) {
        const int dir = wave, l0 = dir == 0 ? 2 * lane : 127 - 2 * lane, l1 = dir == 0 ? 2 * lane + 1 : 126 - 2 * lane;
        const float* ig = gl + dir * 256; const float* fg = ig + 128;
        const float lf0 = logsigf(fg[l0]), lf1 = logsigf(fg[l1]);
        const float incl = wscan_add(lf0 + lf1, lane), bc0 = incl - lf1, bc1 = incl, blast = __shfl(incl, 63);
        const float a0 = blast - bc0 + ig[l0], a1 = blast - bc1 + ig[l1];
        const float m = wave_max(fmaxf(a0, a1));
        wgt[dir * 128 + l0] = __expf(a0 - m); wgt[dir * 128 + l1] = __expf(a1 - m);
        if (lane == 0) { BLAST[(dir * 32 + bh) * NCH + ch] = blast; MLOC[(dir * 32 + bh) * NCH + ch] = m; }
    }
    }
    __syncthreads();
    for (int rr20_ = 0; rr20_ < REPN(20); ++rr20_) {
    for (int idx = tid; idx < 128 * 16; idx += NTHR) { const int l = idx & 127, ck = idx >> 7, isk = ck >> 3, d0 = (ck & 7) * 8, t = t0 + l;
        if (is_ctx && !isk) continue;
        const float* xr = TMP + l * 129 + isk * 64;
        float o[8];
        if (is_ctx) {
#pragma unroll
            for (int e = 0; e < 8; ++e) o[e] = xr[d0 + e];
        } else {
            const int half = d0 >> 5, dd0 = d0 & 31, i0 = dd0 & 15, pos = half == 0 ? (t >> 6) : (t & 63);
            const f32x4* rp = (const f32x4*)(RT + (pos * 16 + i0) * 2);
            const f32x4 r0 = rp[0], r1 = rp[1], r2 = rp[2], r3 = rp[3];
            const float cs_[8] = {r0.x, r0.z, r1.x, r1.z, r2.x, r2.z, r3.x, r3.z}, sn[8] = {r0.y, r0.w, r1.y, r1.w, r2.y, r2.w, r3.y, r3.w};
#pragma unroll
            for (int e = 0; e < 8; ++e) { const float x1 = xr[half * 32 + i0 + e], x2 = xr[half * 32 + 16 + i0 + e]; o[e] = dd0 < 16 ? x1 * cs_[e] - x2 * sn[e] : x1 * sn[e] + x2 * cs_[e]; }
        }
        if (!isk) { u32x4 w; w.x = pk2(o[0] * 0.125f, o[1] * 0.125f); w.y = pk2(o[2] * 0.125f, o[3] * 0.125f); w.z = pk2(o[4] * 0.125f, o[5] * 0.125f); w.w = pk2(o[6] * 0.125f, o[7] * 0.125f);
            *(GAS u32x4*)(QP + ((size_t)b * 8192 + t) * 256 + h * 64 + d0) = w; }
        else { u32x4 w; w.x = pk2(o[0], o[1]); w.y = pk2(o[2], o[3]); w.z = pk2(o[4], o[5]); w.w = pk2(o[6], o[7]);
            *(GAS u32x4*)(KP + (rowbase + t) * 256 + h * 64 + d0) = w;
            KT[(d0 + 0) * 136 + l] = (bf16_t)(w.x & 0xffffu); KT[(d0 + 1) * 136 + l] = (bf16_t)(w.x >> 16); KT[(d0 + 2) * 136 + l] = (bf16_t)(w.y & 0xffffu); KT[(d0 + 3) * 136 + l] = (bf16_t)(w.y >> 16);
            KT[(d0 + 4) * 136 + l] = (bf16_t)(w.z & 0xffffu); KT[(d0 + 5) * 136 + l] = (bf16_t)(w.z >> 16); KT[(d0 + 6) * 136 + l] = (bf16_t)(w.w & 0xffffu); KT[(d0 + 7) * 136 + l] = (bf16_t)(w.w >> 16); }
    }
    }
    __syncthreads();
    for (int rr21_ = 0; rr21_ < REPN(21); ++rr21_) {
#pragma unroll
    for (int i = 0; i < 4; ++i) { const int idx = tid + i * NTHR, l = idx & 127, ck = idx >> 7;
        const u32x4 w = pre.v[i];
        const float wf = wgt[l], wb = wgt[128 + l];
        const float vv[8] = {bflo(w.x), bfhi(w.x), bflo(w.y), bfhi(w.y), bflo(w.z), bfhi(w.z), bflo(w.w), bfhi(w.w)};
#pragma unroll
        for (int e = 0; e < 8; ++e) { WV[(ck * 8 + e) * 136 + l] = (bf16_t)f2bf(wf * vv[e]); WV[(128 + ck * 8 + e) * 136 + l] = (bf16_t)f2bf(wb * vv[e]); } }
    }
    __syncthreads();
    if (next_item >= 0) ml_stats_prefetch(p, next_item, tid, pre);
    for (int rr22_ = 0; rr22_ < REPN(22); ++rr22_) {
    { const int dir = wave >> 2, vb0 = (wave & 3) * 2;
      GAS bf16_t* cdst = CLOC + ((size_t)(dir * 32 + bh) * NCH + ch) * 8192;
#pragma unroll
      for (int vbi = 0; vbi < 2; ++vbi) {
          const int vb = vb0 + vbi;
          bf16x8_t af[4];
#pragma unroll
          for (int ls = 0; ls < 4; ++ls) af[ls] = *(const bf16x8_t*)(WV + (dir * 128 + vb * 16 + fr) * 136 + ls * 32 + 8 * fq);
#pragma unroll
          for (int kb = 0; kb < 4; ++kb) {
              f32x4 acc = (f32x4){0.f, 0.f, 0.f, 0.f};
#pragma unroll
              for (int ls = 0; ls < 4; ++ls) { const bf16x8_t bfr = *(const bf16x8_t*)(KT + (kb * 16 + fr) * 136 + ls * 32 + 8 * fq); acc = __builtin_amdgcn_mfma_f32_16x16x32_bf16(af[ls], bfr, acc, 0, 0, 0); }
#pragma unroll
              for (int j = 0; j < 4; ++j) cdst[(vb * 16 + 4 * fq + j) * 64 + kb * 16 + fr] = (bf16_t)f2bf(acc[j]);
          }
      }
      if (tid < 128) { const int d2 = tid >> 6, k = tid & 63; float sn = 0.f;
          for (int l = 0; l < 128; ++l) sn += wgt[d2 * 128 + l] * bf2f(KT[k * 136 + l]);
          NLOC[((size_t)(d2 * 32 + bh) * NCH + ch) * 64 + k] = sn; }
    }
    }
    __syncthreads();
}
__device__ __forceinline__ void ph3(const Params& p, unsigned char* lds, int bid, int nblk) {
    for (int rep_ = 0; rep_ < REPN(14); ++rep_) for (int it = bid; it < 256; it += nblk) na_item(p, lds, (nblk == 256) ? ((it & 7) * 32 + (it >> 3)) : it);
    {
      float* RTw = (float*)((bf16_t*)lds + 64 * 136 + 132 * 128) + 128 * 129 + 512 + 256; const GAS float* ROPEg = (const GAS float*)(p.ws + WS_ROPE);
      for (int i = threadIdx.x; i < 4096; i += NTHR) RTw[i] = ROPEg[i];
      __syncthreads(); }
    for (int rep_ = 0; rep_ < REPN(15); ++rep_) { StPre pre; if (bid < 32 * NCH) ml_stats_prefetch(p, bid, (int)threadIdx.x, pre);
        for (int it = bid; it < 32 * NCH; it += nblk) ml_stats_item(p, lds, it, pre, it + nblk < 32 * NCH ? it + nblk : -1); }
}

__device__ __forceinline__ void ph4(const Params& p, int bid, int nblk) {
    GAS bf16_t* CLOC = (GAS bf16_t*)(p.ws + WS_CLOC); GAS float* NLOC = (GAS float*)(p.ws + WS_NLOC); const GAS float* MLOC = (const GAS float*)(p.ws + WS_MLOC);
    const GAS float* BLAST = (const GAS float*)(p.ws + WS_BLAST); GAS float* MIN = (GAS float*)(p.ws + WS_MIN);
    const int tid = ltid();
    for (int it = bid; it < 64 * 5; it += nblk) {
        const bool small = it >= 256; const int q = small ? it - 256 : it >> 2, seg = it & 3, dir = q >> 5;
        if (small && tid > 64) continue;
        float c0 = 0.f, c1 = 0.f, c2 = 0.f, c3 = 0.f, m_prev = 0.f;
        GAS bf16_t* cbase = CLOC + (size_t)q * NCH * 8192 + seg * 2048 + tid * 4;
        GAS float* nbase = NLOC + (size_t)q * NCH * 64 + (tid & 63);
        for (int s0 = 0; s0 < NCH; s0 += 22) {
            u32x2 cw[22]; float nv[22], bl[22], ml[22]; int ci[22];
#pragma unroll
            for (int u = 0; u < 22; ++u) { const int step = s0 + u; ci[u] = dir == 0 ? (step < 2 ? 64 + step : step - 2) : 65 - step;
                bl[u] = BLAST[q * NCH + ci[u]]; ml[u] = MLOC[q * NCH + ci[u]];
                if (!small) cw[u] = *(const GAS u32x2*)(cbase + (size_t)ci[u] * 8192); else nv[u] = tid < 64 ? nbase[ci[u] * 64] : 0.f; }
#pragma unroll
            for (int u = 0; u < 22; ++u) {
                const float m_new = fmaxf(bl[u] + m_prev, ml[u]), sp = __expf(bl[u] + m_prev - m_new), sl = __expf(ml[u] - m_new);
                if (!small) { u32x2 o; o.x = pk2(c0, c1); o.y = pk2(c2, c3); *(GAS u32x2*)(cbase + (size_t)ci[u] * 8192) = o;
                    c0 = sp * c0 + sl * bflo(cw[u].x); c1 = sp * c1 + sl * bfhi(cw[u].x); c2 = sp * c2 + sl * bflo(cw[u].y); c3 = sp * c3 + sl * bfhi(cw[u].y); }
                else if (tid < 64) { nbase[ci[u] * 64] = c0; c0 = sp * c0 + sl * nv[u]; }
                else MIN[q * NCH + ci[u]] = m_prev;
                m_prev = m_new;
            }
        }
    }
}

struct MlPre { u32x4 q[2], k[2], v[4], c[2][2]; };
__device__ __forceinline__ void ml_out_prefetch(const Params& p, int item, int tid, MlPre& r) {
    const GAS bf16_t* U = (const GAS bf16_t*)(p.ws + WS_U); const GAS bf16_t* QP = (const GAS bf16_t*)(p.ws + WS_QP); const GAS bf16_t* KP = (const GAS bf16_t*)(p.ws + WS_KP);
    const GAS bf16_t* CLOC = (const GAS bf16_t*)(p.ws + WS_CLOC);
    const int J = item & 63, bh = item >> 6, h = bh & 3, b = bh >> 2; const size_t row0 = (size_t)b * 8192 + J * 128;
#pragma unroll
    for (int i = 0; i < 2; ++i) { const int idx = tid + i * NTHR, rr = idx >> 3, ck = idx & 7;
        r.q[i] = *(const GAS u32x4*)(QP + (row0 + rr) * 256 + h * 64 + ck * 8); r.k[i] = *(const GAS u32x4*)(KP + (row0 + rr) * 256 + h * 64 + ck * 8); }
#pragma unroll
    for (int i = 0; i < 4; ++i) { const int idx = tid + i * NTHR, l = idx & 127, ck = idx >> 7; r.v[i] = *(const GAS u32x4*)(U + (row0 + l) * DINP + C_VM + h * 128 + ck * 8); }
#pragma unroll
    for (int dir = 0; dir < 2; ++dir) { const GAS bf16_t* csrc = CLOC + ((size_t)(dir * 32 + bh) * NCH + J) * 8192;
#pragma unroll
        for (int i = 0; i < 2; ++i) { const int idx = tid + i * NTHR; r.c[dir][i] = *(const GAS u32x4*)(csrc + idx * 8); } }
}
__device__ __forceinline__ void ml_out_item(const Params& p, unsigned char* lds, int item, MlPre& pre, int next_item) {
    const GAS bf16_t* U = (const GAS bf16_t*)(p.ws + WS_U); const GAS bf16_t* QP = (const GAS bf16_t*)(p.ws + WS_QP); const GAS bf16_t* KP = (const GAS bf16_t*)(p.ws + WS_KP);
    const GAS float* NLOC = (const GAS float*)(p.ws + WS_NLOC); const GAS float* MIN = (const GAS float*)(p.ws + WS_MIN);
    GAS bf16_t* MIX = (GAS bf16_t*)(p.ws + WS_MIX);
    const int tid = ltid(), lane = tid & 63, wave = __builtin_amdgcn_readfirstlane(tid >> 6), fr = lane & 15, fq = lane >> 4;
    const int J = item & 63, bh = item >> 6, h = bh & 3, b = bh >> 2, t0 = J * 128;
    const size_t row0 = (size_t)b * 8192 + t0;
    bf16_t* Qs = (bf16_t*)lds;
    bf16_t* Ks = Qs + 128 * 72;
    bf16_t* VT = Ks + 128 * 72;
    bf16_t* Cs = VT + 128 * 136;
    float* asv = (float*)(Cs + 2 * 128 * 72);
    float* btv = asv + 256;
    float* itv = btv + 256;
    float* emt = itv + 256;
    float* nin = emt + 256;
    float* OST = nin + 128 + wave * (8 * 132);
    for (int r16_ = 0; r16_ < REPN(16); ++r16_) {
    if (wave < 2) {
        const int dir = wave, l0 = dir == 0 ? 2 * lane : 127 - 2 * lane, l1 = dir == 0 ? 2 * lane + 1 : 126 - 2 * lane;
        const GAS bf16_t* g0 = U + (row0 + l0) * DINP + C_GT + h; const GAS bf16_t* g1 = U + (row0 + l1) * DINP + C_GT + h;
        const float bi = p.b_gate[dir * 8 + h], bf_ = p.b_gate[dir * 8 + 4 + h];
        const float i0 = bf2f(g0[dir * 8]) + bi, f0 = bf2f(g0[dir * 8 + 4]) + bf_, i1 = bf2f(g1[dir * 8]) + bi, f1 = bf2f(g1[dir * 8 + 4]) + bf_;
        const float m_in = MIN[(dir * 32 + bh) * NCH + J];
        const float lf0 = logsigf(f0), lf1 = logsigf(f1);
        const float incl = wscan_add(lf0 + lf1, lane), bc0 = incl - lf1, bc1 = incl;
        const float as0 = i0 - bc0, as1 = i1 - bc1;
        const float inclm = wscan_max(fmaxf(as0, as1), lane); float exclm = __shfl_up(inclm, 1); if (lane == 0) exclm = -INFINITY;
        const float gm0 = fmaxf(exclm, as0), gm1 = inclm;
        const float mp0 = bc0 + m_in, mp1 = bc1 + m_in, mt0 = fmaxf(bc0 + gm0, mp0), mt1 = fmaxf(bc1 + gm1, mp1);
        asv[dir * 128 + l0] = as0; asv[dir * 128 + l1] = as1; btv[dir * 128 + l0] = bc0 - mt0; btv[dir * 128 + l1] = bc1 - mt1;
        itv[dir * 128 + l0] = __expf(mp0 - mt0); itv[dir * 128 + l1] = __expf(mp1 - mt1); emt[dir * 128 + l0] = __expf(-mt0); emt[dir * 128 + l1] = __expf(-mt1);
    }
#pragma unroll
    for (int i = 0; i < 2; ++i) { const int idx = tid + i * NTHR, r = idx >> 3, ck = idx & 7; *(u32x4*)(Qs + r * 72 + ck * 8) = pre.q[i]; *(u32x4*)(Ks + r * 72 + ck * 8) = pre.k[i]; }
#pragma unroll
    for (int i = 0; i < 4; ++i) { const int idx = tid + i * NTHR, l = idx & 127, ck = idx >> 7;
        const u32x4 w = pre.v[i]; bf16_t* d = VT + (ck * 8) * 136 + l;
        d[0 * 136] = (bf16_t)(w.x & 0xffffu); d[1 * 136] = (bf16_t)(w.x >> 16); d[2 * 136] = (bf16_t)(w.y & 0xffffu); d[3 * 136] = (bf16_t)(w.y >> 16);
        d[4 * 136] = (bf16_t)(w.z & 0xffffu); d[5 * 136] = (bf16_t)(w.z >> 16); d[6 * 136] = (bf16_t)(w.w & 0xffffu); d[7 * 136] = (bf16_t)(w.w >> 16); }
#pragma unroll
    for (int dir = 0; dir < 2; ++dir)
#pragma unroll
        for (int i = 0; i < 2; ++i) { const int idx = tid + i * NTHR, v = idx >> 3, k8 = idx & 7; *(u32x4*)(Cs + (dir * 128 + v) * 72 + k8 * 8) = pre.c[dir][i]; }
    if (tid < 128) nin[tid] = NLOC[((size_t)((tid >> 6) * 32 + bh) * NCH + J) * 64 + (tid & 63)];
    }
    __syncthreads();
    if (next_item >= 0) ml_out_prefetch(p, next_item, tid, pre);
    const int tb = wave;
    bf16x8_t qf[2];
#pragma unroll
    for (int ks = 0; ks < 2; ++ks) qf[ks] = *(const bf16x8_t*)(Qs + (16 * tb + fr) * 72 + ks * 32 + 8 * fq);
    f32x4 hs[8];
    for (int r17_ = 0; r17_ < REPN(17); ++r17_) {
#pragma unroll
    for (int vb = 0; vb < 8; ++vb) hs[vb] = (f32x4){0.f, 0.f, 0.f, 0.f};
#pragma unroll
    for (int dir = 0; dir < 2; ++dir) {
        f32x4 acc[8];
#pragma unroll
        for (int vb = 0; vb < 8; ++vb) { acc[vb] = (f32x4){0.f, 0.f, 0.f, 0.f};
#pragma unroll
            for (int ks = 0; ks < 2; ++ks) { const bf16x8_t cf = *(const bf16x8_t*)(Cs + (dir * 128 + vb * 16 + fr) * 72 + ks * 32 + 8 * fq); acc[vb] = __builtin_amdgcn_mfma_f32_16x16x32_bf16(qf[ks], cf, acc[vb], 0, 0, 0); } }
        { const f32x4 i4 = *(const f32x4*)(itv + dir * 128 + 16 * tb + 4 * fq);
#pragma unroll
          for (int vb = 0; vb < 8; ++vb) acc[vb] = acc[vb] * i4; }
        const float bt = btv[dir * 128 + 16 * tb + fr];
        float rowsum = 0.f;
#pragma unroll
        for (int pr = 0; pr < 4; ++pr) {
            const int sb0 = 2 * pr, sb1 = 2 * pr + 1;
            const bool need0 = dir == 0 ? (sb0 <= tb) : (sb0 >= tb), need1 = dir == 0 ? (sb1 <= tb) : (sb1 >= tb);
            if (!need0 && !need1) continue;
            f32x4 s0 = (f32x4){0.f, 0.f, 0.f, 0.f}, s1 = (f32x4){0.f, 0.f, 0.f, 0.f};
            if (need0) {
#pragma unroll
                for (int ks = 0; ks < 2; ++ks) { const bf16x8_t kf = *(const bf16x8_t*)(Ks + (16 * sb0 + fr) * 72 + ks * 32 + 8 * fq); s0 = __builtin_amdgcn_mfma_f32_16x16x32_bf16(kf, qf[ks], s0, 0, 0, 0); }
                const f32x4 a4 = *(const f32x4*)(asv + dir * 128 + 16 * sb0 + 4 * fq);
#pragma unroll
                for (int j = 0; j < 4; ++j) { const bool valid = (sb0 != tb) || (dir == 0 ? (4 * fq + j <= fr) : (4 * fq + j >= fr)); s0[j] = valid ? s0[j] * __expf(bt + a4[j]) : 0.f; }
            }
            if (need1) {
#pragma unroll
                for (int ks = 0; ks < 2; ++ks) { const bf16x8_t kf = *(const bf16x8_t*)(Ks + (16 * sb1 + fr) * 72 + ks * 32 + 8 * fq); s1 = __builtin_amdgcn_mfma_f32_16x16x32_bf16(kf, qf[ks], s1, 0, 0, 0); }
                const f32x4 a4 = *(const f32x4*)(asv + dir * 128 + 16 * sb1 + 4 * fq);
#pragma unroll
                for (int j = 0; j < 4; ++j) { const bool valid = (sb1 != tb) || (dir == 0 ? (4 * fq + j <= fr) : (4 * fq + j >= fr)); s1[j] = valid ? s1[j] * __expf(bt + a4[j]) : 0.f; }
            }
            rowsum += (s0[0] + s0[1]) + (s0[2] + s0[3]) + (s1[0] + s1[1]) + (s1[2] + s1[3]);
            u32x4 pw; pw.x = cvtpk(s0[0], s0[1]); pw.y = cvtpk(s0[2], s0[3]); pw.z = cvtpk(s1[0], s1[1]); pw.w = cvtpk(s1[2], s1[3]);
            const bf16x8_t pa = __builtin_bit_cast(bf16x8_t, pw);
#pragma unroll
            for (int vb = 0; vb < 8; ++vb) {
                const u32x2 v0 = *(const u32x2*)(VT + (vb * 16 + fr) * 136 + 16 * sb0 + 4 * fq), v1 = *(const u32x2*)(VT + (vb * 16 + fr) * 136 + 16 * sb1 + 4 * fq);
                const u32x4 vw = (u32x4){v0.x, v0.y, v1.x, v1.y};
                acc[vb] = __builtin_amdgcn_mfma_f32_16x16x32_bf16(pa, __builtin_bit_cast(bf16x8_t, vw), acc[vb], 0, 0, 0);
            }
        }
        rowsum += __shfl_xor(rowsum, 16); rowsum += __shfl_xor(rowsum, 32);
        float nq = 0.f;
        { const u32x4 qa = *(const u32x4*)(Qs + (16 * tb + fr) * 72 + 16 * fq), qb = *(const u32x4*)(Qs + (16 * tb + fr) * 72 + 16 * fq + 8); const float* nn = nin + dir * 64 + 16 * fq;
          nq = nn[0] * bflo(qa.x) + nn[1] * bfhi(qa.x) + nn[2] * bflo(qa.y) + nn[3] * bfhi(qa.y) + nn[4] * bflo(qa.z) + nn[5] * bfhi(qa.z) + nn[6] * bflo(qa.w) + nn[7] * bfhi(qa.w)
             + nn[8] * bflo(qb.x) + nn[9] * bfhi(qb.x) + nn[10] * bflo(qb.y) + nn[11] * bfhi(qb.y) + nn[12] * bflo(qb.z) + nn[13] * bfhi(qb.z) + nn[14] * bflo(qb.w) + nn[15] * bfhi(qb.w); }
        nq += __shfl_xor(nq, 16); nq += __shfl_xor(nq, 32);
        const float den = rowsum + itv[dir * 128 + 16 * tb + fr] * nq;
        const float rdn = 1.f / fmaxf(fabsf(den), emt[dir * 128 + 16 * tb + fr]);
#pragma unroll
        for (int j = 0; j < 4; ++j) { const float r = __shfl(rdn, 4 * fq + j);
#pragma unroll
            for (int vb = 0; vb < 8; ++vb) hs[vb][j] += acc[vb][j] * r; }
    }
    }
    float mu[4], rs[4];
#pragma unroll
    for (int j = 0; j < 4; ++j) { float sm = 0.f;
#pragma unroll
        for (int vb = 0; vb < 8; ++vb) sm += hs[vb][j];
        sm += __shfl_xor(sm, 1); sm += __shfl_xor(sm, 2); sm += __shfl_xor(sm, 4); sm += __shfl_xor(sm, 8);
        mu[j] = sm * (1.f / 128.f); float sq = 0.f;
#pragma unroll
        for (int vb = 0; vb < 8; ++vb) { const float d = hs[vb][j] - mu[j]; sq += d * d; }
        sq += __shfl_xor(sq, 1); sq += __shfl_xor(sq, 2); sq += __shfl_xor(sq, 4); sq += __shfl_xor(sq, 8);
        rs[j] = rsqrtf(sq * (1.f / 128.f) + LN_EPS); }
    const GAS float* mng = (const GAS float*)p.ml_norm_g + h * 128;
    for (int r18_ = 0; r18_ < REPN(18); ++r18_) {
#pragma unroll
    for (int ps = 0; ps < 2; ++ps) {
#pragma unroll
        for (int vb = 0; vb < 8; ++vb) { const float gg = mng[vb * 16 + fr];
#pragma unroll
            for (int jj = 0; jj < 2; ++jj) { const int j = 2 * ps + jj; OST[(2 * fq + jj) * 132 + vb * 16 + fr] = (hs[vb][j] - mu[j]) * rs[j] * gg; } }
        LDS_FENCE();
        { const int rl = lane >> 3, ck = lane & 7, t = 16 * tb + 4 * (rl >> 1) + 2 * ps + (rl & 1);
          const float* src = OST + rl * 132 + ck * 16;
          const f32x4 o0 = *(const f32x4*)src, o1 = *(const f32x4*)(src + 4), o2 = *(const f32x4*)(src + 8), o3 = *(const f32x4*)(src + 12);
          const GAS bf16_t* omp = U + (row0 + t) * DINP + C_OM + h * 128 + ck * 16;
          const u32x4 oa = *(const GAS u32x4*)omp, ob = *(const GAS u32x4*)(omp + 8);
          u32x4 wa, wb;
          wa.x = pk2(o0.x * sigmoidf_(bflo(oa.x)), o0.y * sigmoidf_(bfhi(oa.x))); wa.y = pk2(o0.z * sigmoidf_(bflo(oa.y)), o0.w * sigmoidf_(bfhi(oa.y)));
          wa.z = pk2(o1.x * sigmoidf_(bflo(oa.z)), o1.y * sigmoidf_(bfhi(oa.z))); wa.w = pk2(o1.z * sigmoidf_(bflo(oa.w)), o1.w * sigmoidf_(bfhi(oa.w)));
          wb.x = pk2(o2.x * sigmoidf_(bflo(ob.x)), o2.y * sigmoidf_(bfhi(ob.x))); wb.y = pk2(o2.z * sigmoidf_(bflo(ob.y)), o2.w * sigmoidf_(bfhi(ob.y)));
          wb.z = pk2(o3.x * sigmoidf_(bflo(ob.z)), o3.y * sigmoidf_(bfhi(ob.z))); wb.w = pk2(o3.z * sigmoidf_(bflo(ob.w)), o3.w * sigmoidf_(bfhi(ob.w)));
          GAS bf16_t* dst = MIX + (row0 + t) * 1024 + 512 + h * 128 + ck * 16;
          *(GAS u32x4*)dst = wa; *(GAS u32x4*)(dst + 8) = wb; }
        LDS_FENCE();
    }
    }
    __syncthreads();
}
__device__ __forceinline__ void ph5(const Params& p, unsigned char* lds, int bid, int nblk) {
    MlPre pre; const int tid0 = threadIdx.x;
    if (bid < 32 * 64) ml_out_prefetch(p, bid, tid0, pre);
    for (int it = bid; it < 32 * 64; it += nblk) ml_out_item(p, lds, it, pre, it + nblk < 32 * 64 ? it + nblk : -1);
}


struct TrItem { const GAS float* W; GAS unsigned char* WT; size_t orow0; int N, k0, n0, ldt; float qs; };
__device__ __forceinline__ TrItem tr_decode(const Params& p, int it) {
    TrItem t; const int e = it / (3 * 704), r = it % (3 * 704), which = r / 704, q = r % 704;
    if (which < 2) { const int kb = q / 44, nb = q % 44; t.n0 = nb * 64; t.k0 = kb * 64; t.W = (const GAS float*)(which == 0 ? p.w_eg : p.w_eu) + (size_t)e * 1024 * DFF; t.N = DFF;
        t.WT = (GAS unsigned char*)(p.ws + WS_WGUT) + (size_t)e * 2 * DFF * 1024; t.orow0 = (size_t)((t.n0 >> 7) * 256 + which * 128 + (t.n0 & 127)); t.ldt = 1024; t.qs = 32.f; }
    else { const int kb = q / 16, nb = q % 16; t.n0 = nb * 64; t.k0 = kb * 64; t.W = (const GAS float*)p.w_ed + (size_t)e * DFF * 1024; t.N = 1024;
        t.WT = (GAS unsigned char*)(p.ws + WS_WDT) + (size_t)e * 1024 * DFF; t.orow0 = (size_t)t.n0; t.ldt = DFF; t.qs = 64.f; }
    return t;
}
__device__ __forceinline__ void tr_load(const TrItem& t, int lane, f32x4 (&v)[16]) {
    const int cq = (lane & 15) * 4, rq = lane >> 4;
#pragma unroll
    for (int i = 0; i < 16; ++i) v[i] = __builtin_nontemporal_load((const GAS f32x4*)(t.W + (size_t)(t.k0 + 4 * i + rq) * t.N + t.n0 + cq));
}
__device__ __forceinline__ void tr_to_lds(const TrItem& t, int lane, const f32x4 (&v)[16], float* scr) {
    const int cq = (lane & 15) * 4, rq = lane >> 4;
#pragma unroll
    for (int i = 0; i < 16; ++i) { float* d = scr + (4 * i + rq) * 65 + cq; d[0] = v[i].x * t.qs; d[1] = v[i].y * t.qs; d[2] = v[i].z * t.qs; d[3] = v[i].w * t.qs; }
    LDS_FENCE();
}
__device__ __forceinline__ void tr_store(const TrItem& t, int lane, const float* scr) {
    const int c = lane & 7;
#pragma unroll
    for (int j = 0; j < 8; ++j) {
        const int n = (lane >> 3) + 8 * j; const float* sp = scr + (8 * c) * 65 + n;
        u32x2 o; o.x = pk4_fp8(sp[0 * 65], sp[1 * 65], sp[2 * 65], sp[3 * 65]); o.y = pk4_fp8(sp[4 * 65], sp[5 * 65], sp[6 * 65], sp[7 * 65]);
        *(GAS u32x2*)(t.WT + (t.orow0 + n) * t.ldt + t.k0 + 8 * c) = o;
    }
    LDS_FENCE();
}
__device__ __forceinline__ float reduce16(const float (&lg)[16], int lane) {
    float a8[8], a4[4], a2[2];
    const bool h5 = lane & 32, h4 = lane & 16, h3 = lane & 8, h2 = lane & 4;
#pragma unroll
    for (int i = 0; i < 8; ++i) { const float snd = h5 ? lg[i] : lg[8 + i], kp = h5 ? lg[8 + i] : lg[i]; a8[i] = kp + __shfl_xor(snd, 32); }
#pragma unroll
    for (int i = 0; i < 4; ++i) { const float snd = h4 ? a8[i] : a8[4 + i], kp = h4 ? a8[4 + i] : a8[i]; a4[i] = kp + __shfl_xor(snd, 16); }
#pragma unroll
    for (int i = 0; i < 2; ++i) { const float snd = h3 ? a4[i] : a4[2 + i], kp = h3 ? a4[2 + i] : a4[i]; a2[i] = kp + __shfl_xor(snd, 8); }
    const float snd = h2 ? a2[0] : a2[1], kp = h2 ? a2[1] : a2[0];
    float d = kp + __shfl_xor(snd, 4);
    d += __shfl_xor(d, 2); d += __shfl_xor(d, 1);
    return d;
}
__device__ __forceinline__ void ph7(const Params& p, unsigned char* lds, int bid, int nblk) {
    const int tid = ltid(), lane = tid & 63, wave = tid >> 6;
    const GAS float* MOD = (const GAS float*)(p.ws + WS_MOD); GAS unsigned char* HMOD = (GAS unsigned char*)(p.ws + WS_HMOD); GAS float* AFF = (GAS float*)(p.ws + WS_AFF);
    const GAS bf16_t* Y = (const GAS bf16_t*)(p.ws + WS_Y); const GAS float* ln1g = (const GAS float*)p.ln1_g; const GAS float* ln1b = (const GAS float*)p.ln1_b;
    const int gw = bid * NWAVES + wave, ngw = nblk * NWAVES;
    __syncthreads();
    float* WR = (float*)lds; float* RED = WR + 16 * 1028;
    { const GAS float* wr = (const GAS float*)p.w_router; for (int idx = tid; idx < 16 * 1024; idx += NTHR) { const int k = idx >> 4, e = idx & 15; WR[e * 1028 + k] = wr[idx]; } }
    __syncthreads();
    for (int rep12_ = 0; rep12_ < REPN(12); ++rep12_) {
    u32x2 vn[2][4];
    if (2 * gw < NLAT) {
#pragma unroll
        for (int r = 0; r < 2; ++r)
#pragma unroll
            for (int j = 0; j < 4; ++j) vn[r][j] = *(const GAS u32x2*)(Y + (size_t)(2 * gw + r) * 1024 + j * 256 + lane * 4); }
    for (int m0 = 2 * gw; m0 < NLAT; m0 += 2 * ngw) {
        asm volatile("" ::: "memory");
        const int b = m0 >> 13;
        const GAS float* sh2 = MOD + b * 6144 + 3072; const GAS float* sc2 = sh2 + 1024;
        f32x4 v[2][4]; float mean[2], rstd[2];
#pragma unroll
        for (int r = 0; r < 2; ++r)
#pragma unroll
            for (int j = 0; j < 4; ++j) v[r][j] = (f32x4){hlo(vn[r][j].x), hhi(vn[r][j].x), hlo(vn[r][j].y), hhi(vn[r][j].y)};
        if (m0 + 2 * ngw < NLAT) {
#pragma unroll
            for (int r = 0; r < 2; ++r)
#pragma unroll
                for (int j = 0; j < 4; ++j) vn[r][j] = *(const GAS u32x2*)(Y + (size_t)(m0 + 2 * ngw + r) * 1024 + j * 256 + lane * 4); }
#pragma unroll
        for (int r = 0; r < 2; ++r) { float sm = 0.f;
#pragma unroll
            for (int j = 0; j < 4; ++j) sm += (v[r][j].x + v[r][j].y) + (v[r][j].z + v[r][j].w);
            mean[r] = wave_sum(sm) * (1.f / 1024.f); float s2 = 0.f;
#pragma unroll
            for (int j = 0; j < 4; ++j) { v[r][j] = v[r][j] - mean[r]; s2 += (v[r][j].x * v[r][j].x + v[r][j].y * v[r][j].y) + (v[r][j].z * v[r][j].z + v[r][j].w * v[r][j].w); }
            rstd[r] = rsqrtf(wave_sum(s2) * (1.f / 1024.f) + LN_EPS); }
        f32x4 hm[2][4];
#pragma unroll
        for (int j = 0; j < 4; ++j) {
            const int k = j * 256 + lane * 4;
            const f32x4 g = *(const GAS f32x4*)(ln1g + k), be = *(const GAS f32x4*)(ln1b + k), a = *(const GAS f32x4*)(sc2 + k), sb = *(const GAS f32x4*)(sh2 + k);
#pragma unroll
            for (int r = 0; r < 2; ++r) { hm[r][j] = (v[r][j] * rstd[r] * g + be) * (1.f + a) + sb;
                *(GAS unsigned*)(HMOD + (size_t)(m0 + r) * 1024 + k) = pk4_fp8(hm[r][j].x, hm[r][j].y, hm[r][j].z, hm[r][j].w); }
        }
        float* red = RED + wave * (2 * 64 * 17);
#pragma unroll
        for (int e4 = 0; e4 < 4; ++e4) {
            float a[2][4];
#pragma unroll
            for (int ee = 0; ee < 4; ++ee) {
                f32x4 a0 = {0.f, 0.f, 0.f, 0.f}, a1 = {0.f, 0.f, 0.f, 0.f};
#pragma unroll
                for (int j = 0; j < 4; ++j) { const f32x4 w = *(const f32x4*)(WR + (e4 * 4 + ee) * 1028 + j * 256 + lane * 4);
                    a0 = __builtin_elementwise_fma(hm[0][j], w, a0); a1 = __builtin_elementwise_fma(hm[1][j], w, a1); }
                a[0][ee] = (a0.x + a0.y) + (a0.z + a0.w); a[1][ee] = (a1.x + a1.y) + (a1.z + a1.w);
            }
#pragma unroll
            for (int ee = 0; ee < 4; ++ee) { red[lane * 17 + e4 * 4 + ee] = a[0][ee]; red[64 * 17 + lane * 17 + e4 * 4 + ee] = a[1][ee]; }
            asm volatile("" ::: "memory");
        }
        LDS_FENCE();
        { const int e = lane & 15, r = (lane >> 4) & 1, part = lane >> 5;
          float d = 0.f; const float* src = red + r * (64 * 17) + e + part * 32 * 17;
#pragma unroll 8
          for (int l = 0; l < 32; ++l) d += src[l * 17];
          d += __shfl_xor(d, 32);
          float mx = d; mx = fmaxf(mx, __shfl_xor(mx, 1)); mx = fmaxf(mx, __shfl_xor(mx, 2)); mx = fmaxf(mx, __shfl_xor(mx, 4)); mx = fmaxf(mx, __shfl_xor(mx, 8));
          const float ex = expf(d - mx); float sm = ex; sm += __shfl_xor(sm, 1); sm += __shfl_xor(sm, 2); sm += __shfl_xor(sm, 4); sm += __shfl_xor(sm, 8);
          if (lane < 32) AFF[((size_t)b * 16 + e) * 8192 + ((m0 + r) & 8191)] = ex / sm; }
        LDS_FENCE();
    }
    }
}
__device__ __forceinline__ void ph7_conv(const Params& p, unsigned char* lds, int bid, int nblk) {
    const int tid = ltid(), lane = tid & 63, wave = tid >> 6;
    const int gw = bid * NWAVES + wave, ngw = nblk * NWAVES;
    float* scr = (float*)lds + wave * (64 * 65);
    for (int rep13_ = 0; rep13_ < REPN(13); ++rep13_) {
        f32x4 tv[16]; int it = gw;
        if (it < NE * 3 * 704) { const TrItem c0 = tr_decode(p, it); tr_load(c0, lane, tv); }
        for (; it < NE * 3 * 704; it += ngw) {
            const TrItem cur = tr_decode(p, it);
            tr_to_lds(cur, lane, tv, scr);
            if (it + ngw < NE * 3 * 704) { const TrItem nx = tr_decode(p, it + ngw); tr_load(nx, lane, tv); }
            tr_store(cur, lane, scr);
        }
    }
    __syncthreads();
}

__device__ __forceinline__ void topk_item(const Params& p, unsigned char* lds, int item) {
    const float* AFF = (const float*)(p.ws + WS_AFF); int* IDX = (int*)(p.ws + WS_IDX); float* GSEL = (float*)(p.ws + WS_GSEL); int* INV = (int*)(p.ws + WS_INV);
    const int tid = ltid(), lane = tid & 63, wave = tid >> 6;
    const int b = item >> 4, e = item & 15;
    unsigned* wcnt = (unsigned*)lds;
    const float* a = AFF + ((size_t)b * 16 + e) * 8192;
    unsigned bits[16];
#pragma unroll
    for (int j = 0; j < 16; ++j) bits[j] = __float_as_uint(a[j * 512 + tid]);
    __syncthreads();
    unsigned tau = 0u;
    for (int bit = 30; bit >= 0; --bit) {
        const unsigned cand = tau | (1u << bit);
        unsigned cnt = 0;
#pragma unroll
        for (int j = 0; j < 16; ++j) cnt += (unsigned)__popcll(__ballot(bits[j] >= cand));
        unsigned* slot = wcnt + ((bit & 1) << 3);
        if (lane == 0) slot[wave] = cnt;
        __syncthreads();
        unsigned tot = 0;
#pragma unroll
        for (int w = 0; w < 8; ++w) tot += slot[w];
        if (tot >= (unsigned)CAP) tau = cand;
    }
    unsigned* ctab = wcnt + 32;
    const unsigned long long lt_mask = (1ull << lane) - 1ull;
#pragma unroll
    for (int j = 0; j < 16; ++j) { const unsigned cw = (unsigned)__popcll(__ballot(bits[j] > tau)) | ((unsigned)__popcll(__ballot(bits[j] == tau)) << 16);
        if (lane == 0) ctab[j * 8 + wave] = cw; }
    __syncthreads();
    unsigned ngt = 0;
#pragma unroll
    for (int j = 0; j < 16; ++j)
#pragma unroll
        for (int w = 0; w < 8; ++w) ngt += ctab[j * 8 + w] & 0xffffu;
    const unsigned need = (unsigned)CAP - ngt;
    unsigned base_gt = 0, base_eq = 0;
#pragma unroll
    for (int j = 0; j < 16; ++j) {
        const bool gt = bits[j] > tau, eq = bits[j] == tau;
        const unsigned long long bg = __ballot(gt), be = __ballot(eq);
        unsigned pgt = 0, peq = 0, tgt = 0, teq = 0;
#pragma unroll
        for (int w = 0; w < 8; ++w) { const unsigned cw = ctab[j * 8 + w], cg_ = cw & 0xffffu, ce = cw >> 16; if (w < wave) { pgt += cg_; peq += ce; } tgt += cg_; teq += ce; }
        const unsigned gt_before = base_gt + pgt + (unsigned)__popcll(bg & lt_mask), eq_before = base_eq + peq + (unsigned)__popcll(be & lt_mask);
        const bool sel = gt || (eq && eq_before < need);
        const unsigned slot = gt_before + (eq_before < need ? eq_before : need);
        const int i = j * 512 + tid;
        if (sel) { IDX[(e * 8 + b) * CAP + slot] = i; GSEL[(e * 8 + b) * CAP + slot] = __uint_as_float(bits[j]); }
        INV[((size_t)b * 8192 + i) * 16 + e] = sel ? (int)slot : -1;
        base_gt += tgt; base_eq += teq;
    }
    __syncthreads();
}
__device__ __forceinline__ void ph8(const Params& p, unsigned char* lds, int bid, int nblk) { for (int it = bid; it < 128; it += nblk) topk_item(p, lds, it); }


#define XB_TMO      128
#define XB_XCNT(j)  (256  + 64 * (j))
#define XB_XSUB(j)  (1280 + 64 * (j))
#define XB_XGEN(j)  (2304 + 64 * (j))
#define XB_TOP      3328
#define XB_TOPGEN   3392
#define XCD_BAR_WORDS 3456
#define XB_SPIN_CAP (1u << 18)
__device__ __forceinline__ unsigned xb_ld(unsigned* p)              { return __hip_atomic_load(p, __ATOMIC_RELAXED, __HIP_MEMORY_SCOPE_AGENT); }
__device__ __forceinline__ unsigned xb_add(unsigned* p, unsigned v) { return __hip_atomic_fetch_add(p, v, __ATOMIC_RELAXED, __HIP_MEMORY_SCOPE_AGENT); }
__device__ __forceinline__ unsigned xb_xcc_id() { return (unsigned)__builtin_amdgcn_s_getreg((3 << 11) | 20) & 0xFu; }
#define XB_SPIN(cond, bar) do { unsigned _sp = 0; while (cond) { __builtin_amdgcn_s_sleep(1); \
    if ((++_sp & 255u) == 0u) { if (xb_ld(&(bar)[XB_TMO])) break; if (_sp > XB_SPIN_CAP) { atomicAdd(&(bar)[XB_TMO], 1u); break; } } } } while (0)
struct XcdBarrier { unsigned* bar; unsigned x; volatile LAS unsigned* st; };
__device__ __forceinline__ XcdBarrier xcd_barrier_post(unsigned* bar, volatile LAS unsigned* st) {
    XcdBarrier b; b.bar = bar; b.x = xb_xcc_id(); b.st = st;
    if (threadIdx.x == 0) (void)xb_add(&bar[XB_XCNT(b.x)], 1u);
    return b;
}
__device__ __forceinline__ void xcd_barrier_complete(unsigned* bar, unsigned x, unsigned& nloc, unsigned& nx) {
    const unsigned G = gridDim.x * gridDim.y * gridDim.z;
    unsigned sum, cnt, mine, sp = 0u;
    for (;;) {
        sum = 0u; cnt = 0u; mine = 0u;
#pragma unroll
        for (unsigned j = 0; j < 16; ++j) { const unsigned c = xb_ld(&bar[XB_XCNT(j)]); sum += c; cnt += (c > 0u) ? 1u : 0u; mine = (j == x) ? c : mine; }
        if (sum == G) break;
        __builtin_amdgcn_s_sleep(1);
        if ((++sp & 255u) == 0u) { if (xb_ld(&bar[XB_TMO])) break; if (sp > XB_SPIN_CAP) { atomicAdd(&bar[XB_TMO], 1u); break; } }
    }
    nloc = mine > 0u ? mine : 1u; nx = cnt > 0u ? cnt : 1u;
}
__device__ __forceinline__ void xcd_barrier(const XcdBarrier& b) {
    asm volatile("s_waitcnt vmcnt(0)" ::: "memory");
    __syncthreads();
    if (threadIdx.x == 0) {
        unsigned* bar = b.bar;
        __builtin_amdgcn_s_waitcnt(0);
        unsigned nloc = b.st[0], nx = b.st[1];
        if (nloc == 0u) { xcd_barrier_complete(bar, b.x, nloc, nx); b.st[0] = nloc; b.st[1] = nx; }
        const unsigned old = xb_add(&bar[XB_XSUB(b.x)], 1u);
        const unsigned gen = old / nloc;
        if (old + 1u == (gen + 1u) * nloc) {
            __builtin_amdgcn_fence(__ATOMIC_RELEASE, "agent");
            asm volatile("s_waitcnt vmcnt(0)" ::: "memory");
            const unsigned og = xb_add(&bar[XB_TOP], 1u);
            const unsigned tg = og / nx;
            if (og + 1u == (tg + 1u) * nx) xb_add(&bar[XB_TOPGEN], 1u);
            else XB_SPIN(xb_ld(&bar[XB_TOPGEN]) == tg, bar);
            __builtin_amdgcn_fence(__ATOMIC_ACQUIRE, "agent");
            xb_add(&bar[XB_XGEN(b.x)], 1u);
            asm volatile("s_waitcnt vmcnt(0)" ::: "memory");
        } else {
            XB_SPIN(xb_ld(&bar[XB_XGEN(b.x)]) == gen, bar);
            __builtin_amdgcn_fence(__ATOMIC_ACQUIRE, "agent");
            asm volatile("s_waitcnt vmcnt(0)" ::: "memory");
        }
    }
    __syncthreads();
}

__device__ __forceinline__ pg8::GemmDesc make_desc(const Params& p, int gi) {
    pg8::GemmDesc g{};
    if (gi == 0) { g.A = p.ws + WS_XM; g.Bt = p.ws + WS_WINT; g.O = p.ws + WS_U; g.Kb = 2048; g.nM = MROWS / 256; g.nN = DINP / 256; g.epi = 0; g.ldc = DINP; g.qtiles = 2; }
    else if (gi == 1) { g.A = p.ws + WS_MIX; g.Bt = p.ws + WS_WOUTG; g.bEstride = (size_t)D_ * D_ * 2; g.O = p.ws + WS_Y; g.x = p.x; g.Kb = 2048; g.nM = NLAT / 256; g.nN = 4; g.epi = 2; g.ldc = 1024; }
    else if (gi == 2) { g.A = p.ws + WS_HMOD; g.Bt = p.ws + WS_WGUT; g.IDX = (const int*)(p.ws + WS_IDX); g.O = p.ws + WS_ACT; g.bEstride = (size_t)2 * DFF * 1024; g.Kb = 1024; g.nM = NE * 32; g.nN = 22; g.epi = 1; g.ldc = DFF; }
    else { g.A = p.ws + WS_ACT; g.Bt = p.ws + WS_WDT; g.O = p.ws + WS_EO; g.bEstride = (size_t)1024 * DFF; g.Kb = DFF; g.nM = NE * 32; g.nN = 4; g.epi = 3; g.ldc = 1024; }
    return g;
}

__device__ __forceinline__ void ph_final(const Params& p, int bid, int nblk) {
    const int tid = ltid(), lane = tid & 63, wave = tid >> 6;
    const GAS float* MOD = (const GAS float*)(p.ws + WS_MOD); const GAS bf16_t* EO = (const GAS bf16_t*)(p.ws + WS_EO); const GAS float* GSEL = (const GAS float*)(p.ws + WS_GSEL); const GAS int* INV = (const GAS int*)(p.ws + WS_INV);
    const GAS bf16_t* Y = (const GAS bf16_t*)(p.ws + WS_Y); GAS float* OUT = (GAS float*)p.out; const GAS float* ln1g = (const GAS float*)p.ln1_g; const GAS float* ln1b = (const GAS float*)p.ln1_b; const GAS float* ln2g = (const GAS float*)p.ln2_g; const GAS float* ln2b = (const GAS float*)p.ln2_b;
    constexpr int NPF = 3;
    const int mstride = nblk * NWAVES;
    int m = bid * NWAVES + wave;
    u32x2 vn[4]; int inv1 = -1, inv2 = -1;
    u32x2 pe[NPF][4]; float pg[NPF];
#define FIN_PREFETCH(row_, inv_) do { unsigned _em = (unsigned)__ballot((inv_) >= 0); const int _bb = (row_) >> 13; \
        _Pragma("unroll") for (int _t = 0; _t < NPF; ++_t) { \
            if (_em) { const int _e = __builtin_ctz(_em); _em &= _em - 1u; const int _slot = __builtin_amdgcn_readlane((inv_), _e); \
                pg[_t] = GSEL[(_e * 8 + _bb) * CAP + _slot]; const GAS bf16_t* _rp = EO + ((size_t)_e * 8192 + _bb * 1024 + _slot) * 1024; \
                _Pragma("unroll") for (int j = 0; j < 4; ++j) pe[_t][j] = *(const GAS u32x2*)(_rp + j * 256 + lane * 4); } \
            else { pg[_t] = 0.f; _Pragma("unroll") for (int j = 0; j < 4; ++j) pe[_t][j] = (u32x2){0u, 0u}; } } } while (0)
    if (m < NLAT) { inv1 = lane < 16 ? INV[(size_t)m * 16 + lane] : -1;
#pragma unroll
        for (int j = 0; j < 4; ++j) vn[j] = *(const GAS u32x2*)(Y + (size_t)m * 1024 + j * 256 + lane * 4);
        if (m + mstride < NLAT) inv2 = lane < 16 ? INV[(size_t)(m + mstride) * 16 + lane] : -1;
        FIN_PREFETCH(m, inv1); }
    for (; m < NLAT; m += mstride) {
        const int b = m >> 13;
        GAS float* y = OUT + (size_t)m * 1024; const GAS float* g2 = MOD + b * 6144 + 5120;
        const int myinv = inv1;
        f32x4 v[4]; float s = 0.f;
#pragma unroll
        for (int j = 0; j < 4; ++j) { v[j] = (f32x4){hlo(vn[j].x), hhi(vn[j].x), hlo(vn[j].y), hhi(vn[j].y)}; s += (v[j].x + v[j].y) + (v[j].z + v[j].w); }
        f32x4 moe[4];
#pragma unroll
        for (int j = 0; j < 4; ++j) moe[j] = (f32x4){0.f, 0.f, 0.f, 0.f};
        unsigned emask = (unsigned)__ballot(myinv >= 0);
#pragma unroll
        for (int t = 0; t < NPF; ++t) { if (emask) { emask &= emask - 1u; const float g = pg[t];
#pragma unroll
            for (int j = 0; j < 4; ++j) { const u32x2 w = pe[t][j]; moe[j].x += g * bflo(w.x); moe[j].y += g * bfhi(w.x); moe[j].z += g * bflo(w.y); moe[j].w += g * bfhi(w.y); } } }
        { const int mn = m + mstride; inv1 = inv2;
          if (mn < NLAT) {
#pragma unroll
              for (int j = 0; j < 4; ++j) vn[j] = *(const GAS u32x2*)(Y + (size_t)mn * 1024 + j * 256 + lane * 4);
              inv2 = (mn + mstride < NLAT && lane < 16) ? INV[(size_t)(mn + mstride) * 16 + lane] : -1;
              FIN_PREFETCH(mn, inv1); } }
        while (emask) {
            const int e = __builtin_ctz(emask); emask &= emask - 1u;
            const int slot = __builtin_amdgcn_readlane(myinv, e);
            const float g = GSEL[(e * 8 + b) * CAP + slot];
            const GAS bf16_t* row = EO + ((size_t)e * 8192 + b * 1024 + slot) * 1024;
#pragma unroll
            for (int j = 0; j < 4; ++j) { const u32x2 w = *(const GAS u32x2*)(row + j * 256 + lane * 4); moe[j].x += g * bflo(w.x); moe[j].y += g * bfhi(w.x); moe[j].z += g * bflo(w.y); moe[j].w += g * bfhi(w.y); }
        }
        const float mean = wave_sum(s) * (1.f / 1024.f); float s2 = 0.f;
#pragma unroll
        for (int j = 0; j < 4; ++j) { v[j] = v[j] - mean; s2 += (v[j].x * v[j].x + v[j].y * v[j].y) + (v[j].z * v[j].z + v[j].w * v[j].w); }
        const float rstd = rsqrtf(wave_sum(s2) * (1.f / 1024.f) + LN_EPS);
        float s3 = 0.f;
#pragma unroll
        for (int j = 0; j < 4; ++j) { const int k = j * 256 + lane * 4;
            const f32x4 g = *(const GAS f32x4*)(ln1g + k), be = *(const GAS f32x4*)(ln1b + k), gg = *(const GAS f32x4*)(g2 + k);
            v[j] = ALPHA * (v[j] * rstd * g + be) + gg * moe[j]; s3 += (v[j].x + v[j].y) + (v[j].z + v[j].w); }
        const float mean2 = wave_sum(s3) * (1.f / 1024.f); float s4 = 0.f;
#pragma unroll
        for (int j = 0; j < 4; ++j) { v[j] = v[j] - mean2; s4 += (v[j].x * v[j].x + v[j].y * v[j].y) + (v[j].z * v[j].z + v[j].w * v[j].w); }
        const float rstd2 = rsqrtf(wave_sum(s4) * (1.f / 1024.f) + LN_EPS);
#pragma unroll
        for (int j = 0; j < 4; ++j) { const int k = j * 256 + lane * 4; const f32x4 g = *(const GAS f32x4*)(ln2g + k), be = *(const GAS f32x4*)(ln2b + k);
            __builtin_nontemporal_store(v[j] * rstd2 * g + be, (GAS f32x4*)(y + k)); }
    }
}

constexpr int NPHASE = 12;
#ifndef ONLY_PH
#define ONLY_PH -1
#endif
#define PH_EN(n) (ONLY_PH < 0 || ONLY_PH == (n))
__global__ void __launch_bounds__(NTHR, 2) mk_fwd(Params p) {
    extern __shared__ __attribute__((aligned(16))) unsigned char lds[];
    const int bid = blockIdx.x, nblk = gridDim.x;
    volatile LAS unsigned* MISC = (volatile LAS unsigned*)((LAS unsigned char*)lds + (LDS_BYTES - 16));
    if (threadIdx.x < 4) MISC[threadIdx.x] = 0u;
    __syncthreads();
    const XcdBarrier xbar = xcd_barrier_post((unsigned*)(p.ws + WS_CTL) + 4096, MISC);
#ifndef PHMASK
#define PHMASK 0xffff
#endif
#define IN(k) ((((PHMASK) >> (k)) & 1) && p.ph_lo <= (k) && (k) < p.ph_hi)
#define LOADP() load_params()
#define LAUNDER() const int bid_ = bid, nblk_ = nblk; unsigned char* const lds_ = lds
#define SEAM(k) do { if (IN(k) && IN((k) + 1)) xcd_barrier(xbar); } while (0)
    if (IN(0)) for (int rep_ = 0; rep_ < REPN(0); ++rep_) { const Params q = LOADP(); LAUNDER(); ph0(q, lds_, bid_, nblk_); }
    SEAM(0);
    if (IN(1)) for (int rep_ = 0; rep_ < REPN(1); ++rep_) { const Params q = LOADP(); LAUNDER(); ph1(q, bid_, nblk_); }
    SEAM(1);
    if (IN(2)) for (int rep_ = 0; rep_ < REPN(2); ++rep_) { const Params q = load_params_s(); LAUNDER(); const pg8::GemmDesc g = make_desc(q, 0); pg8::gemm_phase<false, false>((LAS unsigned char*)lds, g, nblk_, bid_); }
    SEAM(2);
    if (IN(3)) for (int rep_ = 0; rep_ < REPN(3); ++rep_) { const Params q = LOADP(); LAUNDER(); ph3(q, lds_, bid_, nblk_); }
    SEAM(3);
    if (IN(4)) for (int rep_ = 0; rep_ < REPN(4); ++rep_) { const Params q = LOADP(); LAUNDER(); ph4(q, bid_, nblk_); }
    SEAM(4);
    if (IN(5)) for (int rep_ = 0; rep_ < REPN(5); ++rep_) { const Params q = LOADP(); LAUNDER(); ph5(q, lds_, bid_, nblk_); }
    SEAM(5);
    if (IN(6)) for (int rep_ = 0; rep_ < REPN(6); ++rep_) { const Params q = load_params_s(); LAUNDER(); const int grp_ = (bid_ >> 5) & 1;
        if (grp_ == 0) ph7_conv(q, lds_, bid_, nblk_);
        { const pg8::GemmDesc g = make_desc(q, 1); pg8::gemm_phase<false, false>((LAS unsigned char*)lds, g, nblk_, bid_); }
        if (grp_ != 0) { const Params q2 = LOADP(); ph7_conv(q2, lds_, bid_, nblk_); } }
    SEAM(6);
    if (IN(7)) for (int rep_ = 0; rep_ < REPN(7); ++rep_) { const Params q = LOADP(); LAUNDER(); ph7(q, lds_, bid_, nblk_); }
    SEAM(7);
    if (IN(8)) for (int rep_ = 0; rep_ < REPN(8); ++rep_) { const Params q = LOADP(); LAUNDER(); ph8(q, lds_, bid_, nblk_); }
    SEAM(8);
#pragma unroll 1
    for (int st = 2; st < 4; ++st) {
        if (IN(7 + st)) for (int rep_ = 0; rep_ < REPN(9); ++rep_) { const Params q = load_params_s(); LAUNDER(); const pg8::GemmDesc g = make_desc(q, st); pg8::gemm_phase<true, true>((LAS unsigned char*)lds, g, nblk_, bid_); }
        SEAM(7 + st);
    }
    if (IN(11)) for (int rep_ = 0; rep_ < REPN(11); ++rep_) { const Params q = LOADP(); LAUNDER(); ph_final(q, bid_, nblk_); }
#undef IN
#undef SEAM
}

extern "C" void kernel_launch(void* const* d_in, const int* in_sizes, int n_in, void* d_out, int out_size, void* d_ws, size_t ws_size, hipStream_t stream) {
    static int grid_blocks = 0;
    if (grid_blocks == 0) {
        if (n_in != 20 || out_size != NLAT * D_ || ws_size < WS_WOUTG + (size_t)NB * D_ * D_ * 2 || ws_size < WS_END) { fprintf(stderr, "kernel_launch: unexpected shapes (n_in %d out %d ws %zu need %zu)\n", n_in, out_size, ws_size, (size_t)WS_END); grid_blocks = -1; return; }
        int dev = 0, cus = 0, per_cu = 0;
        if (hipGetDevice(&dev) != hipSuccess || hipDeviceGetAttribute(&cus, hipDeviceAttributeMultiprocessorCount, dev) != hipSuccess) { grid_blocks = -1; return; }
        if (hipFuncSetAttribute((const void*)mk_fwd, hipFuncAttributeMaxDynamicSharedMemorySize, LDS_BYTES) != hipSuccess) { fprintf(stderr, "kernel_launch: hipFuncSetAttribute failed\n"); grid_blocks = -1; return; }
        if (hipOccupancyMaxActiveBlocksPerMultiprocessor(&per_cu, (const void*)mk_fwd, NTHR, LDS_BYTES) != hipSuccess || per_cu < 1) { fprintf(stderr, "kernel_launch: occupancy query failed (%d)\n", per_cu); grid_blocks = -1; return; }
        grid_blocks = cus * per_cu;
    }
    if (grid_blocks < 0) return;
    if (hipMemsetAsync((char*)d_ws + WS_CTL, 0, 65536, stream) != hipSuccess) { fprintf(stderr, "kernel_launch: hipMemsetAsync failed\n"); return; }
    Params p{};
    const float** pp = (const float**)&p;
    for (int i = 0; i < 20; ++i) pp[i] = (const float*)d_in[i];
    p.out = (float*)d_out; p.ws = (unsigned char*)d_ws;
    p.ph_lo = 0; p.ph_hi = NPHASE;
    void* args[] = {&p};
    hipError_t e = hipLaunchCooperativeKernel((const void*)mk_fwd, dim3(grid_blocks), dim3(NTHR), args, LDS_BYTES, stream);
    if (e != hipSuccess) fprintf(stderr, "cooperative launch failed: %s (grid %d)\n", hipGetErrorString(e), grid_blocks);
}
```

```cpp
#include <hip/hip_runtime.h>
#include <hip/hip_cooperative_groups.h>
#include <cstdio>
#include <cstdint>
namespace cg = cooperative_groups;
#ifndef REPMASK
#define REPMASK 0
#endif
#define REPN(k) ((((REPMASK) >> (k)) & 1) ? 2 : 1)

typedef unsigned short bf16_t;
#define GAS __attribute__((address_space(1)))
typedef float f32x4 __attribute__((ext_vector_type(4)));
typedef unsigned u32x4 __attribute__((ext_vector_type(4)));
typedef unsigned u32x2 __attribute__((ext_vector_type(2)));

constexpr int NB = 8, T_ = 8192, D_ = 1024, LC = 256;
constexpr int NLAT = NB * T_, NCTX = NB * LC, MROWS = NLAT + NCTX;
constexpr int DIN = 3088, DINP = 3328;
constexpr int NE = 16, CAP = 1024, DFF = 2816;
constexpr int C_QA = 0, C_KA = 512, C_VA = 1024, C_QM = 1536, C_KM = 1792, C_VM = 2048, C_OM = 2560, C_GT = 3072;
constexpr int NCH = 66;
constexpr float LN_EPS = 1e-5f;
constexpr float ALPHA = 1.189207115002721f;
constexpr int NGROUPS = 1, EPG = NE / NGROUPS;

constexpr int NTHR = 512, NWAVES = 8;
constexpr int LDS_BYTES = 163840;

constexpr size_t MiB = 1u << 20;
constexpr size_t WS_CTL = 0;
constexpr size_t WS_MOD = 1 * MiB;
constexpr size_t WS_ROPE = 1 * MiB + 256 * 1024;
constexpr size_t WS_BLAST = 1 * MiB + 512 * 1024;
constexpr size_t WS_MLOC = WS_BLAST + 32 * 1024;
constexpr size_t WS_MIN = WS_MLOC + 32 * 1024;
constexpr size_t WS_NLOC = 2 * MiB;
constexpr size_t WS_IDX = 4 * MiB;
constexpr size_t WS_GSEL = 4 * MiB + 512 * 1024;
constexpr size_t WS_AFF = 5 * MiB;
constexpr size_t WS_INV = 9 * MiB;
constexpr size_t WS_WINT = 16 * MiB;
constexpr size_t WS_WOUTT = 23 * MiB;
constexpr size_t WS_XM = 32 * MiB;
constexpr size_t WS_U = 164 * MiB;
constexpr size_t WS_QP = 593 * MiB;
constexpr size_t WS_KP = 625 * MiB;
constexpr size_t WS_CLOC = 658 * MiB;
constexpr size_t WS_MIX = 32 * MiB;
constexpr size_t WS_WOUTG = 948 * MiB;
constexpr size_t WS_Y = 820 * MiB;
constexpr size_t WS_HMOD = 16 * MiB;
constexpr size_t WS_WGUT = 688 * MiB;
constexpr size_t WS_WDT = 776 * MiB;
constexpr size_t WS_EO = 80 * MiB;
constexpr size_t WS_ACT = 336 * MiB;
constexpr size_t WS_END = WS_WDT + (size_t)NE * D_ * DFF;
static_assert(WS_XM + (size_t)MROWS * D_ * 2 <= WS_U, "map");
static_assert(WS_U + (size_t)MROWS * DINP * 2 <= WS_QP, "map");
static_assert(WS_KP + (size_t)MROWS * 256 * 2 <= WS_CLOC, "map");
static_assert(WS_CLOC + (size_t)64 * NCH * 8192 * 4 <= WS_Y, "map");
static_assert(WS_MIX + (size_t)NLAT * D_ * 2 <= WS_U, "map");
static_assert(WS_Y + (size_t)NLAT * D_ * 2 <= WS_WOUTG && WS_WOUTG + (size_t)NB * D_ * D_ * 2 <= 1024 * MiB, "map");
static_assert(WS_HMOD + (size_t)NLAT * D_ <= WS_EO && WS_EO + (size_t)NE * 8192 * D_ * 2 <= WS_ACT, "map");
static_assert(WS_ACT + (size_t)NE * 8192 * DFF <= WS_WGUT && WS_WGUT + (size_t)NE * 2 * DFF * D_ <= WS_WDT, "map");
static_assert(WS_MIX + (size_t)NLAT * D_ * 2 <= WS_WGUT && WS_CLOC <= WS_WGUT, "map");
static_assert(WS_END <= WS_Y, "map");

struct Params {
    const float *x, *c, *ctx, *c_ctx, *w_ada, *b_ada, *w_in, *b_gate, *conv_qk, *na_bias, *ml_norm_g, *w_out,
        *ln1_g, *ln1_b, *w_router, *w_eg, *w_eu, *w_ed, *ln2_g, *ln2_b;
    float* out; unsigned char* ws;
    int ph_lo, ph_hi;
};


template <class T> __device__ __forceinline__ T* as_global(T* p) { return (T*)(__attribute__((address_space(1))) T*)p; }
__device__ __forceinline__ Params load_params_s() {
    const Params* kp = (const Params*)__builtin_amdgcn_kernarg_segment_ptr(); asm volatile("" : "+s"(kp));
    const __attribute__((address_space(4))) unsigned long long* kc = (const __attribute__((address_space(4))) unsigned long long*)(unsigned long long)kp;
    Params q;
    q.x = (const float*)kc[0]; q.c = (const float*)kc[1]; q.ctx = (const float*)kc[2]; q.c_ctx = (const float*)kc[3]; q.w_ada = (const float*)kc[4]; q.b_ada = (const float*)kc[5]; q.w_in = (const float*)kc[6];
    q.b_gate = (const float*)kc[7]; q.conv_qk = (const float*)kc[8]; q.na_bias = (const float*)kc[9]; q.ml_norm_g = (const float*)kc[10]; q.w_out = (const float*)kc[11];
    q.ln1_g = (const float*)kc[12]; q.ln1_b = (const float*)kc[13]; q.w_router = (const float*)kc[14]; q.w_eg = (const float*)kc[15]; q.w_eu = (const float*)kc[16]; q.w_ed = (const float*)kc[17];
    q.ln2_g = (const float*)kc[18]; q.ln2_b = (const float*)kc[19]; q.out = (float*)kc[20]; q.ws = (unsigned char*)kc[21];
    { const unsigned long long ph = kc[22]; q.ph_lo = (int)(unsigned)ph; q.ph_hi = (int)(unsigned)(ph >> 32); }
    q.x = as_global(q.x); q.c = as_global(q.c); q.ctx = as_global(q.ctx); q.c_ctx = as_global(q.c_ctx); q.w_ada = as_global(q.w_ada); q.b_ada = as_global(q.b_ada); q.w_in = as_global(q.w_in);
    q.b_gate = as_global(q.b_gate); q.conv_qk = as_global(q.conv_qk); q.na_bias = as_global(q.na_bias); q.ml_norm_g = as_global(q.ml_norm_g); q.w_out = as_global(q.w_out);
    q.ln1_g = as_global(q.ln1_g); q.ln1_b = as_global(q.ln1_b); q.w_router = as_global(q.w_router); q.w_eg = as_global(q.w_eg); q.w_eu = as_global(q.w_eu); q.w_ed = as_global(q.w_ed);
    q.ln2_g = as_global(q.ln2_g); q.ln2_b = as_global(q.ln2_b); q.out = as_global(q.out); q.ws = as_global(q.ws);
    return q;
}
__device__ __forceinline__ Params load_params() {
    const Params* kp = (const Params*)__builtin_amdgcn_kernarg_segment_ptr(); asm volatile("" : "+s"(kp));
    Params q = *kp;
    q.x = as_global(q.x); q.c = as_global(q.c); q.ctx = as_global(q.ctx); q.c_ctx = as_global(q.c_ctx); q.w_ada = as_global(q.w_ada); q.b_ada = as_global(q.b_ada); q.w_in = as_global(q.w_in);
    q.b_gate = as_global(q.b_gate); q.conv_qk = as_global(q.conv_qk); q.na_bias = as_global(q.na_bias); q.ml_norm_g = as_global(q.ml_norm_g); q.w_out = as_global(q.w_out);
    q.ln1_g = as_global(q.ln1_g); q.ln1_b = as_global(q.ln1_b); q.w_router = as_global(q.w_router); q.w_eg = as_global(q.w_eg); q.w_eu = as_global(q.w_eu); q.w_ed = as_global(q.w_ed);
    q.ln2_g = as_global(q.ln2_g); q.ln2_b = as_global(q.ln2_b); q.out = as_global(q.out); q.ws = as_global(q.ws);
    return q;
}
__device__ __forceinline__ float bf2f(bf16_t v) { return __uint_as_float((unsigned)v << 16); }
__device__ __forceinline__ unsigned f2bf(float f) { unsigned u = __float_as_uint(f); return (u + 0x7fffu + ((u >> 16) & 1u)) >> 16; }
__device__ __forceinline__ unsigned pk2(float lo, float hi) { return f2bf(lo) | (f2bf(hi) << 16); }
__device__ __forceinline__ float bflo(unsigned w) { return __uint_as_float(w << 16); }
__device__ __forceinline__ float bfhi(unsigned w) { return __uint_as_float(w & 0xffff0000u); }
typedef _Float16 f16x2 __attribute__((ext_vector_type(2)));
typedef float f32x2_ __attribute__((ext_vector_type(2)));
__device__ __forceinline__ unsigned pk_f16(float lo, float hi) {
    const f32x2_ v = {__builtin_amdgcn_fmed3f(lo, -65504.f, 65504.f), __builtin_amdgcn_fmed3f(hi, -65504.f, 65504.f)};
    const f16x2 h = __builtin_convertvector(v, f16x2); return __builtin_bit_cast(unsigned, h); }
__device__ __forceinline__ float hlo(unsigned w) { const f16x2 h = __builtin_bit_cast(f16x2, w); return (float)h.x; }
__device__ __forceinline__ float hhi(unsigned w) { const f16x2 h = __builtin_bit_cast(f16x2, w); return (float)h.y; }
template <int CTRL> __device__ __forceinline__ float dpp_mov(float v) { return __int_as_float(__builtin_amdgcn_update_dpp(0, __float_as_int(v), CTRL, 0xF, 0xF, true)); }
__device__ __forceinline__ float lane_bcast(float v, int l) { return __int_as_float(__builtin_amdgcn_readlane(__float_as_int(v), l)); }
__device__ __forceinline__ float wave_sum(float v) {
    v += dpp_mov<0xB1>(v);
    v += dpp_mov<0x4E>(v);
    v += dpp_mov<0x141>(v);
    v += dpp_mov<0x140>(v);
    return (lane_bcast(v, 0) + lane_bcast(v, 16)) + (lane_bcast(v, 32) + lane_bcast(v, 48));
}
__device__ __forceinline__ float wave_max(float v) {
    v = fmaxf(v, dpp_mov<0xB1>(v)); v = fmaxf(v, dpp_mov<0x4E>(v)); v = fmaxf(v, dpp_mov<0x141>(v)); v = fmaxf(v, dpp_mov<0x140>(v));
    return fmaxf(fmaxf(lane_bcast(v, 0), lane_bcast(v, 16)), fmaxf(lane_bcast(v, 32), lane_bcast(v, 48)));
}

__device__ __forceinline__ float wscan_add(float v, int lane) {
#pragma unroll
    for (int o = 1; o < 64; o <<= 1) { const float t = __shfl_up(v, o); if (lane >= o) v += t; }
    return v;
}
__device__ __forceinline__ float wscan_max(float v, int lane) {
#pragma unroll
    for (int o = 1; o < 64; o <<= 1) { const float t = __shfl_up(v, o); if (lane >= o) v = fmaxf(v, t); }
    return v;
}
typedef short bf16x8_t __attribute__((ext_vector_type(8)));
typedef short bf16x4_t __attribute__((ext_vector_type(4)));
typedef float f32x2_t __attribute__((ext_vector_type(2)));
typedef __bf16 bf16x2_t __attribute__((ext_vector_type(2)));
__device__ __forceinline__ unsigned cvtpk(float lo, float hi) { const f32x2_t v = {lo, hi}; const bf16x2_t b = __builtin_convertvector(v, bf16x2_t); return __builtin_bit_cast(unsigned, b); }
__device__ __forceinline__ float siluf(float v) { return v * __builtin_amdgcn_rcpf(1.f + __expf(-v)); }
__device__ __forceinline__ float sigmoidf_(float v) { return __builtin_amdgcn_rcpf(1.f + __expf(-v)); }
__device__ __forceinline__ float logsigf(float v) { return fminf(v, 0.f) - log1pf(__expf(-fabsf(v))); }
__device__ __forceinline__ int ltid() { int t = threadIdx.x; asm volatile("" : "+v"(t)); return t; }
#define FP8EMU 0
__device__ __forceinline__ float q8(float x) { const int p = __builtin_amdgcn_cvt_pk_fp8_f32(x, x, 0, false); return __builtin_amdgcn_cvt_f32_fp8(p, 0); }
__device__ __forceinline__ unsigned pk4_fp8(float a, float b, float c, float d) { int w = __builtin_amdgcn_cvt_pk_fp8_f32(a, b, 0, false); w = __builtin_amdgcn_cvt_pk_fp8_f32(c, d, w, true); return (unsigned)w; }
#define LDS_FENCE() asm volatile("s_waitcnt lgkmcnt(0)" ::: "memory")

__device__ __forceinline__ void ph_ada_item(const Params& p, unsigned char* lds, int item) {
    float* sc = (float*)lds;
    float* red = sc + 9 * 1024;
    const int tid = ltid();
    float* MOD = (float*)(p.ws + WS_MOD);
    for (int i = tid; i < 9 * 1024; i += NTHR) { const int r = i >> 10, k = i & 1023; const float v = r < 8 ? p.c[r * 1024 + k] : p.c_ctx[k]; sc[i] = v / (1.f + expf(-v)); }
    __syncthreads();
    const int col = item * 64 + (tid & 63), ks = tid >> 6;
    float acc[9];
#pragma unroll
    for (int r = 0; r < 9; ++r) acc[r] = 0.f;
    { const GAS float* wa = (const GAS float*)p.w_ada + col;
      for (int k = ks * 128; k < ks * 128 + 128; k += 16) {
          float w[16];
#pragma unroll
          for (int u = 0; u < 16; ++u) w[u] = wa[(size_t)(k + u) * 6144];
#pragma unroll
          for (int u = 0; u < 16; ++u)
#pragma unroll
              for (int r = 0; r < 9; ++r) acc[r] += sc[r * 1024 + k + u] * w[u];
      } }
#pragma unroll
    for (int r = 0; r < 9; ++r) red[(ks * 64 + (tid & 63)) * 9 + r] = acc[r];
    __syncthreads();
    if (tid < 64) {
#pragma unroll
        for (int r = 0; r < 9; ++r) { float s = p.b_ada[col]; for (int k2 = 0; k2 < 8; ++k2) s += red[(k2 * 64 + tid) * 9 + r]; MOD[r * 6144 + col] = s; }
    }
    __syncthreads();
}
__device__ __forceinline__ void transpose_item(const float* W, int N, int k0, int n0, int nvalid, bf16_t* WT, size_t orow0, int ldt, float* scr, int lane) {
#pragma unroll 8
    for (int i = 0; i < 32; ++i) { const int kk = 2 * i + (lane >> 5), nn = lane & 31; scr[kk * 33 + nn] = nn < nvalid ? W[(size_t)(k0 + kk) * N + n0 + nn] : 0.f; }
    LDS_FENCE();
    const int c = lane & 7;
#pragma unroll
    for (int j = 0; j < 4; ++j) {
        const int n = (lane >> 3) + 8 * j; const float* s = scr + (8 * c) * 33 + n;
        u32x4 o; o.x = pk2(s[0 * 33], s[1 * 33]); o.y = pk2(s[2 * 33], s[3 * 33]); o.z = pk2(s[4 * 33], s[5 * 33]); o.w = pk2(s[6 * 33], s[7 * 33]);
        *(u32x4*)(WT + (orow0 + n) * ldt + k0 + 8 * c) = o;
    }
    LDS_FENCE();
}
__device__ __forceinline__ void ph0(const Params& p, unsigned char* lds, int bid, int nblk) {
    __syncthreads();
    for (int it = bid; it < 96; it += nblk) ph_ada_item(p, lds, it);
    const int tid = ltid(), lane = tid & 63, wave = tid >> 6;
    float* scr = (float*)lds + wave * (64 * 33);
    bf16_t* WINT = (bf16_t*)(p.ws + WS_WINT); bf16_t* WOUTT = (bf16_t*)(p.ws + WS_WOUTT);
    const int gw = bid * NWAVES + wave, ngw = nblk * NWAVES;
    constexpr int I_IN = 16 * 97, I_OUT = 16 * 32;
    for (int it = gw; it < I_IN + I_OUT; it += ngw) {
        if (it < I_IN) { const int kb = it / 97, nb = it % 97; const int n0 = nb * 32; const int nv = (DIN - n0) < 32 ? (DIN - n0) : 32; transpose_item(p.w_in, DIN, kb * 64, n0, nv, WINT, (size_t)n0, 1024, scr, lane); }
        else { const int r = it - I_IN; const int kb = r / 32, nb = r % 32; transpose_item(p.w_out, 1024, kb * 64, nb * 32, 32, WOUTT, (size_t)nb * 32, 1024, scr, lane); }
    }
    { float* ROPE = (float*)(p.ws + WS_ROPE); for (int idx = bid * NTHR + tid; idx < 2048; idx += nblk * NTHR) { const int pos = idx >> 4, i = idx & 15;
        const float inv = exp2f(-(float)i * (13.287712379549449f / 16.f)); float sn, cs_; sincosf((float)pos * inv, &sn, &cs_); ROPE[idx * 2] = cs_; ROPE[idx * 2 + 1] = sn; } }
    { const size_t n16 = (size_t)(DINP - 3104) * 1024 * 2 / 16; u32x4* z = (u32x4*)(WINT + (size_t)3104 * 1024);
      for (size_t i = (size_t)bid * NTHR + tid; i < n16; i += (size_t)nblk * NTHR) z[i] = (u32x4){0u, 0u, 0u, 0u}; }
}

__device__ __forceinline__ void ph1(const Params& p, int bid, int nblk) {
    const int tid = ltid(), lane = tid & 63, wave = tid >> 6;
    const GAS float* MOD = (const GAS float*)(p.ws + WS_MOD); GAS bf16_t* XM = (GAS bf16_t*)(p.ws + WS_XM);
    const GAS float* xs = (const GAS float*)p.x; const GAS float* cs = (const GAS float*)p.ctx;
    const int nw = nblk * NWAVES, gw = bid * NWAVES + wave, per = (MROWS + nw - 1) / nw, m_beg = gw * per, m_end = min(m_beg + per, MROWS);
    { const GAS bf16_t* WT = (const GAS bf16_t*)(p.ws + WS_WOUTT); GAS bf16_t* WG = (GAS bf16_t*)(p.ws + WS_WOUTG);
      for (int i = bid * NTHR + tid; i < NB * 1024 * 128; i += nblk * NTHR) { const int b = i >> 17, n = (i >> 7) & 1023, k8 = (i & 127) * 8;
          const float g = MOD[b * 6144 + 2048 + n]; const u32x4 w = *(const GAS u32x4*)(WT + (size_t)n * 1024 + k8); u32x4 o;
          o.x = pk2(g * bflo(w.x), g * bfhi(w.x)); o.y = pk2(g * bflo(w.y), g * bfhi(w.y)); o.z = pk2(g * bflo(w.z), g * bfhi(w.z)); o.w = pk2(g * bflo(w.w), g * bfhi(w.w));
          *(GAS u32x4*)(WG + ((size_t)b * 1024 + n) * 1024 + k8) = o; } }
    int rcur = -1; f32x4 sa[4], sb[4];
    for (int m0 = m_beg; m0 < m_end; m0 += 4) {
        f32x4 v[4][4]; int rr_[4];
#pragma unroll
        for (int i = 0; i < 4; ++i) { const int m = min(m0 + i, m_end - 1); rr_[i] = m < NLAT ? (m >> 13) : 8;
            const GAS float* src = m < NLAT ? xs + (size_t)m * 1024 : cs + (size_t)(m - NLAT) * 1024;
#pragma unroll
            for (int j = 0; j < 4; ++j) v[i][j] = __builtin_nontemporal_load((const GAS f32x4*)(src + j * 256 + lane * 4)); }
#pragma unroll
        for (int i = 0; i < 4; ++i) { if (m0 + i < m_end) {
            if (rr_[i] != rcur) { rcur = rr_[i];
#pragma unroll
                for (int j = 0; j < 4; ++j) { sb[j] = *(const GAS f32x4*)(MOD + rcur * 6144 + j * 256 + lane * 4); sa[j] = *(const GAS f32x4*)(MOD + rcur * 6144 + 1024 + j * 256 + lane * 4) + 1.f; } }
#pragma unroll
            for (int j = 0; j < 4; ++j) { const f32x4 r = v[i][j] * sa[j] + sb[j]; u32x2 o; o.x = pk2(r.x, r.y); o.y = pk2(r.z, r.w);
                *(GAS u32x2*)(XM + (size_t)(m0 + i) * 1024 + j * 256 + lane * 4) = o; } } }
    }
}


#define LAS __attribute__((address_space(3)))
typedef short bf16x8 __attribute__((ext_vector_type(8)));
typedef int i32x8 __attribute__((ext_vector_type(8)));
constexpr float NA_C2 = 0.125f * 1.4426950408889634f;
namespace pg8 {
constexpr int BM = 256, BK = 64, HALF = 128, HTB = HALF * BK * 2, STAGE_BYTES = 8 * HTB, NXCD = 8, WGM = 8;
constexpr int TAB_OFF = STAGE_BYTES;
__device__ __forceinline__ int lds_byte(int r, int c) { const int st = (r >> 4) * 2 + (c >> 5), rr = r & 15, cc = c & 31, ob = rr * 64 + cc * 2; return st * 1024 + (ob ^ (((ob >> 9) & 1) << 5)); }
__device__ __forceinline__ void stage_rc(int b, int& R, int& C) { const int st = b / 1024, sb = b % 1024, swz = sb ^ (((sb >> 9) & 1) << 5); R = (st >> 1) * 16 + swz / 64; C = (st & 1) * 32 + (swz % 64) / 2; }
__device__ __forceinline__ int perm32(int rho) { const int n = rho >> 4, i = rho & 15; return 8 * (i >> 2) + 4 * n + (i & 3); }
struct Unit { int pm, pn; };
struct StaticOrder {
    int nM, nN, nwg, G, c;
    __device__ void init(int nM_, int nN_, int G_, int c_) { nM = nM_; nN = nN_; nwg = nM * nN; G = G_; c = c_; }
    __device__ bool next(int i, Unit& u) const {
        const long L = (long)i * G + c; if (L >= nwg) return false;
        int wgid = (int)L; { const int q = nwg / NXCD, r = nwg % NXCD, xcd = wgid % NXCD, off = wgid / NXCD; wgid = (xcd < r ? xcd * (q + 1) : r * (q + 1) + (xcd - r) * q) + off; }
        const int nig = WGM * nN, gid = wgid / nig, fm = gid * WGM, gsz = (nM - fm) < WGM ? (nM - fm) : WGM;
        u.pm = fm + ((wgid % nig) % gsz); u.pn = (wgid % nig) / gsz; return true;
    }
};
__device__ __forceinline__ unsigned cvt_pk_bf16(float lo, float hi) { return cvtpk(lo, hi); }
struct GemmDesc { const void* A; const void* Bt; const int* IDX; void* O; const float* x; const float* MOD; size_t bEstride  ; int Kb  , egrp0, nM, nN, epi, ldc, qtiles  ; };

__device__ __forceinline__ void epilogue(const GemmDesc& g, const f32x4 (&acc)[2][2][4][2], const Unit& u, int wr, int wc, int fr, int fq) {
    if (g.epi == 0 || g.epi == 3) {
        const float sc = g.epi == 3 ? (1.f / 64.f) : (u.pn < g.qtiles ? NA_C2 : 1.f);
        GAS bf16_t* O = (GAS bf16_t*)g.O; const int row0 = u.pm * BM + wr * 64 + fr, col0 = u.pn * BM + wc * 32 + 8 * fq;
#pragma unroll
        for (int ai = 0; ai < 2; ++ai)
#pragma unroll
            for (int m = 0; m < 4; ++m) { GAS bf16_t* rowp = O + (size_t)(row0 + ai * HALF + m * 16) * g.ldc + col0;
#pragma unroll
                for (int bj = 0; bj < 2; ++bj) { const f32x4 v0 = acc[ai][bj][m][0] * sc, v1 = acc[ai][bj][m][1] * sc;
                    u32x4 w; w.x = cvt_pk_bf16(v0[0], v0[1]); w.y = cvt_pk_bf16(v0[2], v0[3]); w.z = cvt_pk_bf16(v1[0], v1[1]); w.w = cvt_pk_bf16(v1[2], v1[3]);
                    *(GAS u32x4*)(rowp + bj * HALF) = w; } }
    } else if (g.epi == 1) {
        GAS unsigned char* O = (GAS unsigned char*)g.O; const int row0 = u.pm * BM + wr * 64 + fr, col0 = u.pn * HALF + wc * 32 + 8 * fq;
#pragma unroll
        for (int ai = 0; ai < 2; ++ai)
#pragma unroll
            for (int m = 0; m < 4; ++m) { GAS unsigned char* rowp = O + (size_t)(row0 + ai * HALF + m * 16) * DFF + col0;
                float r[8];
#pragma unroll
                for (int n = 0; n < 2; ++n)
#pragma unroll
                    for (int jp = 0; jp < 2; ++jp) { const f32x2_ gg = {acc[ai][0][m][n][2 * jp], acc[ai][0][m][n][2 * jp + 1]}, uu = {acc[ai][1][m][n][2 * jp], acc[ai][1][m][n][2 * jp + 1]};
                        const f32x2_ a = gg * (-(1.f / 32.f) * 1.4426950408889634f); f32x2_ e = {__builtin_amdgcn_exp2f(a.x), __builtin_amdgcn_exp2f(a.y)};
                        e = e * 1024.f + 1024.f; const f32x2_ rc = {__builtin_amdgcn_rcpf(e.x), __builtin_amdgcn_rcpf(e.y)}; const f32x2_ rr = (gg * uu) * rc;
                        r[n * 4 + 2 * jp] = rr.x; r[n * 4 + 2 * jp + 1] = rr.y; }
                u32x2 w; w.x = pk4_fp8(r[0], r[1], r[2], r[3]); w.y = pk4_fp8(r[4], r[5], r[6], r[7]);
                *(GAS u32x2*)rowp = w; }
    } else {
        GAS bf16_t* Yo = (GAS bf16_t*)g.O; const int row0 = u.pm * BM + wr * 64 + fr, col0 = u.pn * BM + wc * 32 + 8 * fq;
#pragma unroll
        for (int ai = 0; ai < 2; ++ai)
#pragma unroll
            for (int m = 0; m < 4; ++m) { GAS bf16_t* rowp = Yo + (size_t)(row0 + ai * HALF + m * 16) * 1024 + col0;
#pragma unroll
                for (int bj = 0; bj < 2; ++bj) { const f32x4 y0 = acc[ai][bj][m][0], y1 = acc[ai][bj][m][1];
                    u32x4 w; w.x = pk_f16(y0[0], y0[1]); w.y = pk_f16(y0[2], y0[3]); w.z = pk_f16(y1[0], y1[1]); w.w = pk_f16(y1[2], y1[3]);
                    *(GAS u32x4*)(rowp + bj * HALF) = w; } }
    }
}

template <bool MAYGATHER, bool FP8>
__device__ __forceinline__ void gemm_phase(LAS unsigned char* lds, const GemmDesc g, int G, int c) {
    const int tid = ltid(), wid = __builtin_amdgcn_readfirstlane(tid >> 6), lane = tid & 63, wr = wid >> 2, wc = wid & 3, fr = lane & 15, fq = lane >> 4;
    const int Kb = g.Kb, nt = Kb / (BK * 2);
    const bool perm = true, gather = MAYGATHER && g.IDX != nullptr;
    StaticOrder S; S.init(g.nM, g.nN, G, c);
    unsigned voffB[2];
#pragma unroll
    for (int i = 0; i < 2; ++i) { int R, C; stage_rc(tid * 16 + i * 8192, R, C); const int Rb = perm ? ((R & ~31) + perm32(R & 31)) : R; voffB[i] = (unsigned)(Rb * Kb + C * 2); }
    const size_t kstep = (size_t)(BK * 2), hstep = (size_t)HALF * Kb, tstep = 2 * hstep;
    const unsigned ldsw = (unsigned)wid * 1024u;
    const int aoff = lds_byte(wr * 64 + fr, fq * 8), boff = lds_byte(wc * 32 + fr, fq * 8);
    LAS int* tab = (LAS int*)(lds + TAB_OFF);
#define PG8_SA(b, h) (((b) * 2 + (h)) * HTB)
#define PG8_SB(b, h) ((4 + (b) * 2 + (h)) * HTB)
#define PG8_UNI(p_) ({ const unsigned long long _v = (unsigned long long)(p_); (const GAS char*)(((unsigned long long)(unsigned)__builtin_amdgcn_readfirstlane((int)(_v >> 32)) << 32) | (unsigned)__builtin_amdgcn_readfirstlane((int)_v)); })
#define PG8_GLDS(gptr, ldsoff) __builtin_amdgcn_global_load_lds((const GAS unsigned*)(gptr), (LAS unsigned*)(lds + (ldsoff)), 16, 0, 0)
#define PG8_STAGE_B(bufoff, gbase) do { const GAS char* _gb = (const GAS char*)(gbase); _Pragma("unroll") for (int _i = 0; _i < 2; ++_i) { asm volatile("" : "+v"(voffB[_i])); PG8_GLDS(_gb + voffB[_i], (bufoff) + ldsw + _i * 8192); } } while (0)
#define PG8_STAGE_A(bufoff, kt, v0_, v1_) do { const GAS char* _b = (const GAS char*)g.A + (size_t)(kt) * kstep; asm volatile("" : "+v"(v0_), "+v"(v1_)); PG8_GLDS(_b + (v0_), (bufoff) + ldsw); PG8_GLDS(_b + (v1_), (bufoff) + ldsw + 8192); } while (0)
#define PG8_LDA(dst, b, h) do { _Pragma("unroll") for (int m = 0; m < 4; ++m) _Pragma("unroll") for (int k = 0; k < 2; ++k) dst[m][k] = *(const LAS bf16x8*)(lds + PG8_SA(b, h) + aoff + m * 2048 + k * 1024); } while (0)
#define PG8_LDB(dst, b, h) do { _Pragma("unroll") for (int n = 0; n < 2; ++n) _Pragma("unroll") for (int k = 0; k < 2; ++k) dst[n][k] = *(const LAS bf16x8*)(lds + PG8_SB(b, h) + boff + n * 2048 + k * 1024); } while (0)
#define PG8_MMA(ai, bj, At, Bt) do { __builtin_amdgcn_s_setprio(1); \
        if constexpr (FP8) { _Pragma("unroll") for (int m = 0; m < 4; ++m) _Pragma("unroll") for (int n = 0; n < 2; ++n) { \
            const bf16x8 _b0 = Bt[n][0], _b1 = Bt[n][1], _a0 = At[m][0], _a1 = At[m][1]; \
            const i32x8 _bw = __builtin_bit_cast(i32x8, __builtin_shufflevector(_b0, _b1, 0, 1, 2, 3, 4, 5, 6, 7, 8, 9, 10, 11, 12, 13, 14, 15)); \
            const i32x8 _aw = __builtin_bit_cast(i32x8, __builtin_shufflevector(_a0, _a1, 0, 1, 2, 3, 4, 5, 6, 7, 8, 9, 10, 11, 12, 13, 14, 15)); \
            acc[ai][bj][m][n] = __builtin_amdgcn_mfma_scale_f32_16x16x128_f8f6f4(_bw, _aw, acc[ai][bj][m][n], 0, 0, 0, 0x7f7f7f7f, 0, 0x7f7f7f7f); } } \
        else { _Pragma("unroll") for (int m = 0; m < 4; ++m) _Pragma("unroll") for (int n = 0; n < 2; ++n) _Pragma("unroll") for (int k = 0; k < 2; ++k) \
            acc[ai][bj][m][n] = __builtin_amdgcn_mfma_f32_16x16x32_bf16(Bt[n][k], At[m][k], acc[ai][bj][m][n], 0, 0, 0); } \
        __builtin_amdgcn_s_setprio(0); } while (0)
#define PG8_WAIT_V(n) asm volatile("s_waitcnt vmcnt(" #n ")" ::: "memory")
#define PG8_WAIT_L(n) asm volatile("s_waitcnt lgkmcnt(" #n ")" ::: "memory")
#define PG8_BAR __builtin_amdgcn_s_barrier()
#define PG8_SCHED __builtin_amdgcn_sched_barrier(0)
#define PG8_TAB_FILL(u, s) do { if (wid < 4) { const int _e = g.egrp0 + ((u).pm >> 5), _m0 = ((u).pm & 31) * 256, _b = _m0 >> 10, _s0 = _m0 & 1023; \
        __builtin_amdgcn_global_load_lds((const unsigned*)(g.IDX + (_e * 8 + _b) * CAP + _s0 + wid * 64 + lane), (LAS unsigned*)(lds + TAB_OFF + (s) * 1024 + wid * 256), 4, 0, 0); } } while (0)
#define PG8_ROWS(u, s, v) do { int _t = tid; asm volatile("" : "+v"(_t)); _Pragma("unroll") for (int _i = 0; _i < 2; ++_i) { int _R, _C; stage_rc(_t * 16 + _i * 8192, _R, _C); \
        _Pragma("unroll") for (int _h = 0; _h < 2; ++_h) { \
            if (gather) { const int _b = (((u).pm & 31) * 256) >> 10; const int _ix = tab[(s) * 256 + _h * 128 + _R]; v[_h][_i] = (unsigned)((_b * 8192 + _ix) * Kb + _C * 2); } \
            else v[_h][_i] = (unsigned)(((u).pm * 256 + _h * 128 + _R) * Kb + _C * 2); } } } while (0)
    Unit cur, nxt; int ui = 0;
    if (!S.next(0, cur)) return;
    cur.pm = __builtin_amdgcn_readfirstlane(cur.pm); cur.pn = __builtin_amdgcn_readfirstlane(cur.pn);
    f32x4 acc[2][2][4][2];
#define PG8_ACC_INIT(u) do { if (g.epi == 2) { const GAS float* _x = (const GAS float*)g.x + (size_t)((u).pm * BM + wr * 64 + fr) * 1024 + (u).pn * BM + wc * 32 + 8 * fq; \
        _Pragma("unroll") for (int a = 0; a < 2; ++a) _Pragma("unroll") for (int m = 0; m < 4; ++m) _Pragma("unroll") for (int b = 0; b < 2; ++b) _Pragma("unroll") for (int n = 0; n < 2; ++n) \
            acc[a][b][m][n] = *(const GAS f32x4*)(_x + (size_t)(a * HALF + m * 16) * 1024 + b * HALF + n * 4); \
        _Pragma("unroll") for (int a = 0; a < 2; ++a) _Pragma("unroll") for (int m = 0; m < 4; ++m) _Pragma("unroll") for (int b = 0; b < 2; ++b) _Pragma("unroll") for (int n = 0; n < 2; ++n) \
            acc[a][b][m][n] = acc[a][b][m][n] * ALPHA; } \
      else { float z = 0.f; asm volatile("" : "+v"(z));                   \
        _Pragma("unroll") for (int a = 0; a < 2; ++a) _Pragma("unroll") for (int b = 0; b < 2; ++b) _Pragma("unroll") for (int m = 0; m < 4; ++m) _Pragma("unroll") for (int n = 0; n < 2; ++n) \
            acc[a][b][m][n] = (f32x4){z, z, z, z}; } } while (0)
    PG8_ACC_INIT(cur);
    bf16x8 At[4][2], B0[2][2], B1[2][2];
    unsigned vc[2][2];
    const char* cB = (const char*)g.Bt + (size_t)(g.egrp0 + (cur.pm >> 5)) * g.bEstride + (size_t)cur.pn * tstep;
    const char* nB = cB;
    if (gather) { PG8_TAB_FILL(cur, 0); PG8_WAIT_V(0); PG8_BAR; }
    PG8_ROWS(cur, 0, vc);
    PG8_STAGE_B(PG8_SB(0, 0), cB); PG8_STAGE_B(PG8_SB(0, 1), cB + hstep); PG8_STAGE_A(PG8_SA(0, 0), 0, vc[0][0], vc[0][1]); PG8_STAGE_A(PG8_SA(0, 1), 0, vc[1][0], vc[1][1]);
    if (wr == 1) PG8_BAR;
    PG8_WAIT_V(2); PG8_BAR;
    PG8_STAGE_B(PG8_SB(1, 0), cB + kstep); PG8_STAGE_A(PG8_SA(1, 0), 1, vc[0][0], vc[0][1]); PG8_STAGE_B(PG8_SB(1, 1), cB + hstep + kstep);
    PG8_WAIT_V(6); PG8_BAR;
    for (;;) {
        const bool has_next = S.next(ui + 1, nxt);
        nxt.pm = __builtin_amdgcn_readfirstlane(nxt.pm); nxt.pn = __builtin_amdgcn_readfirstlane(nxt.pn);
        if (has_next) nB = (const char*)g.Bt + (size_t)(g.egrp0 + (nxt.pm >> 5)) * g.bEstride + (size_t)nxt.pn * tstep; else nB = cB;
        if (gather && has_next) PG8_TAB_FILL(nxt, (ui + 1) & 1);
        for (int t = 0; t < nt; t += 2) {
            const bool last = (t == nt - 2);
            const int k2 = last ? 0 : t + 2, k3 = k2 + 1;
            const char* b2 = last ? nB : cB + (size_t)(t + 2) * kstep; const char* b3 = b2 + kstep;
            PG8_LDB(B0, 0, 0); PG8_LDB(B1, 0, 1); PG8_SCHED; PG8_LDA(At, 0, 0); PG8_STAGE_A(PG8_SA(1, 1), t + 1, vc[1][0], vc[1][1]);
            if (last && has_next) PG8_ROWS(nxt, (ui + 1) & 1, vc);
            PG8_WAIT_V(8); PG8_WAIT_L(0); PG8_BAR; PG8_MMA(0, 0, At, B0); PG8_MMA(0, 1, At, B1); PG8_BAR; PG8_SCHED;
            PG8_LDA(At, 0, 1); PG8_STAGE_B(PG8_SB(0, 0), b2); PG8_STAGE_B(PG8_SB(0, 1), b2 + hstep); PG8_STAGE_A(PG8_SA(0, 0), k2, vc[0][0], vc[0][1]);
            PG8_WAIT_V(8); PG8_WAIT_L(0); PG8_BAR; PG8_MMA(1, 0, At, B0); PG8_MMA(1, 1, At, B1); PG8_BAR; PG8_SCHED;
            PG8_LDB(B0, 1, 0); PG8_LDB(B1, 1, 1); PG8_SCHED; PG8_LDA(At, 1, 0); PG8_STAGE_A(PG8_SA(0, 1), k2, vc[1][0], vc[1][1]);
            PG8_WAIT_V(8); PG8_WAIT_L(0); PG8_BAR; PG8_MMA(0, 0, At, B0); PG8_MMA(0, 1, At, B1); PG8_BAR; PG8_SCHED;
            PG8_LDA(At, 1, 1); PG8_STAGE_B(PG8_SB(1, 0), b3); PG8_STAGE_B(PG8_SB(1, 1), b3 + hstep); PG8_STAGE_A(PG8_SA(1, 0), k3, vc[0][0], vc[0][1]);
            PG8_WAIT_V(8); PG8_WAIT_L(0); PG8_BAR; PG8_MMA(1, 0, At, B0); PG8_MMA(1, 1, At, B1); PG8_BAR; PG8_SCHED;
        }
        if (wr == 0) PG8_BAR;
        epilogue(g, acc, cur, wr, wc, fr, fq);
        if (!has_next) break;
        cur = nxt; cB = nB; ++ui;
        PG8_ACC_INIT(cur);
        if (wr == 1) PG8_BAR;
    }
    PG8_WAIT_V(0);
    PG8_BAR;
#undef PG8_SA
#undef PG8_SB
#undef PG8_GLDS
#undef PG8_STAGE_A
#undef PG8_STAGE_B
#undef PG8_LDA
#undef PG8_LDB
#undef PG8_MMA
#undef PG8_WAIT_V
#undef PG8_WAIT_L
#undef PG8_BAR
#undef PG8_ACC_INIT
#undef PG8_SCHED
#undef PG8_TAB_FILL
#undef PG8_ROWS
}
}


constexpr int NA_SLOTS = 9, NA_SLOT_EL = 64 * 72;
__device__ __forceinline__ int vtl_off(int d, int key) { return d * 72 + key; }
__device__ __forceinline__ int vtc_off(int d, int key) { return d * 264 + key; }
__device__ __forceinline__ void na_item(const Params& p, unsigned char* lds, int item) {
    const GAS bf16_t* U = (const GAS bf16_t*)(p.ws + WS_U); GAS bf16_t* MIX = (GAS bf16_t*)(p.ws + WS_MIX);
    const int tid = ltid(), lane = tid & 63, wave = __builtin_amdgcn_readfirstlane(tid >> 6), fr = lane & 15, fq = lane >> 4;
    const int seg = item & 3, bh = item >> 2, h = bh & 7, b = bh >> 3;
    bf16_t* VTL = (bf16_t*)lds;
    bf16_t* VTC = VTL + NA_SLOTS * NA_SLOT_EL;
    bf16_t* KC = VTC + 64 * 264;
    float* BIAS = (float*)(KC + 256 * 72);
    const size_t lat0 = (size_t)b * 8192, ctx0 = (size_t)NLAT + b * 256;
    const GAS bf16_t* Uv = U + C_VA + h * 64 + wave * 8;
#pragma unroll
    for (int i = 0; i < 2; ++i) { const int kp = lane + 64 * i;
        const u32x4 w0 = *(const GAS u32x4*)(Uv + (ctx0 + 2 * kp) * DINP), w1 = *(const GAS u32x4*)(Uv + (ctx0 + 2 * kp + 1) * DINP);
        const unsigned ws_[8] = {(w0.x & 0xffffu) | (w1.x << 16), (w0.x >> 16) | (w1.x & 0xffff0000u), (w0.y & 0xffffu) | (w1.y << 16), (w0.y >> 16) | (w1.y & 0xffff0000u),
                                 (w0.z & 0xffffu) | (w1.z << 16), (w0.z >> 16) | (w1.z & 0xffff0000u), (w0.w & 0xffffu) | (w1.w << 16), (w0.w >> 16) | (w1.w & 0xffff0000u)};
#pragma unroll
        for (int e = 0; e < 8; ++e) *(unsigned*)(VTC + vtc_off(wave * 8 + e, 2 * kp)) = ws_[e]; }
    for (int idx = tid; idx < 256 * 8; idx += NTHR) { const int key = idx >> 3, ck = idx & 7;
        *(u32x4*)(KC + key * 72 + ck * 8) = *(const GAS u32x4*)(U + (ctx0 + key) * DINP + C_KA + h * 64 + ck * 8); }
    if (tid < 512) BIAS[tid] = tid < 465 ? p.na_bias[h * 465 + tid] * 1.4426950408889634f : 0.f;
    const int cg = wave & 3, rr = wave >> 2, c0 = 16 * cg, kb = cg == 0 ? 0 : (cg == 1 ? 8 : (cg == 2 ? 24 : 32));
    const int c = c0 + fr, cs = min(max(c - 8, 0), 48);
    const int r00 = 32 * seg;
#define NA_VFILL(kra_, w0_, w1_) do { const unsigned ws_[8] = {(w0_.x & 0xffffu) | (w1_.x << 16), (w0_.x >> 16) | (w1_.x & 0xffff0000u), (w0_.y & 0xffffu) | (w1_.y << 16), (w0_.y >> 16) | (w1_.y & 0xffff0000u), \
            (w0_.z & 0xffffu) | (w1_.z << 16), (w0_.z >> 16) | (w1_.z & 0xffff0000u), (w0_.w & 0xffffu) | (w1_.w << 16), (w0_.w >> 16) | (w1_.w & 0xffff0000u)}; \
        bf16_t* sl_ = VTL + ((kra_) % NA_SLOTS) * NA_SLOT_EL; _Pragma("unroll") for (int e_ = 0; e_ < 8; ++e_) *(unsigned*)(sl_ + vtl_off(wave * 8 + e_, 2 * (lane & 31))) = ws_[e_]; } while (0)
    { const int lo = min(max(r00 - 4, 0), 120), hi = min(max(r00 + 1 - 4, 0), 120) + 7;
      for (int kra = lo + (lane >> 5); kra <= hi; kra += 2) { const size_t k0 = lat0 + kra * 64 + 2 * (lane & 31);
          const u32x4 w0 = *(const GAS u32x4*)(Uv + k0 * DINP), w1 = *(const GAS u32x4*)(Uv + (k0 + 1) * DINP);
          NA_VFILL(kra, w0, w1); } }
#define NA_LOADK(kf_, ch, rw_) do { const int rs_ = min(max((rw_) - 4, 0), 120); unsigned koff_ = koff; asm volatile("" : "+v"(koff_));     \
        _Pragma("unroll") for (int t_ = 0; t_ < 4; ++t_) { \
        const size_t krow_ = lat0 + (rs_ + 2 * (ch) + (t_ >> 1)) * 64 + kb + 16 * (t_ & 1); \
        const GAS char* bp_ = Ub + krow_ * (DINP * 2); \
        kf_[2 * t_] = *(const GAS bf16x8_t*)(bp_ + koff_); kf_[2 * t_ + 1] = *(const GAS bf16x8_t*)(bp_ + koff_ + 64); } } while (0)
    const GAS char* Ub = (const GAS char*)U;
    const unsigned koff = (unsigned)((fr * DINP + C_KA + h * 64 + 8 * fq) * 2);
    bf16x8_t kfa[8], kfb[8], qf[2];
    { const int rw0 = r00 + rr; const size_t qrow = lat0 + rw0 * 64 + c0 + fr;
      qf[0] = *(const GAS bf16x8_t*)(U + qrow * DINP + C_QA + h * 64 + 8 * fq); qf[1] = *(const GAS bf16x8_t*)(U + qrow * DINP + C_QA + h * 64 + 32 + 8 * fq);
      NA_LOADK(kfa, 0, rw0); NA_LOADK(kfb, 1, rw0); }
    __syncthreads();
#pragma unroll 1
    for (int step = 0; step < 16; ++step) {
        const int r = r00 + 2 * step, rw = r + rr, rsw = min(max(rw - 4, 0), 120);
        const int nhi_cur = min(max(r + 1 - 4, 0), 120) + 7, nhi_nxt = min(max(r + 3 - 4, 0), 120) + 7;
        const int vkra = nhi_cur + 1 + (lane >> 5); const bool vld = step < 15 && vkra <= nhi_nxt;
        u32x4 vw0 = (u32x4){0u, 0u, 0u, 0u}, vw1 = (u32x4){0u, 0u, 0u, 0u};
        float m_run = -INFINITY, l_run = 0.f;
        f32x4 o[4];
#pragma unroll
        for (int db = 0; db < 4; ++db) o[db] = (f32x4){0.f, 0.f, 0.f, 0.f};
#pragma unroll
        for (int ch = 0; ch < 8; ++ch) {
            f32x4 sc[4];
            if (ch < 4) {
#pragma unroll
                for (int t = 0; t < 4; ++t) { f32x4 a = (f32x4){0.f, 0.f, 0.f, 0.f};
                    if (ch & 1) { a = __builtin_amdgcn_mfma_f32_16x16x32_bf16(kfb[2 * t], qf[0], a, 0, 0, 0); a = __builtin_amdgcn_mfma_f32_16x16x32_bf16(kfb[2 * t + 1], qf[1], a, 0, 0, 0); }
                    else { a = __builtin_amdgcn_mfma_f32_16x16x32_bf16(kfa[2 * t], qf[0], a, 0, 0, 0); a = __builtin_amdgcn_mfma_f32_16x16x32_bf16(kfa[2 * t + 1], qf[1], a, 0, 0, 0); }
                    sc[t] = a; }
                __builtin_amdgcn_sched_barrier(0);
                if (ch < 2) { if (ch & 1) { NA_LOADK(kfb, ch + 2, rw); } else { NA_LOADK(kfa, ch + 2, rw); } }
                else if (step < 15) { if (ch & 1) { NA_LOADK(kfb, 1, rw + 2); } else { NA_LOADK(kfa, 0, rw + 2); } }
            } else {
#pragma unroll
                for (int t = 0; t < 4; ++t) { const bf16_t* kp = KC + (64 * (ch - 4) + 16 * t + fr) * 72 + 8 * fq;
                    const bf16x8_t k0 = *(const bf16x8_t*)kp, k1 = *(const bf16x8_t*)(kp + 32);
                    f32x4 a = (f32x4){0.f, 0.f, 0.f, 0.f};
                    a = __builtin_amdgcn_mfma_f32_16x16x32_bf16(k0, qf[0], a, 0, 0, 0); a = __builtin_amdgcn_mfma_f32_16x16x32_bf16(k1, qf[1], a, 0, 0, 0); sc[t] = a; }
                __builtin_amdgcn_sched_barrier(0);
                if (ch == 7 && step < 15) { const size_t qrow = lat0 + (rw + 2) * 64 + c0 + fr;
                    qf[0] = *(const GAS bf16x8_t*)(U + qrow * DINP + C_QA + h * 64 + 8 * fq); qf[1] = *(const GAS bf16x8_t*)(U + qrow * DINP + C_QA + h * 64 + 32 + 8 * fq); }
                if (ch == 4 && vld) { const size_t k0 = lat0 + vkra * 64 + 2 * (lane & 31); vw0 = *(const GAS u32x4*)(Uv + k0 * DINP); vw1 = *(const GAS u32x4*)(Uv + (k0 + 1) * DINP); }
            }
            u32x2 vfr[2][4][2];
#pragma unroll
            for (int t = 0; t < 2; ++t)
#pragma unroll
                for (int db = 0; db < 4; ++db) {
                    if (ch < 4) { const bf16_t* sl = VTL + ((rsw + 2 * ch + t) % NA_SLOTS) * NA_SLOT_EL;
                        vfr[t][db][0] = *(const u32x2*)(sl + vtl_off(db * 16 + fr, kb + 4 * fq)); vfr[t][db][1] = *(const u32x2*)(sl + vtl_off(db * 16 + fr, kb + 16 + 4 * fq)); }
                    else { vfr[t][db][0] = *(const u32x2*)(VTC + vtc_off(db * 16 + fr, 64 * (ch - 4) + 32 * t + 4 * fq)); vfr[t][db][1] = *(const u32x2*)(VTC + vtc_off(db * 16 + fr, 64 * (ch - 4) + 32 * t + 16 + 4 * fq)); }
                }
            float bv[4][4];
            if (ch < 4) {
#pragma unroll
                for (int t = 0; t < 4; ++t) { const int kr = 2 * ch + (t >> 1), cb = t & 1;
                    const float* brow = BIAS + (rsw + kr - rw + 7) * 31;
#pragma unroll
                    for (int j = 0; j < 4; ++j) bv[t][j] = brow[kb + 16 * cb + 4 * fq + j - c + 15]; }
                asm volatile("" : "+v"(bv[0][0]), "+v"(bv[0][1]), "+v"(bv[0][2]), "+v"(bv[0][3]), "+v"(bv[1][0]), "+v"(bv[1][1]), "+v"(bv[1][2]), "+v"(bv[1][3]),
                                  "+v"(bv[2][0]), "+v"(bv[2][1]), "+v"(bv[2][2]), "+v"(bv[2][3]), "+v"(bv[3][0]), "+v"(bv[3][1]), "+v"(bv[3][2]), "+v"(bv[3][3]));
            }
            __builtin_amdgcn_sched_barrier(0);
            if (ch < 4) {
#pragma unroll
                for (int t = 0; t < 4; ++t) { const int cb = t & 1;
#pragma unroll
                    for (int j = 0; j < 4; ++j) { const int col = kb + 16 * cb + 4 * fq + j; const bool valid = (col >= cs) && (col < cs + 16);
                        sc[t][j] = valid ? sc[t][j] + bv[t][j] : -INFINITY; } }
            }
            float cm = -INFINITY;
#pragma unroll
            for (int t = 0; t < 4; ++t) cm = fmaxf(cm, fmaxf(fmaxf(sc[t][0], sc[t][1]), fmaxf(sc[t][2], sc[t][3])));
            if (__any(cm > m_run + 11.5f)) {
                cm = fmaxf(cm, __shfl_xor(cm, 16)); cm = fmaxf(cm, __shfl_xor(cm, 32));
                const float m_new = fmaxf(m_run, cm), alpha = __builtin_amdgcn_exp2f(m_run - m_new);
                m_run = m_new; l_run *= alpha;
#pragma unroll
                for (int j = 0; j < 4; ++j) { const float aj = __shfl(alpha, 4 * fq + j);
#pragma unroll
                    for (int db = 0; db < 4; ++db) o[db][j] *= aj; }
            }
            const float m_new = m_run;
            float psum = 0.f;
            u32x4 pw[2];
#pragma unroll
            for (int t = 0; t < 2; ++t) {
                f32x4 e0, e1;
#pragma unroll
                for (int j = 0; j < 4; ++j) { e0[j] = __builtin_amdgcn_exp2f(sc[2 * t][j] - m_new); e1[j] = __builtin_amdgcn_exp2f(sc[2 * t + 1][j] - m_new); }
                psum += (e0[0] + e0[1]) + (e0[2] + e0[3]) + (e1[0] + e1[1]) + (e1[2] + e1[3]);
                pw[t].x = cvtpk(e0[0], e0[1]); pw[t].y = cvtpk(e0[2], e0[3]); pw[t].z = cvtpk(e1[0], e1[1]); pw[t].w = cvtpk(e1[2], e1[3]);
            }
            l_run += psum;
#pragma unroll
            for (int t = 0; t < 2; ++t)
#pragma unroll
                for (int db = 0; db < 4; ++db) { const u32x4 vw = (u32x4){vfr[t][db][0].x, vfr[t][db][0].y, vfr[t][db][1].x, vfr[t][db][1].y};
                    o[db] = __builtin_amdgcn_mfma_f32_16x16x32_bf16(__builtin_bit_cast(bf16x8_t, pw[t]), __builtin_bit_cast(bf16x8_t, vw), o[db], 0, 0, 0); }
            __builtin_amdgcn_sched_barrier(0);
        }
        float lsum = l_run; lsum += __shfl_xor(lsum, 16); lsum += __shfl_xor(lsum, 32);
        const float rinv = 1.f / lsum;
#pragma unroll
        for (int j = 0; j < 4; ++j) { const float rj = __shfl(rinv, 4 * fq + j);
            GAS bf16_t* orow = MIX + (lat0 + rw * 64 + c0 + 4 * fq + j) * 1024 + h * 64 + fr;
#pragma unroll
            for (int db = 0; db < 4; ++db) orow[db * 16] = (bf16_t)f2bf(o[db][j] * rj); }
        __syncthreads();
        if (vld) NA_VFILL(vkra, vw0, vw1);
        __syncthreads();
    }
#undef NA_LOADK
#undef NA_VFILL
}

__device__ __forceinline__ float rope_elem(const float* xr, int d, int t, const GAS float* ROPE) {
    const int half = d >> 5, dd = d & 31, i = dd & 15;
    const int pos = half == 0 ? (t >> 6) : (t & 63);
    const float cs_ = ROPE[(pos * 16 + i) * 2], sn = ROPE[(pos * 16 + i) * 2 + 1];
    const float x1 = xr[half * 32 + i], x2 = xr[half * 32 + 16 + i];
    return dd < 16 ? x1 * cs_ - x2 * sn : x1 * sn + x2 * cs_;
}

struct StPre { u32x4 raw[5]; u32x4 v[4]; };
__device__ __forceinline__ void ml_stats_prefetch(const Params& p, int item, int tid, StPre& r) {
    const GAS bf16_t* U = (const GAS bf16_t*)(p.ws + WS_U);
    const int ch = item % NCH, bh = item / NCH, h = bh & 3, b = bh >> 2;
    const bool is_ctx = ch >= 64; const int Tseq = is_ctx ? 256 : 8192, t0 = (is_ctx ? ch - 64 : ch) * 128;
    const size_t rowbase = is_ctx ? (size_t)NLAT + b * 256 : (size_t)b * 8192;
#pragma unroll
    for (int i = 0; i < 5; ++i) { const int idx = tid + i * NTHR, tt = idx >> 4, ck = idx & 15, t = t0 - 2 + tt;
        u32x4 w = (u32x4){0u, 0u, 0u, 0u};
        if (idx < 132 * 16 && t >= 0 && t < Tseq) w = *(const GAS u32x4*)(U + (rowbase + t) * DINP + (ck < 8 ? C_QM : C_KM) + h * 64 + (ck & 7) * 8);
        r.raw[i] = w; }
#pragma unroll
    for (int i = 0; i < 4; ++i) { const int idx = tid + i * NTHR, l = idx & 127, ck = idx >> 7; r.v[i] = *(const GAS u32x4*)(U + (rowbase + t0 + l) * DINP + C_VM + h * 128 + ck * 8); }
}
__device__ __forceinline__ void ml_stats_item(const Params& p, unsigned char* lds, int item, StPre& pre, int next_item) {
    const GAS bf16_t* U = (const GAS bf16_t*)(p.ws + WS_U); GAS bf16_t* QP = (GAS bf16_t*)(p.ws + WS_QP); GAS bf16_t* KP = (GAS bf16_t*)(p.ws + WS_KP);
    GAS bf16_t* CLOC = (GAS bf16_t*)(p.ws + WS_CLOC); GAS float* NLOC = (GAS float*)(p.ws + WS_NLOC); GAS float* MLOC = (GAS float*)(p.ws + WS_MLOC); GAS float* BLAST = (GAS float*)(p.ws + WS_BLAST);
    const GAS float* ROPE = (const GAS float*)(p.ws + WS_ROPE); const GAS float* convw = (const GAS float*)p.conv_qk;
    const int tid = ltid(), lane = tid & 63, wave = __builtin_amdgcn_readfirstlane(tid >> 6), fr = lane & 15, fq = lane >> 4;
    const int ch = item % NCH, bh = item / NCH, h = bh & 3, b = bh >> 2;
    const bool is_ctx = ch >= 64; const int Tseq = is_ctx ? 256 : 8192, cl = is_ctx ? ch - 64 : ch, t0 = cl * 128;
    const size_t rowbase = is_ctx ? (size_t)NLAT + b * 256 : (size_t)b * 8192;
    bf16_t* KT = (bf16_t*)lds;
    bf16_t* RAW = KT + 64 * 136;
    float* TMP = (float*)(RAW + 132 * 128);
    bf16_t* WV = RAW;
    float* gl = TMP + 128 * 129;
    float* wgt = gl + 512;
    const float* RT = wgt + 256;
#pragma unroll
    for (int i = 0; i < 5; ++i) { const int idx = tid + i * NTHR; if (idx < 132 * 16) *(u32x4*)(RAW + (idx >> 4) * 128 + (idx & 15) * 8) = pre.raw[i]; }
    { const int g = tid >> 7, l = tid & 127; gl[tid] = bf2f(U[(rowbase + t0 + l) * DINP + C_GT + g * 4 + h]) + p.b_gate[g * 4 + h]; }
    __syncthreads();
    for (int rr19_ = 0; rr19_ < REPN(19); ++rr19_) {
    { const int chn = tid & 127, wofs = (chn < 64 ? 0 : 256) + h * 64 + (chn & 63);
      float cw[5];
#pragma unroll
      for (int j = 0; j < 5; ++j) cw[j] = convw[j * 512 + wofs];
      const int l0 = (tid >> 7) * 32;
      float w0 = bf2f(RAW[(l0 + 0) * 128 + chn]), w1 = bf2f(RAW[(l0 + 1) * 128 + chn]), w2 = bf2f(RAW[(l0 + 2) * 128 + chn]), w3 = bf2f(RAW[(l0 + 3) * 128 + chn]);
#pragma unroll 8
      for (int i = 0; i < 32; ++i) { const float w4 = bf2f(RAW[(l0 + i + 4) * 128 + chn]);
          const float a = cw[0] * w0 + cw[1] * w1 + cw[2] * w2 + cw[3] * w3 + cw[4] * w4;
          TMP[(l0 + i) * 129 + chn] = siluf(a); w0 = w1; w1 = w2; w2 = w3; w3 = w4; } }
    if (wave < 2) {
        const int dir = wave, l0 = dir == 0 ? 2 * lane : 127 - 2 * lane, l1 = dir == 0 ? 2 * lane + 1 : 126 - 2 * lane;
        const float* ig = gl + dir * 256; const float* fg = ig + 128;
        const float lf0 = logsigf(fg[l0]), lf1 = logsigf(fg[l1]);
        const float incl = wscan_add(lf0 + lf1, lane), bc0 = incl - lf1, bc1 = incl, blast = __shfl(incl, 63);
        const float a0 = blast - bc0 + ig[l0], a1 = blast - bc1 + ig[l1];
        const float m = wave_max(fmaxf(a0, a1));
        wgt[dir * 128 + l0] = __expf(a0 - m); wgt[dir * 128 + l1] = __expf(a1 - m);
        if (lane == 0) { BLAST[(dir * 32 + bh) * NCH + ch] = blast; MLOC[(dir * 32 + bh) * NCH + ch] = m; }
    }
    }
    __syncthreads();
    for (int rr20_ = 0; rr20_ < REPN(20); ++rr20_) {
    for (int idx = tid; idx < 128 * 16; idx += NTHR) { const int l = idx & 127, ck = idx >> 7, isk = ck >> 3, d0 = (ck & 7) * 8, t = t0 + l;
        if (is_ctx && !isk) continue;
        const float* xr = TMP + l * 129 + isk * 64;
        float o[8];
        if (is_ctx) {
#pragma unroll
            for (int e = 0; e < 8; ++e) o[e] = xr[d0 + e];
        } else {
            const int half = d0 >> 5, dd0 = d0 & 31, i0 = dd0 & 15, pos = half == 0 ? (t >> 6) : (t & 63);
            const f32x4* rp = (const f32x4*)(RT + (pos * 16 + i0) * 2);
            const f32x4 r0 = rp[0], r1 = rp[1], r2 = rp[2], r3 = rp[3];
            const float cs_[8] = {r0.x, r0.z, r1.x, r1.z, r2.x, r2.z, r3.x, r3.z}, sn[8] = {r0.y, r0.w, r1.y, r1.w, r2.y, r2.w, r3.y, r3.w};
#pragma unroll
            for (int e = 0; e < 8; ++e) { const float x1 = xr[half * 32 + i0 + e], x2 = xr[half * 32 + 16 + i0 + e]; o[e] = dd0 < 16 ? x1 * cs_[e] - x2 * sn[e] : x1 * sn[e] + x2 * cs_[e]; }
        }
        if (!isk) { u32x4 w; w.x = pk2(o[0] * 0.125f, o[1] * 0.125f); w.y = pk2(o[2] * 0.125f, o[3] * 0.125f); w.z = pk2(o[4] * 0.125f, o[5] * 0.125f); w.w = pk2(o[6] * 0.125f, o[7] * 0.125f);
            *(GAS u32x4*)(QP + ((size_t)b * 8192 + t) * 256 + h * 64 + d0) = w; }
        else { u32x4 w; w.x = pk2(o[0], o[1]); w.y = pk2(o[2], o[3]); w.z = pk2(o[4], o[5]); w.w = pk2(o[6], o[7]);
            *(GAS u32x4*)(KP + (rowbase + t) * 256 + h * 64 + d0) = w;
            KT[(d0 + 0) * 136 + l] = (bf16_t)(w.x & 0xffffu); KT[(d0 + 1) * 136 + l] = (bf16_t)(w.x >> 16); KT[(d0 + 2) * 136 + l] = (bf16_t)(w.y & 0xffffu); KT[(d0 + 3) * 136 + l] = (bf16_t)(w.y >> 16);
            KT[(d0 + 4) * 136 + l] = (bf16_t)(w.z & 0xffffu); KT[(d0 + 5) * 136 + l] = (bf16_t)(w.z >> 16); KT[(d0 + 6) * 136 + l] = (bf16_t)(w.w & 0xffffu); KT[(d0 + 7) * 136 + l] = (bf16_t)(w.w >> 16); }
    }
    }
    __syncthreads();
    for (int rr21_ = 0; rr21_ < REPN(21); ++rr21_) {
#pragma unroll
    for (int i = 0; i < 4; ++i) { const int idx = tid + i * NTHR, l = idx & 127, ck = idx >> 7;
        const u32x4 w = pre.v[i];
        const float wf = wgt[l], wb = wgt[128 + l];
        const float vv[8] = {bflo(w.x), bfhi(w.x), bflo(w.y), bfhi(w.y), bflo(w.z), bfhi(w.z), bflo(w.w), bfhi(w.w)};
#pragma unroll
        for (int e = 0; e < 8; ++e) { WV[(ck * 8 + e) * 136 + l] = (bf16_t)f2bf(wf * vv[e]); WV[(128 + ck * 8 + e) * 136 + l] = (bf16_t)f2bf(wb * vv[e]); } }
    }
    __syncthreads();
    if (next_item >= 0) ml_stats_prefetch(p, next_item, tid, pre);
    for (int rr22_ = 0; rr22_ < REPN(22); ++rr22_) {
    { const int dir = wave >> 2, vb0 = (wave & 3) * 2;
      GAS bf16_t* cdst = CLOC + ((size_t)(dir * 32 + bh) * NCH + ch) * 8192;
#pragma unroll
      for (int vbi = 0; vbi < 2; ++vbi) {
          const int vb = vb0 + vbi;
          bf16x8_t af[4];
#pragma unroll
          for (int ls = 0; ls < 4; ++ls) af[ls] = *(const bf16x8_t*)(WV + (dir * 128 + vb * 16 + fr) * 136 + ls * 32 + 8 * fq);
#pragma unroll
          for (int kb = 0; kb < 4; ++kb) {
              f32x4 acc = (f32x4){0.f, 0.f, 0.f, 0.f};
#pragma unroll
              for (int ls = 0; ls < 4; ++ls) { const bf16x8_t bfr = *(const bf16x8_t*)(KT + (kb * 16 + fr) * 136 + ls * 32 + 8 * fq); acc = __builtin_amdgcn_mfma_f32_16x16x32_bf16(af[ls], bfr, acc, 0, 0, 0); }
#pragma unroll
              for (int j = 0; j < 4; ++j) cdst[(vb * 16 + 4 * fq + j) * 64 + kb * 16 + fr] = (bf16_t)f2bf(acc[j]);
          }
      }
      if (tid < 128) { const int d2 = tid >> 6, k = tid & 63; float sn = 0.f;
          for (int l = 0; l < 128; ++l) sn += wgt[d2 * 128 + l] * bf2f(KT[k * 136 + l]);
          NLOC[((size_t)(d2 * 32 + bh) * NCH + ch) * 64 + k] = sn; }
    }
    }
    __syncthreads();
}
__device__ __forceinline__ void ph3(const Params& p, unsigned char* lds, int bid, int nblk) {
    for (int rep_ = 0; rep_ < REPN(14); ++rep_) for (int it = bid; it < 256; it += nblk) na_item(p, lds, (nblk == 256) ? ((it & 7) * 32 + (it >> 3)) : it);
    {
      float* RTw = (float*)((bf16_t*)lds + 64 * 136 + 132 * 128) + 128 * 129 + 512 + 256; const GAS float* ROPEg = (const GAS float*)(p.ws + WS_ROPE);
      for (int i = threadIdx.x; i < 4096; i += NTHR) RTw[i] = ROPEg[i];
      __syncthreads(); }
    for (int rep_ = 0; rep_ < REPN(15); ++rep_) { StPre pre; if (bid < 32 * NCH) ml_stats_prefetch(p, bid, (int)threadIdx.x, pre);
        for (int it = bid; it < 32 * NCH; it += nblk) ml_stats_item(p, lds, it, pre, it + nblk < 32 * NCH ? it + nblk : -1); }
}

__device__ __forceinline__ void ph4(const Params& p, int bid, int nblk) {
    GAS bf16_t* CLOC = (GAS bf16_t*)(p.ws + WS_CLOC); GAS float* NLOC = (GAS float*)(p.ws + WS_NLOC); const GAS float* MLOC = (const GAS float*)(p.ws + WS_MLOC);
    const GAS float* BLAST = (const GAS float*)(p.ws + WS_BLAST); GAS float* MIN = (GAS float*)(p.ws + WS_MIN);
    const int tid = ltid();
    for (int it = bid; it < 64 * 5; it += nblk) {
        const bool small = it >= 256; const int q = small ? it - 256 : it >> 2, seg = it & 3, dir = q >> 5;
        if (small && tid > 64) continue;
        float c0 = 0.f, c1 = 0.f, c2 = 0.f, c3 = 0.f, m_prev = 0.f;
        GAS bf16_t* cbase = CLOC + (size_t)q * NCH * 8192 + seg * 2048 + tid * 4;
        GAS float* nbase = NLOC + (size_t)q * NCH * 64 + (tid & 63);
        for (int s0 = 0; s0 < NCH; s0 += 22) {
            u32x2 cw[22]; float nv[22], bl[22], ml[22]; int ci[22];
#pragma unroll
            for (int u = 0; u < 22; ++u) { const int step = s0 + u; ci[u] = dir == 0 ? (step < 2 ? 64 + step : step - 2) : 65 - step;
                bl[u] = BLAST[q * NCH + ci[u]]; ml[u] = MLOC[q * NCH + ci[u]];
                if (!small) cw[u] = *(const GAS u32x2*)(cbase + (size_t)ci[u] * 8192); else nv[u] = tid < 64 ? nbase[ci[u] * 64] : 0.f; }
#pragma unroll
            for (int u = 0; u < 22; ++u) {
                const float m_new = fmaxf(bl[u] + m_prev, ml[u]), sp = __expf(bl[u] + m_prev - m_new), sl = __expf(ml[u] - m_new);
                if (!small) { u32x2 o; o.x = pk2(c0, c1); o.y = pk2(c2, c3); *(GAS u32x2*)(cbase + (size_t)ci[u] * 8192) = o;
                    c0 = sp * c0 + sl * bflo(cw[u].x); c1 = sp * c1 + sl * bfhi(cw[u].x); c2 = sp * c2 + sl * bflo(cw[u].y); c3 = sp * c3 + sl * bfhi(cw[u].y); }
                else if (tid < 64) { nbase[ci[u] * 64] = c0; c0 = sp * c0 + sl * nv[u]; }
                else MIN[q * NCH + ci[u]] = m_prev;
                m_prev = m_new;
            }
        }
    }
}

struct MlPre { u32x4 q[2], k[2], v[4], c[2][2]; };
__device__ __forceinline__ void ml_out_prefetch(const Params& p, int item, int tid, MlPre& r) {
    const GAS bf16_t* U = (const GAS bf16_t*)(p.ws + WS_U); const GAS bf16_t* QP = (const GAS bf16_t*)(p.ws + WS_QP); const GAS bf16_t* KP = (const GAS bf16_t*)(p.ws + WS_KP);
    const GAS bf16_t* CLOC = (const GAS bf16_t*)(p.ws + WS_CLOC);
    const int J = item & 63, bh = item >> 6, h = bh & 3, b = bh >> 2; const size_t row0 = (size_t)b * 8192 + J * 128;
#pragma unroll
    for (int i = 0; i < 2; ++i) { const int idx = tid + i * NTHR, rr = idx >> 3, ck = idx & 7;
        r.q[i] = *(const GAS u32x4*)(QP + (row0 + rr) * 256 + h * 64 + ck * 8); r.k[i] = *(const GAS u32x4*)(KP + (row0 + rr) * 256 + h * 64 + ck * 8); }
#pragma unroll
    for (int i = 0; i < 4; ++i) { const int idx = tid + i * NTHR, l = idx & 127, ck = idx >> 7; r.v[i] = *(const GAS u32x4*)(U + (row0 + l) * DINP + C_VM + h * 128 + ck * 8); }
#pragma unroll
    for (int dir = 0; dir < 2; ++dir) { const GAS bf16_t* csrc = CLOC + ((size_t)(dir * 32 + bh) * NCH + J) * 8192;
#pragma unroll
        for (int i = 0; i < 2; ++i) { const int idx = tid + i * NTHR; r.c[dir][i] = *(const GAS u32x4*)(csrc + idx * 8); } }
}
__device__ __forceinline__ void ml_out_item(const Params& p, unsigned char* lds, int item, MlPre& pre, int next_item) {
    const GAS bf16_t* U = (const GAS bf16_t*)(p.ws + WS_U); const GAS bf16_t* QP = (const GAS bf16_t*)(p.ws + WS_QP); const GAS bf16_t* KP = (const GAS bf16_t*)(p.ws + WS_KP);
    const GAS float* NLOC = (const GAS float*)(p.ws + WS_NLOC); const GAS float* MIN = (const GAS float*)(p.ws + WS_MIN);
    GAS bf16_t* MIX = (GAS bf16_t*)(p.ws + WS_MIX);
    const int tid = ltid(), lane = tid & 63, wave = __builtin_amdgcn_readfirstlane(tid >> 6), fr = lane & 15, fq = lane >> 4;
    const int J = item & 63, bh = item >> 6, h = bh & 3, b = bh >> 2, t0 = J * 128;
    const size_t row0 = (size_t)b * 8192 + t0;
    bf16_t* Qs = (bf16_t*)lds;
    bf16_t* Ks = Qs + 128 * 72;
    bf16_t* VT = Ks + 128 * 72;
    bf16_t* Cs = VT + 128 * 136;
    float* asv = (float*)(Cs + 2 * 128 * 72);
    float* btv = asv + 256;
    float* itv = btv + 256;
    float* emt = itv + 256;
    float* nin = emt + 256;
    float* OST = nin + 128 + wave * (8 * 132);
    for (int r16_ = 0; r16_ < REPN(16); ++r16_) {
    if (wave < 2) {
        const int dir = wave, l0 = dir == 0 ? 2 * lane : 127 - 2 * lane, l1 = dir == 0 ? 2 * lane + 1 : 126 - 2 * lane;
        const GAS bf16_t* g0 = U + (row0 + l0) * DINP + C_GT + h; const GAS bf16_t* g1 = U + (row0 + l1) * DINP + C_GT + h;
        const float bi = p.b_gate[dir * 8 + h], bf_ = p.b_gate[dir * 8 + 4 + h];
        const float i0 = bf2f(g0[dir * 8]) + bi, f0 = bf2f(g0[dir * 8 + 4]) + bf_, i1 = bf2f(g1[dir * 8]) + bi, f1 = bf2f(g1[dir * 8 + 4]) + bf_;
        const float m_in = MIN[(dir * 32 + bh) * NCH + J];
        const float lf0 = logsigf(f0), lf1 = logsigf(f1);
        const float incl = wscan_add(lf0 + lf1, lane), bc0 = incl - lf1, bc1 = incl;
        const float as0 = i0 - bc0, as1 = i1 - bc1;
        const float inclm = wscan_max(fmaxf(as0, as1), lane); float exclm = __shfl_up(inclm, 1); if (lane == 0) exclm = -INFINITY;
        const float gm0 = fmaxf(exclm, as0), gm1 = inclm;
        const float mp0 = bc0 + m_in, mp1 = bc1 + m_in, mt0 = fmaxf(bc0 + gm0, mp0), mt1 = fmaxf(bc1 + gm1, mp1);
        asv[dir * 128 + l0] = as0; asv[dir * 128 + l1] = as1; btv[dir * 128 + l0] = bc0 - mt0; btv[dir * 128 + l1] = bc1 - mt1;
        itv[dir * 128 + l0] = __expf(mp0 - mt0); itv[dir * 128 + l1] = __expf(mp1 - mt1); emt[dir * 128 + l0] = __expf(-mt0); emt[dir * 128 + l1] = __expf(-mt1);
    }
#pragma unroll
    for (int i = 0; i < 2; ++i) { const int idx = tid + i * NTHR, r = idx >> 3, ck = idx & 7; *(u32x4*)(Qs + r * 72 + ck * 8) = pre.q[i]; *(u32x4*)(Ks + r * 72 + ck * 8) = pre.k[i]; }
#pragma unroll
    for (int i = 0; i < 4; ++i) { const int idx = tid + i * NTHR, l = idx & 127, ck = idx >> 7;
        const u32x4 w = pre.v[i]; bf16_t* d = VT + (ck * 8) * 136 + l;
        d[0 * 136] = (bf16_t)(w.x & 0xffffu); d[1 * 136] = (bf16_t)(w.x >> 16); d[2 * 136] = (bf16_t)(w.y & 0xffffu); d[3 * 136] = (bf16_t)(w.y >> 16);
        d[4 * 136] = (bf16_t)(w.z & 0xffffu); d[5 * 136] = (bf16_t)(w.z >> 16); d[6 * 136] = (bf16_t)(w.w & 0xffffu); d[7 * 136] = (bf16_t)(w.w >> 16); }
#pragma unroll
    for (int dir = 0; dir < 2; ++dir)
#pragma unroll
        for (int i = 0; i < 2; ++i) { const int idx = tid + i * NTHR, v = idx >> 3, k8 = idx & 7; *(u32x4*)(Cs + (dir * 128 + v) * 72 + k8 * 8) = pre.c[dir][i]; }
    if (tid < 128) nin[tid] = NLOC[((size_t)((tid >> 6) * 32 + bh) * NCH + J) * 64 + (tid & 63)];
    }
    __syncthreads();
    if (next_item >= 0) ml_out_prefetch(p, next_item, tid, pre);
    const int tb = wave;
    bf16x8_t qf[2];
#pragma unroll
    for (int ks = 0; ks < 2; ++ks) qf[ks] = *(const bf16x8_t*)(Qs + (16 * tb + fr) * 72 + ks * 32 + 8 * fq);
    f32x4 hs[8];
    for (int r17_ = 0; r17_ < REPN(17); ++r17_) {
#pragma unroll
    for (int vb = 0; vb < 8; ++vb) hs[vb] = (f32x4){0.f, 0.f, 0.f, 0.f};
#pragma unroll
    for (int dir = 0; dir < 2; ++dir) {
        f32x4 acc[8];
#pragma unroll
        for (int vb = 0; vb < 8; ++vb) { acc[vb] = (f32x4){0.f, 0.f, 0.f, 0.f};
#pragma unroll
            for (int ks = 0; ks < 2; ++ks) { const bf16x8_t cf = *(const bf16x8_t*)(Cs + (dir * 128 + vb * 16 + fr) * 72 + ks * 32 + 8 * fq); acc[vb] = __builtin_amdgcn_mfma_f32_16x16x32_bf16(qf[ks], cf, acc[vb], 0, 0, 0); } }
        { const f32x4 i4 = *(const f32x4*)(itv + dir * 128 + 16 * tb + 4 * fq);
#pragma unroll
          for (int vb = 0; vb < 8; ++vb) acc[vb] = acc[vb] * i4; }
        const float bt = btv[dir * 128 + 16 * tb + fr];
        float rowsum = 0.f;
#pragma unroll
        for (int pr = 0; pr < 4; ++pr) {
            const int sb0 = 2 * pr, sb1 = 2 * pr + 1;
            const bool need0 = dir == 0 ? (sb0 <= tb) : (sb0 >= tb), need1 = dir == 0 ? (sb1 <= tb) : (sb1 >= tb);
            if (!need0 && !need1) continue;
            f32x4 s0 = (f32x4){0.f, 0.f, 0.f, 0.f}, s1 = (f32x4){0.f, 0.f, 0.f, 0.f};
            if (need0) {
#pragma unroll
                for (int ks = 0; ks < 2; ++ks) { const bf16x8_t kf = *(const bf16x8_t*)(Ks + (16 * sb0 + fr) * 72 + ks * 32 + 8 * fq); s0 = __builtin_amdgcn_mfma_f32_16x16x32_bf16(kf, qf[ks], s0, 0, 0, 0); }
                const f32x4 a4 = *(const f32x4*)(asv + dir * 128 + 16 * sb0 + 4 * fq);
#pragma unroll
                for (int j = 0; j < 4; ++j) { const bool valid = (sb0 != tb) || (dir == 0 ? (4 * fq + j <= fr) : (4 * fq + j >= fr)); s0[j] = valid ? s0[j] * __expf(bt + a4[j]) : 0.f; }
            }
            if (need1) {
#pragma unroll
                for (int ks = 0; ks < 2; ++ks) { const bf16x8_t kf = *(const bf16x8_t*)(Ks + (16 * sb1 + fr) * 72 + ks * 32 + 8 * fq); s1 = __builtin_amdgcn_mfma_f32_16x16x32_bf16(kf, qf[ks], s1, 0, 0, 0); }
                const f32x4 a4 = *(const f32x4*)(asv + dir * 128 + 16 * sb1 + 4 * fq);
#pragma unroll
                for (int j = 0; j < 4; ++j) { const bool valid = (sb1 != tb) || (dir == 0 ? (4 * fq + j <= fr) : (4 * fq + j >= fr)); s1[j] = valid ? s1[j] * __expf(bt + a4[j]) : 0.f; }
            }
            rowsum += (s0[0] + s0[1]) + (s0[2] + s0[3]) + (s1[0] + s1[1]) + (s1[2] + s1[3]);
            u32x4 pw; pw.x = cvtpk(s0[0], s0[1]); pw.y = cvtpk(s0[2], s0[3]); pw.z = cvtpk(s1[0], s1[1]); pw.w = cvtpk(s1[2], s1[3]);
            const bf16x8_t pa = __builtin_bit_cast(bf16x8_t, pw);
#pragma unroll
            for (int vb = 0; vb < 8; ++vb) {
                const u32x2 v0 = *(const u32x2*)(VT + (vb * 16 + fr) * 136 + 16 * sb0 + 4 * fq), v1 = *(const u32x2*)(VT + (vb * 16 + fr) * 136 + 16 * sb1 + 4 * fq);
                const u32x4 vw = (u32x4){v0.x, v0.y, v1.x, v1.y};
                acc[vb] = __builtin_amdgcn_mfma_f32_16x16x32_bf16(pa, __builtin_bit_cast(bf16x8_t, vw), acc[vb], 0, 0, 0);
            }
        }
        rowsum += __shfl_xor(rowsum, 16); rowsum += __shfl_xor(rowsum, 32);
        float nq = 0.f;
        { const u32x4 qa = *(const u32x4*)(Qs + (16 * tb + fr) * 72 + 16 * fq), qb = *(const u32x4*)(Qs + (16 * tb + fr) * 72 + 16 * fq + 8); const float* nn = nin + dir * 64 + 16 * fq;
          nq = nn[0] * bflo(qa.x) + nn[1] * bfhi(qa.x) + nn[2] * bflo(qa.y) + nn[3] * bfhi(qa.y) + nn[4] * bflo(qa.z) + nn[5] * bfhi(qa.z) + nn[6] * bflo(qa.w) + nn[7] * bfhi(qa.w)
             + nn[8] * bflo(qb.x) + nn[9] * bfhi(qb.x) + nn[10] * bflo(qb.y) + nn[11] * bfhi(qb.y) + nn[12] * bflo(qb.z) + nn[13] * bfhi(qb.z) + nn[14] * bflo(qb.w) + nn[15] * bfhi(qb.w); }
        nq += __shfl_xor(nq, 16); nq += __shfl_xor(nq, 32);
        const float den = rowsum + itv[dir * 128 + 16 * tb + fr] * nq;
        const float rdn = 1.f / fmaxf(fabsf(den), emt[dir * 128 + 16 * tb + fr]);
#pragma unroll
        for (int j = 0; j < 4; ++j) { const float r = __shfl(rdn, 4 * fq + j);
#pragma unroll
            for (int vb = 0; vb < 8; ++vb) hs[vb][j] += acc[vb][j] * r; }
    }
    }
    float mu[4], rs[4];
#pragma unroll
    for (int j = 0; j < 4; ++j) { float sm = 0.f;
#pragma unroll
        for (int vb = 0; vb < 8; ++vb) sm += hs[vb][j];
        sm += __shfl_xor(sm, 1); sm += __shfl_xor(sm, 2); sm += __shfl_xor(sm, 4); sm += __shfl_xor(sm, 8);
        mu[j] = sm * (1.f / 128.f); float sq = 0.f;
#pragma unroll
        for (int vb = 0; vb < 8; ++vb) { const float d = hs[vb][j] - mu[j]; sq += d * d; }
        sq += __shfl_xor(sq, 1); sq += __shfl_xor(sq, 2); sq += __shfl_xor(sq, 4); sq += __shfl_xor(sq, 8);
        rs[j] = rsqrtf(sq * (1.f / 128.f) + LN_EPS); }
    const GAS float* mng = (const GAS float*)p.ml_norm_g + h * 128;
    for (int r18_ = 0; r18_ < REPN(18); ++r18_) {
#pragma unroll
    for (int ps = 0; ps < 2; ++ps) {
#pragma unroll
        for (int vb = 0; vb < 8; ++vb) { const float gg = mng[vb * 16 + fr];
#pragma unroll
            for (int jj = 0; jj < 2; ++jj) { const int j = 2 * ps + jj; OST[(2 * fq + jj) * 132 + vb * 16 + fr] = (hs[vb][j] - mu[j]) * rs[j] * gg; } }
        LDS_FENCE();
        { const int rl = lane >> 3, ck = lane & 7, t = 16 * tb + 4 * (rl >> 1) + 2 * ps + (rl & 1);
          const float* src = OST + rl * 132 + ck * 16;
          const f32x4 o0 = *(const f32x4*)src, o1 = *(const f32x4*)(src + 4), o2 = *(const f32x4*)(src + 8), o3 = *(const f32x4*)(src + 12);
          const GAS bf16_t* omp = U + (row0 + t) * DINP + C_OM + h * 128 + ck * 16;
          const u32x4 oa = *(const GAS u32x4*)omp, ob = *(const GAS u32x4*)(omp + 8);
          u32x4 wa, wb;
          wa.x = pk2(o0.x * sigmoidf_(bflo(oa.x)), o0.y * sigmoidf_(bfhi(oa.x))); wa.y = pk2(o0.z * sigmoidf_(bflo(oa.y)), o0.w * sigmoidf_(bfhi(oa.y)));
          wa.z = pk2(o1.x * sigmoidf_(bflo(oa.z)), o1.y * sigmoidf_(bfhi(oa.z))); wa.w = pk2(o1.z * sigmoidf_(bflo(oa.w)), o1.w * sigmoidf_(bfhi(oa.w)));
          wb.x = pk2(o2.x * sigmoidf_(bflo(ob.x)), o2.y * sigmoidf_(bfhi(ob.x))); wb.y = pk2(o2.z * sigmoidf_(bflo(ob.y)), o2.w * sigmoidf_(bfhi(ob.y)));
          wb.z = pk2(o3.x * sigmoidf_(bflo(ob.z)), o3.y * sigmoidf_(bfhi(ob.z))); wb.w = pk2(o3.z * sigmoidf_(bflo(ob.w)), o3.w * sigmoidf_(bfhi(ob.w)));
          GAS bf16_t* dst = MIX + (row0 + t) * 1024 + 512 + h * 128 + ck * 16;
          *(GAS u32x4*)dst = wa; *(GAS u32x4*)(dst + 8) = wb; }
        LDS_FENCE();
    }
    }
    __syncthreads();
}
__device__ __forceinline__ void ph5(const Params& p, unsigned char* lds, int bid, int nblk) {
    MlPre pre; const int tid0 = threadIdx.x;
    if (bid < 32 * 64) ml_out_prefetch(p, bid, tid0, pre);
    for (int it = bid; it < 32 * 64; it += nblk) ml_out_item(p, lds, it, pre, it + nblk < 32 * 64 ? it + nblk : -1);
}


struct TrItem { const GAS float* W; GAS unsigned char* WT; size_t orow0; int N, k0, n0, ldt; float qs; };
__device__ __forceinline__ TrItem tr_decode(const Params& p, int it) {
    TrItem t; const int e = it / (3 * 704), r = it % (3 * 704), which = r / 704, q = r % 704;
    if (which < 2) { const int kb = q / 44, nb = q % 44; t.n0 = nb * 64; t.k0 = kb * 64; t.W = (const GAS float*)(which == 0 ? p.w_eg : p.w_eu) + (size_t)e * 1024 * DFF; t.N = DFF;
        t.WT = (GAS unsigned char*)(p.ws + WS_WGUT) + (size_t)e * 2 * DFF * 1024; t.orow0 = (size_t)((t.n0 >> 7) * 256 + which * 128 + (t.n0 & 127)); t.ldt = 1024; t.qs = 32.f; }
    else { const int kb = q / 16, nb = q % 16; t.n0 = nb * 64; t.k0 = kb * 64; t.W = (const GAS float*)p.w_ed + (size_t)e * DFF * 1024; t.N = 1024;
        t.WT = (GAS unsigned char*)(p.ws + WS_WDT) + (size_t)e * 1024 * DFF; t.orow0 = (size_t)t.n0; t.ldt = DFF; t.qs = 64.f; }
    return t;
}
__device__ __forceinline__ void tr_load(const TrItem& t, int lane, f32x4 (&v)[16]) {
    const int cq = (lane & 15) * 4, rq = lane >> 4;
#pragma unroll
    for (int i = 0; i < 16; ++i) v[i] = __builtin_nontemporal_load((const GAS f32x4*)(t.W + (size_t)(t.k0 + 4 * i + rq) * t.N + t.n0 + cq));
}
__device__ __forceinline__ void tr_to_lds(const TrItem& t, int lane, const f32x4 (&v)[16], float* scr) {
    const int cq = (lane & 15) * 4, rq = lane >> 4;
#pragma unroll
    for (int i = 0; i < 16; ++i) { float* d = scr + (4 * i + rq) * 65 + cq; d[0] = v[i].x * t.qs; d[1] = v[i].y * t.qs; d[2] = v[i].z * t.qs; d[3] = v[i].w * t.qs; }
    LDS_FENCE();
}
__device__ __forceinline__ void tr_store(const TrItem& t, int lane, const float* scr) {
    const int c = lane & 7;
#pragma unroll
    for (int j = 0; j < 8; ++j) {
        const int n = (lane >> 3) + 8 * j; const float* sp = scr + (8 * c) * 65 + n;
        u32x2 o; o.x = pk4_fp8(sp[0 * 65], sp[1 * 65], sp[2 * 65], sp[3 * 65]); o.y = pk4_fp8(sp[4 * 65], sp[5 * 65], sp[6 * 65], sp[7 * 65]);
        *(GAS u32x2*)(t.WT + (t.orow0 + n) * t.ldt + t.k0 + 8 * c) = o;
    }
    LDS_FENCE();
}
__device__ __forceinline__ float reduce16(const float (&lg)[16], int lane) {
    float a8[8], a4[4], a2[2];
    const bool h5 = lane & 32, h4 = lane & 16, h3 = lane & 8, h2 = lane & 4;
#pragma unroll
    for (int i = 0; i < 8; ++i) { const float snd = h5 ? lg[i] : lg[8 + i], kp = h5 ? lg[8 + i] : lg[i]; a8[i] = kp + __shfl_xor(snd, 32); }
#pragma unroll
    for (int i = 0; i < 4; ++i) { const float snd = h4 ? a8[i] : a8[4 + i], kp = h4 ? a8[4 + i] : a8[i]; a4[i] = kp + __shfl_xor(snd, 16); }
#pragma unroll
    for (int i = 0; i < 2; ++i) { const float snd = h3 ? a4[i] : a4[2 + i], kp = h3 ? a4[2 + i] : a4[i]; a2[i] = kp + __shfl_xor(snd, 8); }
    const float snd = h2 ? a2[0] : a2[1], kp = h2 ? a2[1] : a2[0];
    float d = kp + __shfl_xor(snd, 4);
    d += __shfl_xor(d, 2); d += __shfl_xor(d, 1);
    return d;
}
__device__ __forceinline__ void ph7(const Params& p, unsigned char* lds, int bid, int nblk) {
    const int tid = ltid(), lane = tid & 63, wave = tid >> 6;
    const GAS float* MOD = (const GAS float*)(p.ws + WS_MOD); GAS unsigned char* HMOD = (GAS unsigned char*)(p.ws + WS_HMOD); GAS float* AFF = (GAS float*)(p.ws + WS_AFF);
    const GAS bf16_t* Y = (const GAS bf16_t*)(p.ws + WS_Y); const GAS float* ln1g = (const GAS float*)p.ln1_g; const GAS float* ln1b = (const GAS float*)p.ln1_b;
    const int gw = bid * NWAVES + wave, ngw = nblk * NWAVES;
    __syncthreads();
    float* WR = (float*)lds; float* RED = WR + 16 * 1028;
    { const GAS float* wr = (const GAS float*)p.w_router; for (int idx = tid; idx < 16 * 1024; idx += NTHR) { const int k = idx >> 4, e = idx & 15; WR[e * 1028 + k] = wr[idx]; } }
    __syncthreads();
    for (int rep12_ = 0; rep12_ < REPN(12); ++rep12_) {
    u32x2 vn[2][4];
    if (2 * gw < NLAT) {
#pragma unroll
        for (int r = 0; r < 2; ++r)
#pragma unroll
            for (int j = 0; j < 4; ++j) vn[r][j] = *(const GAS u32x2*)(Y + (size_t)(2 * gw + r) * 1024 + j * 256 + lane * 4); }
    for (int m0 = 2 * gw; m0 < NLAT; m0 += 2 * ngw) {
        asm volatile("" ::: "memory");
        const int b = m0 >> 13;
        const GAS float* sh2 = MOD + b * 6144 + 3072; const GAS float* sc2 = sh2 + 1024;
        f32x4 v[2][4]; float mean[2], rstd[2];
#pragma unroll
        for (int r = 0; r < 2; ++r)
#pragma unroll
            for (int j = 0; j < 4; ++j) v[r][j] = (f32x4){hlo(vn[r][j].x), hhi(vn[r][j].x), hlo(vn[r][j].y), hhi(vn[r][j].y)};
        if (m0 + 2 * ngw < NLAT) {
#pragma unroll
            for (int r = 0; r < 2; ++r)
#pragma unroll
                for (int j = 0; j < 4; ++j) vn[r][j] = *(const GAS u32x2*)(Y + (size_t)(m0 + 2 * ngw + r) * 1024 + j * 256 + lane * 4); }
#pragma unroll
        for (int r = 0; r < 2; ++r) { float sm = 0.f;
#pragma unroll
            for (int j = 0; j < 4; ++j) sm += (v[r][j].x + v[r][j].y) + (v[r][j].z + v[r][j].w);
            mean[r] = wave_sum(sm) * (1.f / 1024.f); float s2 = 0.f;
#pragma unroll
            for (int j = 0; j < 4; ++j) { v[r][j] = v[r][j] - mean[r]; s2 += (v[r][j].x * v[r][j].x + v[r][j].y * v[r][j].y) + (v[r][j].z * v[r][j].z + v[r][j].w * v[r][j].w); }
            rstd[r] = rsqrtf(wave_sum(s2) * (1.f / 1024.f) + LN_EPS); }
        f32x4 hm[2][4];
#pragma unroll
        for (int j = 0; j < 4; ++j) {
            const int k = j * 256 + lane * 4;
            const f32x4 g = *(const GAS f32x4*)(ln1g + k), be = *(const GAS f32x4*)(ln1b + k), a = *(const GAS f32x4*)(sc2 + k), sb = *(const GAS f32x4*)(sh2 + k);
#pragma unroll
            for (int r = 0; r < 2; ++r) { hm[r][j] = (v[r][j] * rstd[r] * g + be) * (1.f + a) + sb;
                *(GAS unsigned*)(HMOD + (size_t)(m0 + r) * 1024 + k) = pk4_fp8(hm[r][j].x, hm[r][j].y, hm[r][j].z, hm[r][j].w); }
        }
        float* red = RED + wave * (2 * 64 * 17);
#pragma unroll
        for (int e4 = 0; e4 < 4; ++e4) {
            float a[2][4];
#pragma unroll
            for (int ee = 0; ee < 4; ++ee) {
                f32x4 a0 = {0.f, 0.f, 0.f, 0.f}, a1 = {0.f, 0.f, 0.f, 0.f};
#pragma unroll
                for (int j = 0; j < 4; ++j) { const f32x4 w = *(const f32x4*)(WR + (e4 * 4 + ee) * 1028 + j * 256 + lane * 4);
                    a0 = __builtin_elementwise_fma(hm[0][j], w, a0); a1 = __builtin_elementwise_fma(hm[1][j], w, a1); }
                a[0][ee] = (a0.x + a0.y) + (a0.z + a0.w); a[1][ee] = (a1.x + a1.y) + (a1.z + a1.w);
            }
#pragma unroll
            for (int ee = 0; ee < 4; ++ee) { red[lane * 17 + e4 * 4 + ee] = a[0][ee]; red[64 * 17 + lane * 17 + e4 * 4 + ee] = a[1][ee]; }
            asm volatile("" ::: "memory");
        }
        LDS_FENCE();
        { const int e = lane & 15, r = (lane >> 4) & 1, part = lane >> 5;
          float d = 0.f; const float* src = red + r * (64 * 17) + e + part * 32 * 17;
#pragma unroll 8
          for (int l = 0; l < 32; ++l) d += src[l * 17];
          d += __shfl_xor(d, 32);
          float mx = d; mx = fmaxf(mx, __shfl_xor(mx, 1)); mx = fmaxf(mx, __shfl_xor(mx, 2)); mx = fmaxf(mx, __shfl_xor(mx, 4)); mx = fmaxf(mx, __shfl_xor(mx, 8));
          const float ex = expf(d - mx); float sm = ex; sm += __shfl_xor(sm, 1); sm += __shfl_xor(sm, 2); sm += __shfl_xor(sm, 4); sm += __shfl_xor(sm, 8);
          if (lane < 32) AFF[((size_t)b * 16 + e) * 8192 + ((m0 + r) & 8191)] = ex / sm; }
        LDS_FENCE();
    }
    }
}
__device__ __forceinline__ void ph7_conv(const Params& p, unsigned char* lds, int bid, int nblk) {
    const int tid = ltid(), lane = tid & 63, wave = tid >> 6;
    const int gw = bid * NWAVES + wave, ngw = nblk * NWAVES;
    float* scr = (float*)lds + wave * (64 * 65);
    for (int rep13_ = 0; rep13_ < REPN(13); ++rep13_) {
        f32x4 tv[16]; int it = gw;
        if (it < NE * 3 * 704) { const TrItem c0 = tr_decode(p, it); tr_load(c0, lane, tv); }
        for (; it < NE * 3 * 704; it += ngw) {
            const TrItem cur = tr_decode(p, it);
            tr_to_lds(cur, lane, tv, scr);
            if (it + ngw < NE * 3 * 704) { const TrItem nx = tr_decode(p, it + ngw); tr_load(nx, lane, tv); }
            tr_store(cur, lane, scr);
        }
    }
    __syncthreads();
}

__device__ __forceinline__ void topk_item(const Params& p, unsigned char* lds, int item) {
    const float* AFF = (const float*)(p.ws + WS_AFF); int* IDX = (int*)(p.ws + WS_IDX); float* GSEL = (float*)(p.ws + WS_GSEL); int* INV = (int*)(p.ws + WS_INV);
    const int tid = ltid(), lane = tid & 63, wave = tid >> 6;
    const int b = item >> 4, e = item & 15;
    unsigned* wcnt = (unsigned*)lds;
    const float* a = AFF + ((size_t)b * 16 + e) * 8192;
    unsigned bits[16];
#pragma unroll
    for (int j = 0; j < 16; ++j) bits[j] = __float_as_uint(a[j * 512 + tid]);
    __syncthreads();
    unsigned tau = 0u;
    for (int bit = 30; bit >= 0; --bit) {
        const unsigned cand = tau | (1u << bit);
        unsigned cnt = 0;
#pragma unroll
        for (int j = 0; j < 16; ++j) cnt += (unsigned)__popcll(__ballot(bits[j] >= cand));
        unsigned* slot = wcnt + ((bit & 1) << 3);
        if (lane == 0) slot[wave] = cnt;
        __syncthreads();
        unsigned tot = 0;
#pragma unroll
        for (int w = 0; w < 8; ++w) tot += slot[w];
        if (tot >= (unsigned)CAP) tau = cand;
    }
    unsigned* ctab = wcnt + 32;
    const unsigned long long lt_mask = (1ull << lane) - 1ull;
#pragma unroll
    for (int j = 0; j < 16; ++j) { const unsigned cw = (unsigned)__popcll(__ballot(bits[j] > tau)) | ((unsigned)__popcll(__ballot(bits[j] == tau)) << 16);
        if (lane == 0) ctab[j * 8 + wave] = cw; }
    __syncthreads();
    unsigned ngt = 0;
#pragma unroll
    for (int j = 0; j < 16; ++j)
#pragma unroll
        for (int w = 0; w < 8; ++w) ngt += ctab[j * 8 + w] & 0xffffu;
    const unsigned need = (unsigned)CAP - ngt;
    unsigned base_gt = 0, base_eq = 0;
#pragma unroll
    for (int j = 0; j < 16; ++j) {
        const bool gt = bits[j] > tau, eq = bits[j] == tau;
        const unsigned long long bg = __ballot(gt), be = __ballot(eq);
        unsigned pgt = 0, peq = 0, tgt = 0, teq = 0;
#pragma unroll
        for (int w = 0; w < 8; ++w) { const unsigned cw = ctab[j * 8 + w], cg_ = cw & 0xffffu, ce = cw >> 16; if (w < wave) { pgt += cg_; peq += ce; } tgt += cg_; teq += ce; }
        const unsigned gt_before = base_gt + pgt + (unsigned)__popcll(bg & lt_mask), eq_before = base_eq + peq + (unsigned)__popcll(be & lt_mask);
        const bool sel = gt || (eq && eq_before < need);
        const unsigned slot = gt_before + (eq_before < need ? eq_before : need);
        const int i = j * 512 + tid;
        if (sel) { IDX[(e * 8 + b) * CAP + slot] = i; GSEL[(e * 8 + b) * CAP + slot] = __uint_as_float(bits[j]); }
        INV[((size_t)b * 8192 + i) * 16 + e] = sel ? (int)slot : -1;
        base_gt += tgt; base_eq += teq;
    }
    __syncthreads();
}
__device__ __forceinline__ void ph8(const Params& p, unsigned char* lds, int bid, int nblk) { for (int it = bid; it < 128; it += nblk) topk_item(p, lds, it); }


#define XB_TMO      128
#define XB_XCNT(j)  (256  + 64 * (j))
#define XB_XSUB(j)  (1280 + 64 * (j))
#define XB_XGEN(j)  (2304 + 64 * (j))
#define XB_TOP      3328
#define XB_TOPGEN   3392
#define XCD_BAR_WORDS 3456
#define XB_SPIN_CAP (1u << 18)
__device__ __forceinline__ unsigned xb_ld(unsigned* p)              { return __hip_atomic_load(p, __ATOMIC_RELAXED, __HIP_MEMORY_SCOPE_AGENT); }
__device__ __forceinline__ unsigned xb_add(unsigned* p, unsigned v) { return __hip_atomic_fetch_add(p, v, __ATOMIC_RELAXED, __HIP_MEMORY_SCOPE_AGENT); }
__device__ __forceinline__ unsigned xb_xcc_id() { return (unsigned)__builtin_amdgcn_s_getreg((3 << 11) | 20) & 0xFu; }
#define XB_SPIN(cond, bar) do { unsigned _sp = 0; while (cond) { __builtin_amdgcn_s_sleep(1); \
    if ((++_sp & 255u) == 0u) { if (xb_ld(&(bar)[XB_TMO])) break; if (_sp > XB_SPIN_CAP) { atomicAdd(&(bar)[XB_TMO], 1u); break; } } } } while (0)
struct XcdBarrier { unsigned* bar; unsigned x; volatile LAS unsigned* st; };
__device__ __forceinline__ XcdBarrier xcd_barrier_post(unsigned* bar, volatile LAS unsigned* st) {
    XcdBarrier b; b.bar = bar; b.x = xb_xcc_id(); b.st = st;
    if (threadIdx.x == 0) (void)xb_add(&bar[XB_XCNT(b.x)], 1u);
    return b;
}
__device__ __forceinline__ void xcd_barrier_complete(unsigned* bar, unsigned x, unsigned& nloc, unsigned& nx) {
    const unsigned G = gridDim.x * gridDim.y * gridDim.z;
    unsigned sum, cnt, mine, sp = 0u;
    for (;;) {
        sum = 0u; cnt = 0u; mine = 0u;
#pragma unroll
        for (unsigned j = 0; j < 16; ++j) { const unsigned c = xb_ld(&bar[XB_XCNT(j)]); sum += c; cnt += (c > 0u) ? 1u : 0u; mine = (j == x) ? c : mine; }
        if (sum == G) break;
        __builtin_amdgcn_s_sleep(1);
        if ((++sp & 255u) == 0u) { if (xb_ld(&bar[XB_TMO])) break; if (sp > XB_SPIN_CAP) { atomicAdd(&bar[XB_TMO], 1u); break; } }
    }
    nloc = mine > 0u ? mine : 1u; nx = cnt > 0u ? cnt : 1u;
}
__device__ __forceinline__ void xcd_barrier(const XcdBarrier& b) {
    asm volatile("s_waitcnt vmcnt(0)" ::: "memory");
    __syncthreads();
    if (threadIdx.x == 0) {
        unsigned* bar = b.bar;
        __builtin_amdgcn_s_waitcnt(0);
        unsigned nloc = b.st[0], nx = b.st[1];
        if (nloc == 0u) { xcd_barrier_complete(bar, b.x, nloc, nx); b.st[0] = nloc; b.st[1] = nx; }
        const unsigned old = xb_add(&bar[XB_XSUB(b.x)], 1u);
        const unsigned gen = old / nloc;
        if (old + 1u == (gen + 1u) * nloc) {
            __builtin_amdgcn_fence(__ATOMIC_RELEASE, "agent");
            asm volatile("s_waitcnt vmcnt(0)" ::: "memory");
            const unsigned og = xb_add(&bar[XB_TOP], 1u);
            const unsigned tg = og / nx;
            if (og + 1u == (tg + 1u) * nx) xb_add(&bar[XB_TOPGEN], 1u);
            else XB_SPIN(xb_ld(&bar[XB_TOPGEN]) == tg, bar);
            __builtin_amdgcn_fence(__ATOMIC_ACQUIRE, "agent");
            xb_add(&bar[XB_XGEN(b.x)], 1u);
            asm volatile("s_waitcnt vmcnt(0)" ::: "memory");
        } else {
            XB_SPIN(xb_ld(&bar[XB_XGEN(b.x)]) == gen, bar);
            __builtin_amdgcn_fence(__ATOMIC_ACQUIRE, "agent");
            asm volatile("s_waitcnt vmcnt(0)" ::: "memory");
        }
    }
    __syncthreads();
}

__device__ __forceinline__ pg8::GemmDesc make_desc(const Params& p, int gi) {
    pg8::GemmDesc g{};
    if (gi == 0) { g.A = p.ws + WS_XM; g.Bt = p.ws + WS_WINT; g.O = p.ws + WS_U; g.Kb = 2048; g.nM = MROWS / 256; g.nN = DINP / 256; g.epi = 0; g.ldc = DINP; g.qtiles = 2; }
    else if (gi == 1) { g.A = p.ws + WS_MIX; g.Bt = p.ws + WS_WOUTG; g.bEstride = (size_t)D_ * D_ * 2; g.O = p.ws + WS_Y; g.x = p.x; g.Kb = 2048; g.nM = NLAT / 256; g.nN = 4; g.epi = 2; g.ldc = 1024; }
    else if (gi == 2) { g.A = p.ws + WS_HMOD; g.Bt = p.ws + WS_WGUT; g.IDX = (const int*)(p.ws + WS_IDX); g.O = p.ws + WS_ACT; g.bEstride = (size_t)2 * DFF * 1024; g.Kb = 1024; g.nM = NE * 32; g.nN = 22; g.epi = 1; g.ldc = DFF; }
    else { g.A = p.ws + WS_ACT; g.Bt = p.ws + WS_WDT; g.O = p.ws + WS_EO; g.bEstride = (size_t)1024 * DFF; g.Kb = DFF; g.nM = NE * 32; g.nN = 4; g.epi = 3; g.ldc = 1024; }
    return g;
}

__device__ __forceinline__ void ph_final(const Params& p, int bid, int nblk) {
    const int tid = ltid(), lane = tid & 63, wave = tid >> 6;
    const GAS float* MOD = (const GAS float*)(p.ws + WS_MOD); const GAS bf16_t* EO = (const GAS bf16_t*)(p.ws + WS_EO); const GAS float* GSEL = (const GAS float*)(p.ws + WS_GSEL); const GAS int* INV = (const GAS int*)(p.ws + WS_INV);
    const GAS bf16_t* Y = (const GAS bf16_t*)(p.ws + WS_Y); GAS float* OUT = (GAS float*)p.out; const GAS float* ln1g = (const GAS float*)p.ln1_g; const GAS float* ln1b = (const GAS float*)p.ln1_b; const GAS float* ln2g = (const GAS float*)p.ln2_g; const GAS float* ln2b = (const GAS float*)p.ln2_b;
    constexpr int NPF = 3;
    const int mstride = nblk * NWAVES;
    int m = bid * NWAVES + wave;
    u32x2 vn[4]; int inv1 = -1, inv2 = -1;
    u32x2 pe[NPF][4]; float pg[NPF];
#define FIN_PREFETCH(row_, inv_) do { unsigned _em = (unsigned)__ballot((inv_) >= 0); const int _bb = (row_) >> 13; \
        _Pragma("unroll") for (int _t = 0; _t < NPF; ++_t) { \
            if (_em) { const int _e = __builtin_ctz(_em); _em &= _em - 1u; const int _slot = __builtin_amdgcn_readlane((inv_), _e); \
                pg[_t] = GSEL[(_e * 8 + _bb) * CAP + _slot]; const GAS bf16_t* _rp = EO + ((size_t)_e * 8192 + _bb * 1024 + _slot) * 1024; \
                _Pragma("unroll") for (int j = 0; j < 4; ++j) pe[_t][j] = *(const GAS u32x2*)(_rp + j * 256 + lane * 4); } \
            else { pg[_t] = 0.f; _Pragma("unroll") for (int j = 0; j < 4; ++j) pe[_t][j] = (u32x2){0u, 0u}; } } } while (0)
    f32x4 pg1[4], pb1[4], pg2[4], pb2[4], pgg[4]; int bcur = -1;
#pragma unroll
    for (int j = 0; j < 4; ++j) { const int k = j * 256 + lane * 4; pg1[j] = *(const GAS f32x4*)(ln1g + k); pb1[j] = *(const GAS f32x4*)(ln1b + k); pg2[j] = *(const GAS f32x4*)(ln2g + k); pb2[j] = *(const GAS f32x4*)(ln2b + k); pgg[j] = pg1[j]; }
    if (m < NLAT) { inv1 = lane < 16 ? INV[(size_t)m * 16 + lane] : -1;
#pragma unroll
        for (int j = 0; j < 4; ++j) vn[j] = *(const GAS u32x2*)(Y + (size_t)m * 1024 + j * 256 + lane * 4);
        if (m + mstride < NLAT) inv2 = lane < 16 ? INV[(size_t)(m + mstride) * 16 + lane] : -1;
        FIN_PREFETCH(m, inv1); }
    for (; m < NLAT; m += mstride) {
        const int b = m >> 13;
        GAS float* y = OUT + (size_t)m * 1024; const GAS float* g2 = MOD + b * 6144 + 5120;
        if (b != bcur) { bcur = b;
#pragma unroll
            for (int j = 0; j < 4; ++j) pgg[j] = *(const GAS f32x4*)(g2 + j * 256 + lane * 4); }
        const int myinv = inv1;
        f32x4 v[4]; float s = 0.f;
#pragma unroll
        for (int j = 0; j < 4; ++j) { v[j] = (f32x4){hlo(vn[j].x), hhi(vn[j].x), hlo(vn[j].y), hhi(vn[j].y)}; s += (v[j].x + v[j].y) + (v[j].z + v[j].w); }
        f32x4 moe[4];
#pragma unroll
        for (int j = 0; j < 4; ++j) moe[j] = (f32x4){0.f, 0.f, 0.f, 0.f};
        unsigned emask = (unsigned)__ballot(myinv >= 0);
#pragma unroll
        for (int t = 0; t < NPF; ++t) { if (emask) { emask &= emask - 1u; const float g = pg[t];
#pragma unroll
            for (int j = 0; j < 4; ++j) { const u32x2 w = pe[t][j]; moe[j].x += g * bflo(w.x); moe[j].y += g * bfhi(w.x); moe[j].z += g * bflo(w.y); moe[j].w += g * bfhi(w.y); } } }
        { const int mn = m + mstride; inv1 = inv2;
          if (mn < NLAT) {
#pragma unroll
              for (int j = 0; j < 4; ++j) vn[j] = *(const GAS u32x2*)(Y + (size_t)mn * 1024 + j * 256 + lane * 4);
              inv2 = (mn + mstride < NLAT && lane < 16) ? INV[(size_t)(mn + mstride) * 16 + lane] : -1;
              FIN_PREFETCH(mn, inv1); } }
        while (emask) {
            const int e = __builtin_ctz(emask); emask &= emask - 1u;
            const int slot = __builtin_amdgcn_readlane(myinv, e);
            const float g = GSEL[(e * 8 + b) * CAP + slot];
            const GAS bf16_t* row = EO + ((size_t)e * 8192 + b * 1024 + slot) * 1024;
#pragma unroll
            for (int j = 0; j < 4; ++j) { const u32x2 w = *(const GAS u32x2*)(row + j * 256 + lane * 4); moe[j].x += g * bflo(w.x); moe[j].y += g * bfhi(w.x); moe[j].z += g * bflo(w.y); moe[j].w += g * bfhi(w.y); }
        }
        const float mean = wave_sum(s) * (1.f / 1024.f); float s2 = 0.f;
#pragma unroll
        for (int j = 0; j < 4; ++j) { v[j] = v[j] - mean; s2 += (v[j].x * v[j].x + v[j].y * v[j].y) + (v[j].z * v[j].z + v[j].w * v[j].w); }
        const float rstd = rsqrtf(wave_sum(s2) * (1.f / 1024.f) + LN_EPS);
        float s3 = 0.f;
#pragma unroll
        for (int j = 0; j < 4; ++j) { v[j] = ALPHA * (v[j] * rstd * pg1[j] + pb1[j]) + pgg[j] * moe[j]; s3 += (v[j].x + v[j].y) + (v[j].z + v[j].w); }
        const float mean2 = wave_sum(s3) * (1.f / 1024.f); float s4 = 0.f;
#pragma unroll
        for (int j = 0; j < 4; ++j) { v[j] = v[j] - mean2; s4 += (v[j].x * v[j].x + v[j].y * v[j].y) + (v[j].z * v[j].z + v[j].w * v[j].w); }
        const float rstd2 = rsqrtf(wave_sum(s4) * (1.f / 1024.f) + LN_EPS);
#pragma unroll
        for (int j = 0; j < 4; ++j) { const int k = j * 256 + lane * 4; __builtin_nontemporal_store(v[j] * rstd2 * pg2[j] + pb2[j], (GAS f32x4*)(y + k)); }
    }
}

constexpr int NPHASE = 12;
#ifndef ONLY_PH
#define ONLY_PH -1
#endif
#define PH_EN(n) (ONLY_PH < 0 || ONLY_PH == (n))
__global__ void __launch_bounds__(NTHR, 2) mk_fwd(Params p) {
    extern __shared__ __attribute__((aligned(16))) unsigned char lds[];
    const int bid = blockIdx.x, nblk = gridDim.x;
    volatile LAS unsigned* MISC = (volatile LAS unsigned*)((LAS unsigned char*)lds + (LDS_BYTES - 16));
    if (threadIdx.x < 4) MISC[threadIdx.x] = 0u;
    __syncthreads();
    const XcdBarrier xbar = xcd_barrier_post((unsigned*)(p.ws + WS_CTL) + 4096, MISC);
#ifndef PHMASK
#define PHMASK 0xffff
#endif
#define IN(k) ((((PHMASK) >> (k)) & 1) && p.ph_lo <= (k) && (k) < p.ph_hi)
#define LOADP() load_params()
#define LAUNDER() const int bid_ = bid, nblk_ = nblk; unsigned char* const lds_ = lds
#define SEAM(k) do { if (IN(k) && IN((k) + 1)) xcd_barrier(xbar); } while (0)
    if (IN(0)) for (int rep_ = 0; rep_ < REPN(0); ++rep_) { const Params q = LOADP(); LAUNDER(); ph0(q, lds_, bid_, nblk_); }
    SEAM(0);
    if (IN(1)) for (int rep_ = 0; rep_ < REPN(1); ++rep_) { const Params q = LOADP(); LAUNDER(); ph1(q, bid_, nblk_); }
    SEAM(1);
    if (IN(2)) for (int rep_ = 0; rep_ < REPN(2); ++rep_) { const Params q = load_params_s(); LAUNDER(); const pg8::GemmDesc g = make_desc(q, 0); pg8::gemm_phase<false, false>((LAS unsigned char*)lds, g, nblk_, bid_); }
    SEAM(2);
    if (IN(3)) for (int rep_ = 0; rep_ < REPN(3); ++rep_) { const Params q = LOADP(); LAUNDER(); ph3(q, lds_, bid_, nblk_); }
    SEAM(3);
    if (IN(4)) for (int rep_ = 0; rep_ < REPN(4); ++rep_) { const Params q = LOADP(); LAUNDER(); ph4(q, bid_, nblk_); }
    SEAM(4);
    if (IN(5)) for (int rep_ = 0; rep_ < REPN(5); ++rep_) { const Params q = LOADP(); LAUNDER(); ph5(q, lds_, bid_, nblk_); }
    SEAM(5);
    if (IN(6)) for (int rep_ = 0; rep_ < REPN(6); ++rep_) { const Params q = load_params_s(); LAUNDER(); const int grp_ = (bid_ >> 5) & 1;
        if (grp_ == 0) ph7_conv(q, lds_, bid_, nblk_);
        { const pg8::GemmDesc g = make_desc(q, 1); pg8::gemm_phase<false, false>((LAS unsigned char*)lds, g, nblk_, bid_); }
        if (grp_ != 0) { const Params q2 = LOADP(); ph7_conv(q2, lds_, bid_, nblk_); } }
    SEAM(6);
    if (IN(7)) for (int rep_ = 0; rep_ < REPN(7); ++rep_) { const Params q = LOADP(); LAUNDER(); ph7(q, lds_, bid_, nblk_); }
    SEAM(7);
    if (IN(8)) for (int rep_ = 0; rep_ < REPN(8); ++rep_) { const Params q = LOADP(); LAUNDER(); ph8(q, lds_, bid_, nblk_); }
    SEAM(8);
#pragma unroll 1
    for (int st = 2; st < 4; ++st) {
        if (IN(7 + st)) for (int rep_ = 0; rep_ < REPN(9); ++rep_) { const Params q = load_params_s(); LAUNDER(); const pg8::GemmDesc g = make_desc(q, st); pg8::gemm_phase<true, true>((LAS unsigned char*)lds, g, nblk_, bid_); }
        SEAM(7 + st);
    }
    if (IN(11)) for (int rep_ = 0; rep_ < REPN(11); ++rep_) { const Params q = LOADP(); LAUNDER(); ph_final(q, bid_, nblk_); }
#undef IN
#undef SEAM
}

extern "C" void kernel_launch(void* const* d_in, const int* in_sizes, int n_in, void* d_out, int out_size, void* d_ws, size_t ws_size, hipStream_t stream) {
    static int grid_blocks = 0;
    if (grid_blocks == 0) {
        if (n_in != 20 || out_size != NLAT * D_ || ws_size < WS_WOUTG + (size_t)NB * D_ * D_ * 2 || ws_size < WS_END) { fprintf(stderr, "kernel_launch: unexpected shapes (n_in %d out %d ws %zu need %zu)\n", n_in, out_size, ws_size, (size_t)WS_END); grid_blocks = -1; return; }
        int dev = 0, cus = 0, per_cu = 0;
        if (hipGetDevice(&dev) != hipSuccess || hipDeviceGetAttribute(&cus, hipDeviceAttributeMultiprocessorCount, dev) != hipSuccess) { grid_blocks = -1; return; }
        if (hipFuncSetAttribute((const void*)mk_fwd, hipFuncAttributeMaxDynamicSharedMemorySize, LDS_BYTES) != hipSuccess) { fprintf(stderr, "kernel_launch: hipFuncSetAttribute failed\n"); grid_blocks = -1; return; }
        if (hipOccupancyMaxActiveBlocksPerMultiprocessor(&per_cu, (const void*)mk_fwd, NTHR, LDS_BYTES) != hipSuccess || per_cu < 1) { fprintf(stderr, "kernel_launch: occupancy query failed (%d)\n", per_cu); grid_blocks = -1; return; }
        grid_blocks = cus * per_cu;
    }
    if (grid_blocks < 0) return;
    if (hipMemsetAsync((char*)d_ws + WS_CTL, 0, 65536, stream) != hipSuccess) { fprintf(stderr, "kernel_launch: hipMemsetAsync failed\n"); return; }
    Params p{};
    const float** pp = (const float**)&p;
    for (int i = 0; i < 20; ++i) pp[i] = (const float*)d_in[i];
    p.out = (float*)d_out; p.ws = (unsigned char*)d_ws;
    p.ph_lo = 0; p.ph_hi = NPHASE;
    void* args[] = {&p};
    hipError_t e = hipLaunchCooperativeKernel((const void*)mk_fwd, dim3(grid_blocks), dim3(NTHR), args, LDS_BYTES, stream);
    if (e != hipSuccess) fprintf(stderr, "cooperative launch failed: %s (grid %d)\n", hipGetErrorString(e), grid_blocks);
}
```

```cpp
#include <hip/hip_runtime.h>
#include <hip/hip_cooperative_groups.h>
#include <cstdio>
#include <cstdint>
namespace cg = cooperative_groups;
#ifndef REPMASK
#define REPMASK 0
#endif
#define REPN(k) ((((REPMASK) >> (k)) & 1) ? 2 : 1)

typedef unsigned short bf16_t;
#define GAS __attribute__((address_space(1)))
typedef float f32x4 __attribute__((ext_vector_type(4)));
typedef unsigned u32x4 __attribute__((ext_vector_type(4)));
typedef unsigned u32x2 __attribute__((ext_vector_type(2)));

constexpr int NB = 8, T_ = 8192, D_ = 1024, LC = 256;
constexpr int NLAT = NB * T_, NCTX = NB * LC, MROWS = NLAT + NCTX;
constexpr int DIN = 3088, DINP = 3328;
constexpr int NE = 16, CAP = 1024, DFF = 2816;
constexpr int C_QA = 0, C_KA = 512, C_VA = 1024, C_QM = 1536, C_KM = 1792, C_VM = 2048, C_OM = 2560, C_GT = 3072;
constexpr int NCH = 66;
constexpr float LN_EPS = 1e-5f;
constexpr float ALPHA = 1.189207115002721f;
constexpr int NGROUPS = 1, EPG = NE / NGROUPS;

constexpr int NTHR = 512, NWAVES = 8;
constexpr int LDS_BYTES = 163840;

constexpr size_t MiB = 1u << 20;
constexpr size_t WS_CTL = 0;
constexpr size_t WS_MOD = 1 * MiB;
constexpr size_t WS_ROPE = 1 * MiB + 256 * 1024;
constexpr size_t WS_BLAST = 1 * MiB + 512 * 1024;
constexpr size_t WS_MLOC = WS_BLAST + 32 * 1024;
constexpr size_t WS_MIN = WS_MLOC + 32 * 1024;
constexpr size_t WS_NLOC = 2 * MiB;
constexpr size_t WS_IDX = 4 * MiB;
constexpr size_t WS_GSEL = 4 * MiB + 512 * 1024;
constexpr size_t WS_AFF = 5 * MiB;
constexpr size_t WS_INV = 9 * MiB;
constexpr size_t WS_WINT = 16 * MiB;
constexpr size_t WS_WOUTT = 23 * MiB;
constexpr size_t WS_XM = 32 * MiB;
constexpr size_t WS_U = 164 * MiB;
constexpr size_t WS_QP = 593 * MiB;
constexpr size_t WS_KP = 625 * MiB;
constexpr size_t WS_CLOC = 658 * MiB;
constexpr size_t WS_MIX = 32 * MiB;
constexpr size_t WS_WOUTG = 948 * MiB;
constexpr size_t WS_Y = 820 * MiB;
constexpr size_t WS_HMOD = 16 * MiB;
constexpr size_t WS_WGUT = 688 * MiB;
constexpr size_t WS_WDT = 964 * MiB;
constexpr size_t WS_EO = 80 * MiB;
constexpr size_t WS_ACT = 336 * MiB;
constexpr size_t WS_END = WS_WGUT + (size_t)NE * 2 * DFF * D_;
static_assert(WS_XM + (size_t)MROWS * D_ * 2 <= WS_U, "map");
static_assert(WS_U + (size_t)MROWS * DINP * 2 <= WS_QP, "map");
static_assert(WS_KP + (size_t)MROWS * 256 * 2 <= WS_CLOC, "map");
static_assert(WS_CLOC + (size_t)64 * NCH * 8192 * 4 <= WS_Y, "map");
static_assert(WS_MIX + (size_t)NLAT * D_ * 2 <= WS_U, "map");
static_assert(WS_Y + (size_t)NLAT * D_ * 2 <= WS_WOUTG && WS_WOUTG + (size_t)NB * D_ * D_ * 2 <= 1024 * MiB, "map");
static_assert(WS_HMOD + (size_t)NLAT * D_ <= WS_EO && WS_EO + (size_t)NE * 8192 * D_ * 2 <= WS_ACT, "map");
static_assert(WS_ACT + (size_t)NE * 8192 * DFF <= WS_WGUT && WS_WOUTG + (size_t)NB * D_ * D_ * 2 <= WS_WDT && WS_WDT + (size_t)NE * D_ * DFF <= 1024 * MiB, "map");
static_assert(WS_MIX + (size_t)NLAT * D_ * 2 <= WS_WGUT && WS_CLOC <= WS_WGUT, "map");
static_assert(WS_END <= WS_Y, "map");

struct Params {
    const float *x, *c, *ctx, *c_ctx, *w_ada, *b_ada, *w_in, *b_gate, *conv_qk, *na_bias, *ml_norm_g, *w_out,
        *ln1_g, *ln1_b, *w_router, *w_eg, *w_eu, *w_ed, *ln2_g, *ln2_b;
    float* out; unsigned char* ws;
    int ph_lo, ph_hi;
};


template <class T> __device__ __forceinline__ T* as_global(T* p) { return (T*)(__attribute__((address_space(1))) T*)p; }
__device__ __forceinline__ Params load_params_s() {
    const Params* kp = (const Params*)__builtin_amdgcn_kernarg_segment_ptr(); asm volatile("" : "+s"(kp));
    const __attribute__((address_space(4))) unsigned long long* kc = (const __attribute__((address_space(4))) unsigned long long*)(unsigned long long)kp;
    Params q;
    q.x = (const float*)kc[0]; q.c = (const float*)kc[1]; q.ctx = (const float*)kc[2]; q.c_ctx = (const float*)kc[3]; q.w_ada = (const float*)kc[4]; q.b_ada = (const float*)kc[5]; q.w_in = (const float*)kc[6];
    q.b_gate = (const float*)kc[7]; q.conv_qk = (const float*)kc[8]; q.na_bias = (const float*)kc[9]; q.ml_norm_g = (const float*)kc[10]; q.w_out = (const float*)kc[11];
    q.ln1_g = (const float*)kc[12]; q.ln1_b = (const float*)kc[13]; q.w_router = (const float*)kc[14]; q.w_eg = (const float*)kc[15]; q.w_eu = (const float*)kc[16]; q.w_ed = (const float*)kc[17];
    q.ln2_g = (const float*)kc[18]; q.ln2_b = (const float*)kc[19]; q.out = (float*)kc[20]; q.ws = (unsigned char*)kc[21];
    { const unsigned long long ph = kc[22]; q.ph_lo = (int)(unsigned)ph; q.ph_hi = (int)(unsigned)(ph >> 32); }
    q.x = as_global(q.x); q.c = as_global(q.c); q.ctx = as_global(q.ctx); q.c_ctx = as_global(q.c_ctx); q.w_ada = as_global(q.w_ada); q.b_ada = as_global(q.b_ada); q.w_in = as_global(q.w_in);
    q.b_gate = as_global(q.b_gate); q.conv_qk = as_global(q.conv_qk); q.na_bias = as_global(q.na_bias); q.ml_norm_g = as_global(q.ml_norm_g); q.w_out = as_global(q.w_out);
    q.ln1_g = as_global(q.ln1_g); q.ln1_b = as_global(q.ln1_b); q.w_router = as_global(q.w_router); q.w_eg = as_global(q.w_eg); q.w_eu = as_global(q.w_eu); q.w_ed = as_global(q.w_ed);
    q.ln2_g = as_global(q.ln2_g); q.ln2_b = as_global(q.ln2_b); q.out = as_global(q.out); q.ws = as_global(q.ws);
    return q;
}
__device__ __forceinline__ Params load_params() {
    const Params* kp = (const Params*)__builtin_amdgcn_kernarg_segment_ptr(); asm volatile("" : "+s"(kp));
    Params q = *kp;
    q.x = as_global(q.x); q.c = as_global(q.c); q.ctx = as_global(q.ctx); q.c_ctx = as_global(q.c_ctx); q.w_ada = as_global(q.w_ada); q.b_ada = as_global(q.b_ada); q.w_in = as_global(q.w_in);
    q.b_gate = as_global(q.b_gate); q.conv_qk = as_global(q.conv_qk); q.na_bias = as_global(q.na_bias); q.ml_norm_g = as_global(q.ml_norm_g); q.w_out = as_global(q.w_out);
    q.ln1_g = as_global(q.ln1_g); q.ln1_b = as_global(q.ln1_b); q.w_router = as_global(q.w_router); q.w_eg = as_global(q.w_eg); q.w_eu = as_global(q.w_eu); q.w_ed = as_global(q.w_ed);
    q.ln2_g = as_global(q.ln2_g); q.ln2_b = as_global(q.ln2_b); q.out = as_global(q.out); q.ws = as_global(q.ws);
    return q;
}
__device__ __forceinline__ float bf2f(bf16_t v) { return __uint_as_float((unsigned)v << 16); }
__device__ __forceinline__ unsigned f2bf(float f) { unsigned u = __float_as_uint(f); return (u + 0x7fffu + ((u >> 16) & 1u)) >> 16; }
__device__ __forceinline__ unsigned pk2(float lo, float hi) { return f2bf(lo) | (f2bf(hi) << 16); }
__device__ __forceinline__ float bflo(unsigned w) { return __uint_as_float(w << 16); }
__device__ __forceinline__ float bfhi(unsigned w) { return __uint_as_float(w & 0xffff0000u); }
typedef _Float16 f16x2 __attribute__((ext_vector_type(2)));
typedef float f32x2_ __attribute__((ext_vector_type(2)));
__device__ __forceinline__ unsigned pk_f16(float lo, float hi) {
    const f32x2_ v = {__builtin_amdgcn_fmed3f(lo, -65504.f, 65504.f), __builtin_amdgcn_fmed3f(hi, -65504.f, 65504.f)};
    const f16x2 h = __builtin_convertvector(v, f16x2); return __builtin_bit_cast(unsigned, h); }
__device__ __forceinline__ f32x2_ h2f(unsigned w) { return __builtin_convertvector(__builtin_bit_cast(f16x2, w), f32x2_); }
__device__ __forceinline__ float hlo(unsigned w) { const f16x2 h = __builtin_bit_cast(f16x2, w); return (float)h.x; }
__device__ __forceinline__ float hhi(unsigned w) { const f16x2 h = __builtin_bit_cast(f16x2, w); return (float)h.y; }
template <int CTRL> __device__ __forceinline__ float dpp_mov(float v) { return __int_as_float(__builtin_amdgcn_update_dpp(0, __float_as_int(v), CTRL, 0xF, 0xF, true)); }
__device__ __forceinline__ float lane_bcast(float v, int l) { return __int_as_float(__builtin_amdgcn_readlane(__float_as_int(v), l)); }
__device__ __forceinline__ float wave_sum(float v) {
    v += dpp_mov<0xB1>(v);
    v += dpp_mov<0x4E>(v);
    v += dpp_mov<0x141>(v);
    v += dpp_mov<0x140>(v);
    return (lane_bcast(v, 0) + lane_bcast(v, 16)) + (lane_bcast(v, 32) + lane_bcast(v, 48));
}
__device__ __forceinline__ float wave_max(float v) {
    v = fmaxf(v, dpp_mov<0xB1>(v)); v = fmaxf(v, dpp_mov<0x4E>(v)); v = fmaxf(v, dpp_mov<0x141>(v)); v = fmaxf(v, dpp_mov<0x140>(v));
    return fmaxf(fmaxf(lane_bcast(v, 0), lane_bcast(v, 16)), fmaxf(lane_bcast(v, 32), lane_bcast(v, 48)));
}

__device__ __forceinline__ float wscan_add(float v, int lane) {
#pragma unroll
    for (int o = 1; o < 64; o <<= 1) { const float t = __shfl_up(v, o); if (lane >= o) v += t; }
    return v;
}
__device__ __forceinline__ float wscan_max(float v, int lane) {
#pragma unroll
    for (int o = 1; o < 64; o <<= 1) { const float t = __shfl_up(v, o); if (lane >= o) v = fmaxf(v, t); }
    return v;
}
typedef short bf16x8_t __attribute__((ext_vector_type(8)));
typedef short bf16x4_t __attribute__((ext_vector_type(4)));
typedef float f32x2_t __attribute__((ext_vector_type(2)));
typedef __bf16 bf16x2_t __attribute__((ext_vector_type(2)));
__device__ __forceinline__ unsigned cvtpk(float lo, float hi) { const f32x2_t v = {lo, hi}; const bf16x2_t b = __builtin_convertvector(v, bf16x2_t); return __builtin_bit_cast(unsigned, b); }
__device__ __forceinline__ float siluf(float v) { return v * __builtin_amdgcn_rcpf(1.f + __expf(-v)); }
__device__ __forceinline__ float sigmoidf_(float v) { return __builtin_amdgcn_rcpf(1.f + __expf(-v)); }
__device__ __forceinline__ float logsigf(float v) { return fminf(v, 0.f) - log1pf(__expf(-fabsf(v))); }
__device__ __forceinline__ int ltid() { int t = threadIdx.x; asm volatile("" : "+v"(t)); return t; }
#define FP8EMU 0
__device__ __forceinline__ float q8(float x) { const int p = __builtin_amdgcn_cvt_pk_fp8_f32(x, x, 0, false); return __builtin_amdgcn_cvt_f32_fp8(p, 0); }
__device__ __forceinline__ unsigned pk4_fp8(float a, float b, float c, float d) { int w = __builtin_amdgcn_cvt_pk_fp8_f32(a, b, 0, false); w = __builtin_amdgcn_cvt_pk_fp8_f32(c, d, w, true); return (unsigned)w; }
#define LDS_FENCE() asm volatile("s_waitcnt lgkmcnt(0)" ::: "memory")

__device__ __forceinline__ void ph_ada_item(const Params& p, unsigned char* lds, int item) {
    float* sc = (float*)lds;
    float* red = sc + 9 * 1024;
    const int tid = ltid();
    float* MOD = (float*)(p.ws + WS_MOD);
    for (int i = tid; i < 9 * 1024; i += NTHR) { const int r = i >> 10, k = i & 1023; const float v = r < 8 ? p.c[r * 1024 + k] : p.c_ctx[k]; sc[i] = v / (1.f + expf(-v)); }
    __syncthreads();
    const int col = item * 64 + (tid & 63), ks = tid >> 6;
    float acc[9];
#pragma unroll
    for (int r = 0; r < 9; ++r) acc[r] = 0.f;
    { const GAS float* wa = (const GAS float*)p.w_ada + col;
      for (int k = ks * 128; k < ks * 128 + 128; k += 64) {
          float w[64];
#pragma unroll
          for (int u = 0; u < 64; ++u) w[u] = __builtin_nontemporal_load(wa + (size_t)(k + u) * 6144);
#pragma unroll
          for (int u = 0; u < 64; ++u)
#pragma unroll
              for (int r = 0; r < 9; ++r) acc[r] += sc[r * 1024 + k + u] * w[u];
      } }
#pragma unroll
    for (int r = 0; r < 9; ++r) red[(ks * 64 + (tid & 63)) * 9 + r] = acc[r];
    __syncthreads();
    if (tid < 64) {
#pragma unroll
        for (int r = 0; r < 9; ++r) { float s = p.b_ada[col]; for (int k2 = 0; k2 < 8; ++k2) s += red[(k2 * 64 + tid) * 9 + r]; MOD[r * 6144 + col] = s; }
    }
    __syncthreads();
}
__device__ __forceinline__ void transpose_item(const float* W, int N, int k0, int n0, int nvalid, bf16_t* WT, size_t orow0, int ldt, float* scr, int lane) {
#pragma unroll 8
    for (int i = 0; i < 32; ++i) { const int kk = 2 * i + (lane >> 5), nn = lane & 31; scr[kk * 33 + nn] = nn < nvalid ? W[(size_t)(k0 + kk) * N + n0 + nn] : 0.f; }
    LDS_FENCE();
    const int c = lane & 7;
#pragma unroll
    for (int j = 0; j < 4; ++j) {
        const int n = (lane >> 3) + 8 * j; const float* s = scr + (8 * c) * 33 + n;
        u32x4 o; o.x = pk2(s[0 * 33], s[1 * 33]); o.y = pk2(s[2 * 33], s[3 * 33]); o.z = pk2(s[4 * 33], s[5 * 33]); o.w = pk2(s[6 * 33], s[7 * 33]);
        *(u32x4*)(WT + (orow0 + n) * ldt + k0 + 8 * c) = o;
    }
    LDS_FENCE();
}
__device__ __forceinline__ void ph0(const Params& p, unsigned char* lds, int bid, int nblk) {
    __syncthreads();
    for (int it = bid; it < 96; it += nblk) ph_ada_item(p, lds, it);
    const int tid = ltid(), lane = tid & 63, wave = tid >> 6;
    float* scr = (float*)lds + wave * (64 * 33);
    bf16_t* WINT = (bf16_t*)(p.ws + WS_WINT); bf16_t* WOUTT = (bf16_t*)(p.ws + WS_WOUTT);
    const bool split = nblk >= 96 + 64;
    const int gw = split ? (bid - 96) * NWAVES + wave : bid * NWAVES + wave, ngw = split ? (nblk - 96) * NWAVES : nblk * NWAVES;
    constexpr int I_IN = 16 * 97, I_OUT = 16 * 32;
    for (int it = (split && bid < 96) ? I_IN + I_OUT : gw; it < I_IN + I_OUT; it += ngw) {
        if (it < I_IN) { const int kb = it / 97, nb = it % 97; const int n0 = nb * 32; const int nv = (DIN - n0) < 32 ? (DIN - n0) : 32; transpose_item(p.w_in, DIN, kb * 64, n0, nv, WINT, (size_t)n0, 1024, scr, lane); }
        else { const int r = it - I_IN; const int kb = r / 32, nb = r % 32; transpose_item(p.w_out, 1024, kb * 64, nb * 32, 32, WOUTT, (size_t)nb * 32, 1024, scr, lane); }
    }
    { float* ROPE = (float*)(p.ws + WS_ROPE); for (int idx = bid * NTHR + tid; idx < 2048; idx += nblk * NTHR) { const int pos = idx >> 4, i = idx & 15;
        const float inv = exp2f(-(float)i * (13.287712379549449f / 16.f)); float sn, cs_; sincosf((float)pos * inv, &sn, &cs_); ROPE[idx * 2] = cs_; ROPE[idx * 2 + 1] = sn; } }
    { const size_t n16 = (size_t)(DINP - 3104) * 1024 * 2 / 16; u32x4* z = (u32x4*)(WINT + (size_t)3104 * 1024);
      for (size_t i = (size_t)bid * NTHR + tid; i < n16; i += (size_t)nblk * NTHR) z[i] = (u32x4){0u, 0u, 0u, 0u}; }
}

__device__ __forceinline__ void ph1(const Params& p, unsigned char* lds, int bid, int nblk) {
    const int tid = ltid(), lane = tid & 63, wave = tid >> 6, r = lane & 15, kq = lane >> 4;
    const GAS float* MOD = (const GAS float*)(p.ws + WS_MOD); GAS bf16_t* XM = (GAS bf16_t*)(p.ws + WS_XM); GAS bf16_t* U = (GAS bf16_t*)(p.ws + WS_U);
    const GAS float* xs = (const GAS float*)p.x; const GAS float* cs = (const GAS float*)p.ctx;
    { const GAS bf16_t* WT = (const GAS bf16_t*)(p.ws + WS_WOUTT); GAS bf16_t* WG = (GAS bf16_t*)(p.ws + WS_WOUTG);
      for (int i = bid * NTHR + tid; i < NB * 1024 * 128; i += nblk * NTHR) { const int b = i >> 17, n = (i >> 7) & 1023, k8 = (i & 127) * 8;
          const float g = MOD[b * 6144 + 2048 + n]; const u32x4 w = *(const GAS u32x4*)(WT + (size_t)n * 1024 + k8); u32x4 o;
          o.x = pk2(g * bflo(w.x), g * bfhi(w.x)); o.y = pk2(g * bflo(w.y), g * bfhi(w.y)); o.z = pk2(g * bflo(w.z), g * bfhi(w.z)); o.w = pk2(g * bflo(w.w), g * bfhi(w.w));
          *(GAS u32x4*)(WG + ((size_t)b * 1024 + n) * 1024 + k8) = o; } }
    { bf16_t* XT = (bf16_t*)lds;
      float* RED = (float*)(XT + 32 * 1032);
      bf16x8_t wf[4];
      { const GAS float* wi = (const GAS float*)p.w_in + C_GT + r;
#pragma unroll
        for (int s2 = 0; s2 < 4; ++s2) { float t8[8];
#pragma unroll
            for (int j = 0; j < 8; ++j) t8[j] = wi[(size_t)(128 * wave + 32 * s2 + 8 * kq + j) * DIN];
            u32x4 w; w.x = cvtpk(t8[0], t8[1]); w.y = cvtpk(t8[2], t8[3]); w.z = cvtpk(t8[4], t8[5]); w.w = cvtpk(t8[6], t8[7]); wf[s2] = __builtin_bit_cast(bf16x8_t, w); } }
      f32x4 sa[4], sb[4]; int bcur = -1;
#pragma unroll
      for (int j = 0; j < 4; ++j) sa[j] = sb[j] = (f32x4){0.f, 0.f, 0.f, 0.f};
#define P1_LOAD(buf, g_) do { const GAS float* _x = xs + (size_t)((g_) * 32 + 4 * wave) * 1024 + lane * 4; _Pragma("unroll") for (int t = 0; t < 16; ++t) buf[t] = __builtin_nontemporal_load((const GAS f32x4*)(_x + (t >> 2) * 1024 + (t & 3) * 256)); } while (0)
#define P1_STEP(buf, g_) do { const int _R0 = (g_) * 32, _b = _R0 >> 13; \
        if (_b != bcur) { bcur = _b; _Pragma("unroll") for (int j = 0; j < 4; ++j) { sb[j] = *(const GAS f32x4*)(MOD + _b * 6144 + j * 256 + lane * 4); sa[j] = *(const GAS f32x4*)(MOD + _b * 6144 + 1024 + j * 256 + lane * 4) + 1.f; } } \
        _Pragma("unroll") for (int t = 0; t < 16; ++t) { const int rr = t >> 2, j = t & 3; const f32x4 h = buf[t] * sa[j] + sb[j]; u32x2 o; o.x = cvtpk(h[0], h[1]); o.y = cvtpk(h[2], h[3]); \
            *(GAS u32x2*)(XM + (size_t)(_R0 + 4 * wave + rr) * 1024 + j * 256 + lane * 4) = o; *(u32x2*)(XT + (4 * wave + rr) * 1032 + j * 256 + lane * 4) = o; } \
        __syncthreads(); \
        _Pragma("unroll") for (int tl = 0; tl < 2; ++tl) { f32x4 acc = (f32x4){0.f, 0.f, 0.f, 0.f}; \
            _Pragma("unroll") for (int s2 = 0; s2 < 4; ++s2) { const bf16x8_t bfr = *(const bf16x8_t*)(XT + (16 * tl + r) * 1032 + 128 * wave + 32 * s2 + 8 * kq); acc = __builtin_amdgcn_mfma_f32_16x16x32_bf16(wf[s2], bfr, acc, 0, 0, 0); } \
            *(f32x4*)(RED + ((tl * 8 + wave) * 64 + lane) * 4) = acc; } \
        __syncthreads(); \
        if (wave < 2) { const float* _rd = RED + wave * 2048; f32x4 t = *(const f32x4*)(_rd + lane * 4); _Pragma("unroll") for (int w8 = 1; w8 < 8; ++w8) t += *(const f32x4*)(_rd + (w8 * 64 + lane) * 4); \
            u32x2 o; o.x = cvtpk(t[0], t[1]); o.y = cvtpk(t[2], t[3]); *(GAS u32x2*)(U + (size_t)(_R0 + 16 * wave + r) * DINP + C_GT + 4 * kq) = o; } } while (0)
      constexpr int NG = NLAT / 32;
      f32x4 bA[16], bB[16];
      __syncthreads();
      if (bid < NG) P1_LOAD(bA, bid);
      if (bid + nblk < NG) P1_LOAD(bB, bid + nblk);
      for (int g = bid; g < NG; g += 2 * nblk) {
          P1_STEP(bA, g);
          if (g + 2 * nblk < NG) P1_LOAD(bA, g + 2 * nblk);
          if (g + nblk < NG) { P1_STEP(bB, g + nblk); if (g + 3 * nblk < NG) P1_LOAD(bB, g + 3 * nblk); }
      }
#undef P1_LOAD
#undef P1_STEP
    }
    __syncthreads();
    { const int gw = bid * NWAVES + wave;
      for (int m = NLAT + gw; m < MROWS; m += nblk * NWAVES) { const GAS float* src = cs + (size_t)(m - NLAT) * 1024;
#pragma unroll
          for (int j = 0; j < 4; ++j) { const int k = j * 256 + lane * 4; const f32x4 v = *(const GAS f32x4*)(src + k);
              const f32x4 sb = *(const GAS f32x4*)(MOD + 8 * 6144 + k), sa = *(const GAS f32x4*)(MOD + 8 * 6144 + 1024 + k) + 1.f;
              const f32x4 rr = v * sa + sb; u32x2 o; o.x = pk2(rr.x, rr.y); o.y = pk2(rr.z, rr.w);
              *(GAS u32x2*)(XM + (size_t)m * 1024 + k) = o; } } }
    __syncthreads();
}


#define LAS __attribute__((address_space(3)))
typedef short bf16x8 __attribute__((ext_vector_type(8)));
typedef int i32x8 __attribute__((ext_vector_type(8)));
constexpr float NA_C2 = 0.125f * 1.4426950408889634f;
namespace pg8 {
constexpr int BM = 256, BK = 64, HALF = 128, HTB = HALF * BK * 2, STAGE_BYTES = 8 * HTB, NXCD = 8, WGM = 8;
constexpr int TAB_OFF = STAGE_BYTES;
__device__ __forceinline__ int lds_byte(int r, int c) { const int st = (r >> 4) * 2 + (c >> 5), rr = r & 15, cc = c & 31, ob = rr * 64 + cc * 2; return st * 1024 + (ob ^ (((ob >> 9) & 1) << 5)); }
__device__ __forceinline__ void stage_rc(int b, int& R, int& C) { const int st = b / 1024, sb = b % 1024, swz = sb ^ (((sb >> 9) & 1) << 5); R = (st >> 1) * 16 + swz / 64; C = (st & 1) * 32 + (swz % 64) / 2; }
__device__ __forceinline__ int perm32(int rho) { const int n = rho >> 4, i = rho & 15; return 8 * (i >> 2) + 4 * n + (i & 3); }
struct Unit { int pm, pn; };
struct StaticOrder {
    int nM, nN, nwg, G, c, narrow;
    __device__ void init(int nM_, int nN_, int G_, int c_, int narrow_) { nM = nM_; nN = nN_; G = G_; c = c_; narrow = narrow_; nwg = nM * (narrow ? nN - 1 : nN); }
    __device__ void decode(int wgid, int nNe, Unit& u) const {
        { const int q = nwg / NXCD, r = nwg % NXCD, xcd = wgid % NXCD, off = wgid / NXCD; wgid = (xcd < r ? xcd * (q + 1) : r * (q + 1) + (xcd - r) * q) + off; }
        const int nig = WGM * nNe, gid = wgid / nig, fm = gid * WGM, gsz = (nM - fm) < WGM ? (nM - fm) : WGM;
        u.pm = fm + ((wgid % nig) % gsz); u.pn = (wgid % nig) / gsz;
    }
    __device__ bool next(int i, Unit& u) const {
        if (!narrow) { const long L = (long)i * G + c; if (L >= nwg) return false; decode((int)L, nN, u); return true; }
        const int fr = nwg / G, rem = nwg % G;
        if (i < fr || (i == fr && c < rem)) { decode(i * G + c, nN - 1, u); return true; }
        if (c < rem) return false;
        const int j = (i - fr) * (G - rem) + (c - rem); if (j >= narrow) return false;
        u.pm = nM - narrow + j; u.pn = nN - 1; return true;
    }
};
__device__ __forceinline__ unsigned cvt_pk_bf16(float lo, float hi) { return cvtpk(lo, hi); }
struct GemmDesc { const void* A; const void* Bt; const int* IDX; void* O; const float* x; const float* MOD; size_t bEstride  ; int Kb  , egrp0, nM, nN, epi, ldc, narrow  , qtiles  ; };

__device__ __forceinline__ void epilogue(const GemmDesc& g, const f32x4 (&acc)[2][2][4][2], const Unit& u, int wr, int wc, int fr, int fq) {
    if (g.epi == 0 || g.epi == 3) {
        const float sc = g.epi == 3 ? (1.f / 64.f) : (u.pn < g.qtiles ? NA_C2 : 1.f);
        GAS bf16_t* O = (GAS bf16_t*)g.O; const int row0 = u.pm * BM + wr * 64 + fr, col0 = u.pn * BM + wc * 32 + 8 * fq;
#pragma unroll
        for (int ai = 0; ai < 2; ++ai)
#pragma unroll
            for (int m = 0; m < 4; ++m) { GAS bf16_t* rowp = O + (size_t)(row0 + ai * HALF + m * 16) * g.ldc + col0;
#pragma unroll
                for (int bj = 0; bj < 2; ++bj) { const f32x4 v0 = acc[ai][bj][m][0] * sc, v1 = acc[ai][bj][m][1] * sc;
                    u32x4 w; w.x = cvt_pk_bf16(v0[0], v0[1]); w.y = cvt_pk_bf16(v0[2], v0[3]); w.z = cvt_pk_bf16(v1[0], v1[1]); w.w = cvt_pk_bf16(v1[2], v1[3]);
                    *(GAS u32x4*)(rowp + bj * HALF) = w; } }
    } else if (g.epi == 1) {
        GAS unsigned char* O = (GAS unsigned char*)g.O; const int row0 = u.pm * BM + wr * 64 + fr, col0 = u.pn * HALF + wc * 32 + 8 * fq;
#pragma unroll
        for (int ai = 0; ai < 2; ++ai)
#pragma unroll
            for (int m = 0; m < 4; ++m) { GAS unsigned char* rowp = O + (size_t)(row0 + ai * HALF + m * 16) * DFF + col0;
                float r[8];
#pragma unroll
                for (int n = 0; n < 2; ++n)
#pragma unroll
                    for (int jp = 0; jp < 2; ++jp) { const f32x2_ gg = {acc[ai][0][m][n][2 * jp], acc[ai][0][m][n][2 * jp + 1]}, uu = {acc[ai][1][m][n][2 * jp], acc[ai][1][m][n][2 * jp + 1]};
                        const f32x2_ a = gg * (-(1.f / 32.f) * 1.4426950408889634f); f32x2_ e = {__builtin_amdgcn_exp2f(a.x), __builtin_amdgcn_exp2f(a.y)};
                        e = e * 1024.f + 1024.f; const f32x2_ rc = {__builtin_amdgcn_rcpf(e.x), __builtin_amdgcn_rcpf(e.y)}; const f32x2_ rr = (gg * uu) * rc;
                        r[n * 4 + 2 * jp] = rr.x; r[n * 4 + 2 * jp + 1] = rr.y; }
                u32x2 w; w.x = pk4_fp8(r[0], r[1], r[2], r[3]); w.y = pk4_fp8(r[4], r[5], r[6], r[7]);
                *(GAS u32x2*)rowp = w; }
    } else {
        GAS bf16_t* Yo = (GAS bf16_t*)g.O; const int row0 = u.pm * BM + wr * 64 + fr, col0 = u.pn * BM + wc * 32 + 8 * fq;
#pragma unroll
        for (int ai = 0; ai < 2; ++ai)
#pragma unroll
            for (int m = 0; m < 4; ++m) { GAS bf16_t* rowp = Yo + (size_t)(row0 + ai * HALF + m * 16) * 1024 + col0;
#pragma unroll
                for (int bj = 0; bj < 2; ++bj) { const f32x4 y0 = acc[ai][bj][m][0], y1 = acc[ai][bj][m][1];
                    u32x4 w; w.x = pk_f16(y0[0], y0[1]); w.y = pk_f16(y0[2], y0[3]); w.z = pk_f16(y1[0], y1[1]); w.w = pk_f16(y1[2], y1[3]);
                    *(GAS u32x4*)(rowp + bj * HALF) = w; } }
    }
}

template <bool MAYGATHER, bool FP8>
__device__ __forceinline__ void gemm_phase(LAS unsigned char* lds, const GemmDesc g, int G, int c) {
    const int tid = ltid(), wid = __builtin_amdgcn_readfirstlane(tid >> 6), lane = tid & 63, wr = wid >> 2, wc = wid & 3, fr = lane & 15, fq = lane >> 4;
    const int Kb = g.Kb, nt = Kb / (BK * 2);
    const bool perm = true, gather = MAYGATHER && g.IDX != nullptr;
    StaticOrder S; S.init(g.nM, g.nN, G, c, g.narrow);
    unsigned voffB[2];
#pragma unroll
    for (int i = 0; i < 2; ++i) { int R, C; stage_rc(tid * 16 + i * 8192, R, C); const int Rb = perm ? ((R & ~31) + perm32(R & 31)) : R; voffB[i] = (unsigned)(Rb * Kb + C * 2); }
    const size_t kstep = (size_t)(BK * 2), hstep = (size_t)HALF * Kb, tstep = 2 * hstep;
    const unsigned ldsw = (unsigned)wid * 1024u;
    const int aoff = lds_byte(wr * 64 + fr, fq * 8), boff = lds_byte(wc * 32 + fr, fq * 8);
    LAS int* tab = (LAS int*)(lds + TAB_OFF);
#define PG8_SA(b, h) (((b) * 2 + (h)) * HTB)
#define PG8_SB(b, h) ((4 + (b) * 2 + (h)) * HTB)
#define PG8_UNI(p_) ({ const unsigned long long _v = (unsigned long long)(p_); (const GAS char*)(((unsigned long long)(unsigned)__builtin_amdgcn_readfirstlane((int)(_v >> 32)) << 32) | (unsigned)__builtin_amdgcn_readfirstlane((int)_v)); })
#define PG8_GLDS(gptr, ldsoff) __builtin_amdgcn_global_load_lds((const GAS unsigned*)(gptr), (LAS unsigned*)(lds + (ldsoff)), 16, 0, 0)
#define PG8_STAGE_B(bufoff, gbase) do { const GAS char* _gb = (const GAS char*)(gbase); _Pragma("unroll") for (int _i = 0; _i < 2; ++_i) { asm volatile("" : "+v"(voffB[_i])); PG8_GLDS(_gb + voffB[_i], (bufoff) + ldsw + _i * 8192); } } while (0)
#define PG8_STAGE_A(bufoff, kt, v0_, v1_) do { const GAS char* _b = (const GAS char*)g.A + (size_t)(kt) * kstep; asm volatile("" : "+v"(v0_), "+v"(v1_)); PG8_GLDS(_b + (v0_), (bufoff) + ldsw); PG8_GLDS(_b + (v1_), (bufoff) + ldsw + 8192); } while (0)
#define PG8_LDA(dst, b, h) do { _Pragma("unroll") for (int m = 0; m < 4; ++m) _Pragma("unroll") for (int k = 0; k < 2; ++k) dst[m][k] = *(const LAS bf16x8*)(lds + PG8_SA(b, h) + aoff + m * 2048 + k * 1024); } while (0)
#define PG8_LDB(dst, b, h) do { _Pragma("unroll") for (int n = 0; n < 2; ++n) _Pragma("unroll") for (int k = 0; k < 2; ++k) dst[n][k] = *(const LAS bf16x8*)(lds + PG8_SB(b, h) + boff + n * 2048 + k * 1024); } while (0)
#define PG8_MMA(ai, bj, At, Bt) do { __builtin_amdgcn_s_setprio(1); \
        if constexpr (FP8) { _Pragma("unroll") for (int m = 0; m < 4; ++m) _Pragma("unroll") for (int n = 0; n < 2; ++n) { \
            const bf16x8 _b0 = Bt[n][0], _b1 = Bt[n][1], _a0 = At[m][0], _a1 = At[m][1]; \
            const i32x8 _bw = __builtin_bit_cast(i32x8, __builtin_shufflevector(_b0, _b1, 0, 1, 2, 3, 4, 5, 6, 7, 8, 9, 10, 11, 12, 13, 14, 15)); \
            const i32x8 _aw = __builtin_bit_cast(i32x8, __builtin_shufflevector(_a0, _a1, 0, 1, 2, 3, 4, 5, 6, 7, 8, 9, 10, 11, 12, 13, 14, 15)); \
            acc[ai][bj][m][n] = __builtin_amdgcn_mfma_scale_f32_16x16x128_f8f6f4(_bw, _aw, acc[ai][bj][m][n], 0, 0, 0, 0x7f7f7f7f, 0, 0x7f7f7f7f); } } \
        else { _Pragma("unroll") for (int m = 0; m < 4; ++m) _Pragma("unroll") for (int n = 0; n < 2; ++n) _Pragma("unroll") for (int k = 0; k < 2; ++k) \
            acc[ai][bj][m][n] = __builtin_amdgcn_mfma_f32_16x16x32_bf16(Bt[n][k], At[m][k], acc[ai][bj][m][n], 0, 0, 0); } \
        __builtin_amdgcn_s_setprio(0); } while (0)
#define PG8_WAIT_V(n) asm volatile("s_waitcnt vmcnt(" #n ")" ::: "memory")
#define PG8_WAIT_L(n) asm volatile("s_waitcnt lgkmcnt(" #n ")" ::: "memory")
#define PG8_BAR __builtin_amdgcn_s_barrier()
#define PG8_SCHED __builtin_amdgcn_sched_barrier(0)
#define PG8_TAB_FILL(u, s) do { if (wid < 4) { const int _e = g.egrp0 + ((u).pm >> 5), _m0 = ((u).pm & 31) * 256, _b = _m0 >> 10, _s0 = _m0 & 1023; \
        __builtin_amdgcn_global_load_lds((const unsigned*)(g.IDX + (_e * 8 + _b) * CAP + _s0 + wid * 64 + lane), (LAS unsigned*)(lds + TAB_OFF + (s) * 1024 + wid * 256), 4, 0, 0); } } while (0)
#define PG8_ROWS(u, s, v) do { int _t = tid; asm volatile("" : "+v"(_t)); _Pragma("unroll") for (int _i = 0; _i < 2; ++_i) { int _R, _C; stage_rc(_t * 16 + _i * 8192, _R, _C); \
        _Pragma("unroll") for (int _h = 0; _h < 2; ++_h) { \
            if (gather) { const int _b = (((u).pm & 31) * 256) >> 10; const int _ix = tab[(s) * 256 + _h * 128 + _R]; v[_h][_i] = (unsigned)((_b * 8192 + _ix) * Kb + _C * 2); } \
            else v[_h][_i] = (unsigned)(((u).pm * 256 + _h * 128 + _R) * Kb + _C * 2); } } } while (0)
    Unit cur, nxt; int ui = 0;
    if (!S.next(0, cur)) return;
    cur.pm = __builtin_amdgcn_readfirstlane(cur.pm); cur.pn = __builtin_amdgcn_readfirstlane(cur.pn);
    f32x4 acc[2][2][4][2];
#define PG8_ACC_INIT(u) do { if (g.epi == 2) { const GAS float* _x = (const GAS float*)g.x + (size_t)((u).pm * BM + wr * 64 + fr) * 1024 + (u).pn * BM + wc * 32 + 8 * fq; \
        _Pragma("unroll") for (int a = 0; a < 2; ++a) _Pragma("unroll") for (int m = 0; m < 4; ++m) _Pragma("unroll") for (int b = 0; b < 2; ++b) _Pragma("unroll") for (int n = 0; n < 2; ++n) \
            acc[a][b][m][n] = *(const GAS f32x4*)(_x + (size_t)(a * HALF + m * 16) * 1024 + b * HALF + n * 4); \
        _Pragma("unroll") for (int a = 0; a < 2; ++a) _Pragma("unroll") for (int m = 0; m < 4; ++m) _Pragma("unroll") for (int b = 0; b < 2; ++b) _Pragma("unroll") for (int n = 0; n < 2; ++n) \
            acc[a][b][m][n] = acc[a][b][m][n] * ALPHA; } \
      else { typedef double f64x2_ __attribute__((ext_vector_type(2))); f64x2_ z2 = {0.0, 0.0}; asm volatile("" : "+v"(z2));     \
        _Pragma("unroll") for (int a = 0; a < 2; ++a) _Pragma("unroll") for (int b = 0; b < 2; ++b) _Pragma("unroll") for (int m = 0; m < 4; ++m) _Pragma("unroll") for (int n = 0; n < 2; ++n) \
            acc[a][b][m][n] = __builtin_bit_cast(f32x4, z2); } } while (0)
    PG8_ACC_INIT(cur);
    bf16x8 At[4][2], B0[2][2], B1[2][2];
    unsigned vc[2][2];
    const char* cB = (const char*)g.Bt + (size_t)(g.egrp0 + (cur.pm >> 5)) * g.bEstride + (size_t)cur.pn * tstep;
    const char* nB = cB;
    if (gather) { PG8_TAB_FILL(cur, 0); PG8_WAIT_V(0); PG8_BAR; }
    PG8_ROWS(cur, 0, vc);
    PG8_STAGE_B(PG8_SB(0, 0), cB); PG8_STAGE_B(PG8_SB(0, 1), cB + hstep); PG8_STAGE_A(PG8_SA(0, 0), 0, vc[0][0], vc[0][1]); PG8_STAGE_A(PG8_SA(0, 1), 0, vc[1][0], vc[1][1]);
    if (wr == 1) PG8_BAR;
    PG8_WAIT_V(2); PG8_BAR;
    PG8_STAGE_B(PG8_SB(1, 0), cB + kstep); PG8_STAGE_A(PG8_SA(1, 0), 1, vc[0][0], vc[0][1]); PG8_STAGE_B(PG8_SB(1, 1), cB + hstep + kstep);
    PG8_WAIT_V(6); PG8_BAR;
    for (;;) {
        const bool has_next = S.next(ui + 1, nxt);
        nxt.pm = __builtin_amdgcn_readfirstlane(nxt.pm); nxt.pn = __builtin_amdgcn_readfirstlane(nxt.pn);
        if (has_next) nB = (const char*)g.Bt + (size_t)(g.egrp0 + (nxt.pm >> 5)) * g.bEstride + (size_t)nxt.pn * tstep; else nB = cB;
        if (gather && has_next) PG8_TAB_FILL(nxt, (ui + 1) & 1);
        for (int t = 0; t < nt; t += 2) {
            const bool last = (t == nt - 2);
            const int k2 = last ? 0 : t + 2, k3 = k2 + 1;
            const char* b2 = last ? nB : cB + (size_t)(t + 2) * kstep; const char* b3 = b2 + kstep;
            PG8_LDB(B0, 0, 0); PG8_LDB(B1, 0, 1); PG8_SCHED; PG8_LDA(At, 0, 0); PG8_STAGE_A(PG8_SA(1, 1), t + 1, vc[1][0], vc[1][1]);
            if (last && has_next) PG8_ROWS(nxt, (ui + 1) & 1, vc);
            PG8_WAIT_V(8); PG8_WAIT_L(0); PG8_BAR; PG8_MMA(0, 0, At, B0); PG8_MMA(0, 1, At, B1); PG8_BAR; PG8_SCHED;
            PG8_LDA(At, 0, 1); PG8_STAGE_B(PG8_SB(0, 0), b2); PG8_STAGE_B(PG8_SB(0, 1), b2 + hstep); PG8_STAGE_A(PG8_SA(0, 0), k2, vc[0][0], vc[0][1]);
            PG8_WAIT_V(8); PG8_WAIT_L(0); PG8_BAR; PG8_MMA(1, 0, At, B0); PG8_MMA(1, 1, At, B1); PG8_BAR; PG8_SCHED;
            PG8_LDB(B0, 1, 0); PG8_LDB(B1, 1, 1); PG8_SCHED; PG8_LDA(At, 1, 0); PG8_STAGE_A(PG8_SA(0, 1), k2, vc[1][0], vc[1][1]);
            PG8_WAIT_V(8); PG8_WAIT_L(0); PG8_BAR; PG8_MMA(0, 0, At, B0); PG8_MMA(0, 1, At, B1); PG8_BAR; PG8_SCHED;
            PG8_LDA(At, 1, 1); PG8_STAGE_B(PG8_SB(1, 0), b3); PG8_STAGE_B(PG8_SB(1, 1), b3 + hstep); PG8_STAGE_A(PG8_SA(1, 0), k3, vc[0][0], vc[0][1]);
            PG8_WAIT_V(8); PG8_WAIT_L(0); PG8_BAR; PG8_MMA(1, 0, At, B0); PG8_MMA(1, 1, At, B1); PG8_BAR; PG8_SCHED;
        }
        if (wr == 0) PG8_BAR;
        epilogue(g, acc, cur, wr, wc, fr, fq);
        if (!has_next) break;
        cur = nxt; cB = nB; ++ui;
        PG8_ACC_INIT(cur);
        if (wr == 1) PG8_BAR;
    }
    PG8_WAIT_V(0);
    PG8_BAR;
#undef PG8_SA
#undef PG8_SB
#undef PG8_GLDS
#undef PG8_STAGE_A
#undef PG8_STAGE_B
#undef PG8_LDA
#undef PG8_LDB
#undef PG8_MMA
#undef PG8_WAIT_V
#undef PG8_WAIT_L
#undef PG8_BAR
#undef PG8_ACC_INIT
#undef PG8_SCHED
#undef PG8_TAB_FILL
#undef PG8_ROWS
}
}


constexpr int NA_SLOTS = 9, NA_SLOT_EL = 64 * 72;
__device__ __forceinline__ int vtl_off(int d, int key) { return d * 72 + key; }
__device__ __forceinline__ int vtc_off(int d, int key) { return d * 264 + key; }
__device__ __forceinline__ void na_item(const Params& p, unsigned char* lds, int item) {
    const GAS bf16_t* U = (const GAS bf16_t*)(p.ws + WS_U); GAS bf16_t* MIX = (GAS bf16_t*)(p.ws + WS_MIX);
    const int tid = ltid(), lane = tid & 63, wave = __builtin_amdgcn_readfirstlane(tid >> 6), fr = lane & 15, fq = lane >> 4;
    const int seg = item & 3, bh = item >> 2, h = bh & 7, b = bh >> 3;
    bf16_t* VTL = (bf16_t*)lds;
    bf16_t* VTC = VTL + NA_SLOTS * NA_SLOT_EL;
    bf16_t* KC = VTC + 64 * 264;
    float* BIAS = (float*)(KC + 256 * 72);
    const size_t lat0 = (size_t)b * 8192, ctx0 = (size_t)NLAT + b * 256;
    const GAS bf16_t* Uv = U + C_VA + h * 64 + wave * 8;
#pragma unroll
    for (int i = 0; i < 2; ++i) { const int kp = lane + 64 * i;
        const u32x4 w0 = *(const GAS u32x4*)(Uv + (ctx0 + 2 * kp) * DINP), w1 = *(const GAS u32x4*)(Uv + (ctx0 + 2 * kp + 1) * DINP);
        const unsigned ws_[8] = {(w0.x & 0xffffu) | (w1.x << 16), (w0.x >> 16) | (w1.x & 0xffff0000u), (w0.y & 0xffffu) | (w1.y << 16), (w0.y >> 16) | (w1.y & 0xffff0000u),
                                 (w0.z & 0xffffu) | (w1.z << 16), (w0.z >> 16) | (w1.z & 0xffff0000u), (w0.w & 0xffffu) | (w1.w << 16), (w0.w >> 16) | (w1.w & 0xffff0000u)};
#pragma unroll
        for (int e = 0; e < 8; ++e) *(unsigned*)(VTC + vtc_off(wave * 8 + e, 2 * kp)) = ws_[e]; }
    for (int idx = tid; idx < 256 * 8; idx += NTHR) { const int key = idx >> 3, ck = idx & 7;
        *(u32x4*)(KC + key * 72 + ck * 8) = *(const GAS u32x4*)(U + (ctx0 + key) * DINP + C_KA + h * 64 + ck * 8); }
    if (tid < 512) BIAS[tid] = tid < 465 ? p.na_bias[h * 465 + tid] * 1.4426950408889634f : 0.f;
    const int cg = wave & 3, rr = wave >> 2, c0 = 16 * cg, kb = cg == 0 ? 0 : (cg == 1 ? 8 : (cg == 2 ? 24 : 32));
    const int c = c0 + fr, cs = min(max(c - 8, 0), 48);
    const int r00 = 32 * seg;
#define NA_VFILL(kra_, w0_, w1_) do { const unsigned ws_[8] = {(w0_.x & 0xffffu) | (w1_.x << 16), (w0_.x >> 16) | (w1_.x & 0xffff0000u), (w0_.y & 0xffffu) | (w1_.y << 16), (w0_.y >> 16) | (w1_.y & 0xffff0000u), \
            (w0_.z & 0xffffu) | (w1_.z << 16), (w0_.z >> 16) | (w1_.z & 0xffff0000u), (w0_.w & 0xffffu) | (w1_.w << 16), (w0_.w >> 16) | (w1_.w & 0xffff0000u)}; \
        bf16_t* sl_ = VTL + ((kra_) % NA_SLOTS) * NA_SLOT_EL; _Pragma("unroll") for (int e_ = 0; e_ < 8; ++e_) *(unsigned*)(sl_ + vtl_off(wave * 8 + e_, 2 * (lane & 31))) = ws_[e_]; } while (0)
    { const int lo = min(max(r00 - 4, 0), 120), hi = min(max(r00 + 1 - 4, 0), 120) + 7;
      for (int kra = lo + (lane >> 5); kra <= hi; kra += 2) { const size_t k0 = lat0 + kra * 64 + 2 * (lane & 31);
          const u32x4 w0 = *(const GAS u32x4*)(Uv + k0 * DINP), w1 = *(const GAS u32x4*)(Uv + (k0 + 1) * DINP);
          NA_VFILL(kra, w0, w1); } }
#define NA_LOADK(kf_, ch, rw_) do { const int rs_ = min(max((rw_) - 4, 0), 120); unsigned koff_ = koff; asm volatile("" : "+v"(koff_));     \
        _Pragma("unroll") for (int t_ = 0; t_ < 4; ++t_) { \
        const size_t krow_ = lat0 + (rs_ + 2 * (ch) + (t_ >> 1)) * 64 + kb + 16 * (t_ & 1); \
        const GAS char* bp_ = Ub + krow_ * (DINP * 2); \
        kf_[2 * t_] = *(const GAS bf16x8_t*)(bp_ + koff_); kf_[2 * t_ + 1] = *(const GAS bf16x8_t*)(bp_ + koff_ + 64); } } while (0)
    const GAS char* Ub = (const GAS char*)U;
    const unsigned koff = (unsigned)((fr * DINP + C_KA + h * 64 + 8 * fq) * 2);
    bf16x8_t kfa[8], kfb[8], qf[2];
    { const int rw0 = r00 + rr; const size_t qrow = lat0 + rw0 * 64 + c0 + fr;
      qf[0] = *(const GAS bf16x8_t*)(U + qrow * DINP + C_QA + h * 64 + 8 * fq); qf[1] = *(const GAS bf16x8_t*)(U + qrow * DINP + C_QA + h * 64 + 32 + 8 * fq);
      NA_LOADK(kfa, 0, rw0); NA_LOADK(kfb, 1, rw0); }
    __syncthreads();
#pragma unroll 1
    for (int step = 0; step < 16; ++step) {
        const int r = r00 + 2 * step, rw = r + rr, rsw = min(max(rw - 4, 0), 120);
        const int nhi_cur = min(max(r + 1 - 4, 0), 120) + 7, nhi_nxt = min(max(r + 3 - 4, 0), 120) + 7;
        const int vkra = nhi_cur + 1 + (lane >> 5); const bool vld = step < 15 && vkra <= nhi_nxt;
        u32x4 vw0 = (u32x4){0u, 0u, 0u, 0u}, vw1 = (u32x4){0u, 0u, 0u, 0u};
        float m_run = -INFINITY, l_run = 0.f;
        f32x4 o[4];
#pragma unroll
        for (int db = 0; db < 4; ++db) o[db] = (f32x4){0.f, 0.f, 0.f, 0.f};
#pragma unroll
        for (int ch = 0; ch < 8; ++ch) {
            f32x4 sc[4];
            if (ch < 4) {
#pragma unroll
                for (int t = 0; t < 4; ++t) { f32x4 a = (f32x4){0.f, 0.f, 0.f, 0.f};
                    if (ch & 1) { a = __builtin_amdgcn_mfma_f32_16x16x32_bf16(kfb[2 * t], qf[0], a, 0, 0, 0); a = __builtin_amdgcn_mfma_f32_16x16x32_bf16(kfb[2 * t + 1], qf[1], a, 0, 0, 0); }
                    else { a = __builtin_amdgcn_mfma_f32_16x16x32_bf16(kfa[2 * t], qf[0], a, 0, 0, 0); a = __builtin_amdgcn_mfma_f32_16x16x32_bf16(kfa[2 * t + 1], qf[1], a, 0, 0, 0); }
                    sc[t] = a; }
                __builtin_amdgcn_sched_barrier(0);
                if (ch < 2) { if (ch & 1) { NA_LOADK(kfb, ch + 2, rw); } else { NA_LOADK(kfa, ch + 2, rw); } }
                else if (step < 15) { if (ch & 1) { NA_LOADK(kfb, 1, rw + 2); } else { NA_LOADK(kfa, 0, rw + 2); } }
            } else {
#pragma unroll
                for (int t = 0; t < 4; ++t) { const bf16_t* kp = KC + (64 * (ch - 4) + 16 * t + fr) * 72 + 8 * fq;
                    const bf16x8_t k0 = *(const bf16x8_t*)kp, k1 = *(const bf16x8_t*)(kp + 32);
                    f32x4 a = (f32x4){0.f, 0.f, 0.f, 0.f};
                    a = __builtin_amdgcn_mfma_f32_16x16x32_bf16(k0, qf[0], a, 0, 0, 0); a = __builtin_amdgcn_mfma_f32_16x16x32_bf16(k1, qf[1], a, 0, 0, 0); sc[t] = a; }
                __builtin_amdgcn_sched_barrier(0);
                if (ch == 7 && step < 15) { const size_t qrow = lat0 + (rw + 2) * 64 + c0 + fr;
                    qf[0] = *(const GAS bf16x8_t*)(U + qrow * DINP + C_QA + h * 64 + 8 * fq); qf[1] = *(const GAS bf16x8_t*)(U + qrow * DINP + C_QA + h * 64 + 32 + 8 * fq); }
                if (ch == 4 && vld) { const size_t k0 = lat0 + vkra * 64 + 2 * (lane & 31); vw0 = *(const GAS u32x4*)(Uv + k0 * DINP); vw1 = *(const GAS u32x4*)(Uv + (k0 + 1) * DINP); }
            }
            u32x2 vfr[2][4][2];
#pragma unroll
            for (int t = 0; t < 2; ++t)
#pragma unroll
                for (int db = 0; db < 4; ++db) {
                    if (ch < 4) { const bf16_t* sl = VTL + ((rsw + 2 * ch + t) % NA_SLOTS) * NA_SLOT_EL;
                        vfr[t][db][0] = *(const u32x2*)(sl + vtl_off(db * 16 + fr, kb + 4 * fq)); vfr[t][db][1] = *(const u32x2*)(sl + vtl_off(db * 16 + fr, kb + 16 + 4 * fq)); }
                    else { vfr[t][db][0] = *(const u32x2*)(VTC + vtc_off(db * 16 + fr, 64 * (ch - 4) + 32 * t + 4 * fq)); vfr[t][db][1] = *(const u32x2*)(VTC + vtc_off(db * 16 + fr, 64 * (ch - 4) + 32 * t + 16 + 4 * fq)); }
                }
            float bv[4][4];
            if (ch < 4) {
#pragma unroll
                for (int t = 0; t < 4; ++t) { const int kr = 2 * ch + (t >> 1), cb = t & 1;
                    const float* brow = BIAS + (rsw + kr - rw + 7) * 31;
#pragma unroll
                    for (int j = 0; j < 4; ++j) bv[t][j] = brow[kb + 16 * cb + 4 * fq + j - c + 15]; }
                asm volatile("" : "+v"(bv[0][0]), "+v"(bv[0][1]), "+v"(bv[0][2]), "+v"(bv[0][3]), "+v"(bv[1][0]), "+v"(bv[1][1]), "+v"(bv[1][2]), "+v"(bv[1][3]),
                                  "+v"(bv[2][0]), "+v"(bv[2][1]), "+v"(bv[2][2]), "+v"(bv[2][3]), "+v"(bv[3][0]), "+v"(bv[3][1]), "+v"(bv[3][2]), "+v"(bv[3][3]));
            }
            __builtin_amdgcn_sched_barrier(0);
            if (ch < 4) {
#pragma unroll
                for (int t = 0; t < 4; ++t) { const int cb = t & 1;
#pragma unroll
                    for (int j = 0; j < 4; ++j) { const int col = kb + 16 * cb + 4 * fq + j; const bool valid = (col >= cs) && (col < cs + 16);
                        sc[t][j] = valid ? sc[t][j] + bv[t][j] : -INFINITY; } }
            }
            float cm = -INFINITY;
#pragma unroll
            for (int t = 0; t < 4; ++t) cm = fmaxf(cm, fmaxf(fmaxf(sc[t][0], sc[t][1]), fmaxf(sc[t][2], sc[t][3])));
            if (__any(cm > m_run + 11.5f)) {
                cm = fmaxf(cm, __shfl_xor(cm, 16)); cm = fmaxf(cm, __shfl_xor(cm, 32));
                const float m_new = fmaxf(m_run, cm), alpha = __builtin_amdgcn_exp2f(m_run - m_new);
                m_run = m_new; l_run *= alpha;
#pragma unroll
                for (int db = 0; db < 4; ++db) o[db] *= alpha;
            }
            const float m_new = m_run;
            float psum = 0.f;
            u32x4 pw[2];
#pragma unroll
            for (int t = 0; t < 2; ++t) {
                f32x4 e0, e1;
#pragma unroll
                for (int j = 0; j < 4; ++j) { e0[j] = __builtin_amdgcn_exp2f(sc[2 * t][j] - m_new); e1[j] = __builtin_amdgcn_exp2f(sc[2 * t + 1][j] - m_new); }
                psum += (e0[0] + e0[1]) + (e0[2] + e0[3]) + (e1[0] + e1[1]) + (e1[2] + e1[3]);
                pw[t].x = cvtpk(e0[0], e0[1]); pw[t].y = cvtpk(e0[2], e0[3]); pw[t].z = cvtpk(e1[0], e1[1]); pw[t].w = cvtpk(e1[2], e1[3]);
            }
            l_run += psum;
#pragma unroll
            for (int t = 0; t < 2; ++t)
#pragma unroll
                for (int db = 0; db < 4; ++db) { const u32x4 vw = (u32x4){vfr[t][db][0].x, vfr[t][db][0].y, vfr[t][db][1].x, vfr[t][db][1].y};
                    o[db] = __builtin_amdgcn_mfma_f32_16x16x32_bf16(__builtin_bit_cast(bf16x8_t, vw), __builtin_bit_cast(bf16x8_t, pw[t]), o[db], 0, 0, 0); }
            __builtin_amdgcn_sched_barrier(0);
        }
        float lsum = l_run; lsum += __shfl_xor(lsum, 16); lsum += __shfl_xor(lsum, 32);
        const float rinv = 1.f / lsum;
        { GAS bf16_t* orow = MIX + (lat0 + rw * 64 + c0 + fr) * 1024 + h * 64 + 4 * fq;
#pragma unroll
          for (int db = 0; db < 4; ++db) { u32x2 w; w.x = pk2(o[db][0] * rinv, o[db][1] * rinv); w.y = pk2(o[db][2] * rinv, o[db][3] * rinv); *(GAS u32x2*)(orow + db * 16) = w; } }
        __syncthreads();
        if (vld) NA_VFILL(vkra, vw0, vw1);
        __syncthreads();
    }
#undef NA_LOADK
#undef NA_VFILL
}

__device__ __forceinline__ float rope_elem(const float* xr, int d, int t, const GAS float* ROPE) {
    const int half = d >> 5, dd = d & 31, i = dd & 15;
    const int pos = half == 0 ? (t >> 6) : (t & 63);
    const float cs_ = ROPE[(pos * 16 + i) * 2], sn = ROPE[(pos * 16 + i) * 2 + 1];
    const float x1 = xr[half * 32 + i], x2 = xr[half * 32 + 16 + i];
    return dd < 16 ? x1 * cs_ - x2 * sn : x1 * sn + x2 * cs_;
}

struct StPre { u32x4 raw[5]; u32x4 v[4]; bf16_t gt; };
__device__ __forceinline__ void ml_stats_prefetch_raw(const Params& p, int item, int tid, StPre& r) {
    const GAS bf16_t* U = (const GAS bf16_t*)(p.ws + WS_U);
    const int ch = item % NCH, bh = item / NCH, h = bh & 3, b = bh >> 2;
    const bool is_ctx = ch >= 64; const int Tseq = is_ctx ? 256 : 8192, t0 = (is_ctx ? ch - 64 : ch) * 128;
    const size_t rowbase = is_ctx ? (size_t)NLAT + b * 256 : (size_t)b * 8192;
#pragma unroll
    for (int i = 0; i < 5; ++i) { const int idx = tid + i * NTHR, tt = idx >> 4, ck = idx & 15, t = t0 - 2 + tt;
        u32x4 w = (u32x4){0u, 0u, 0u, 0u};
        if (idx < 132 * 16 && t >= 0 && t < Tseq) w = *(const GAS u32x4*)(U + (rowbase + t) * DINP + (ck < 8 ? C_QM : C_KM) + h * 64 + (ck & 7) * 8);
        r.raw[i] = w; }
    { const int g = tid >> 7, l = tid & 127; r.gt = U[(rowbase + t0 + l) * DINP + C_GT + g * 4 + h]; }
}
__device__ __forceinline__ void ml_stats_prefetch_v(const Params& p, int item, int tid, StPre& r) {
    const GAS bf16_t* U = (const GAS bf16_t*)(p.ws + WS_U);
    const int ch = item % NCH, bh = item / NCH, h = bh & 3, b = bh >> 2;
    const bool is_ctx = ch >= 64; const int t0 = (is_ctx ? ch - 64 : ch) * 128;
    const size_t rowbase = is_ctx ? (size_t)NLAT + b * 256 : (size_t)b * 8192;
#pragma unroll
    for (int i = 0; i < 4; ++i) { const int idx = tid + i * NTHR, l = idx & 127, ck = idx >> 7; r.v[i] = *(const GAS u32x4*)(U + (rowbase + t0 + l) * DINP + C_VM + h * 128 + ck * 8); }
}
__device__ __forceinline__ void ml_stats_prefetch(const Params& p, int item, int tid, StPre& r) { ml_stats_prefetch_raw(p, item, tid, r); ml_stats_prefetch_v(p, item, tid, r); }
__device__ __forceinline__ void ml_stats_item(const Params& p, unsigned char* lds, int item, StPre& pre, int next_item) {
    const GAS bf16_t* U = (const GAS bf16_t*)(p.ws + WS_U); GAS bf16_t* QP = (GAS bf16_t*)(p.ws + WS_QP); GAS bf16_t* KP = (GAS bf16_t*)(p.ws + WS_KP);
    GAS bf16_t* CLOC = (GAS bf16_t*)(p.ws + WS_CLOC); GAS float* NLOC = (GAS float*)(p.ws + WS_NLOC); GAS float* MLOC = (GAS float*)(p.ws + WS_MLOC); GAS float* BLAST = (GAS float*)(p.ws + WS_BLAST);
    const GAS float* ROPE = (const GAS float*)(p.ws + WS_ROPE); const GAS float* convw = (const GAS float*)p.conv_qk;
    const int tid = ltid(), lane = tid & 63, wave = __builtin_amdgcn_readfirstlane(tid >> 6), fr = lane & 15, fq = lane >> 4;
    const int ch = item % NCH, bh = item / NCH, h = bh & 3, b = bh >> 2;
    const bool is_ctx = ch >= 64; const int Tseq = is_ctx ? 256 : 8192, cl = is_ctx ? ch - 64 : ch, t0 = cl * 128;
    const size_t rowbase = is_ctx ? (size_t)NLAT + b * 256 : (size_t)b * 8192;
    bf16_t* KT = (bf16_t*)lds;
    bf16_t* RAW = KT + 64 * 136;
    float* TMP = (float*)(RAW + 132 * 128);
    bf16_t* WV = RAW;
    float* gl = TMP + 128 * 129;
    float* wgt = gl + 512;
    const float* RT = wgt + 256;
#pragma unroll
    for (int i = 0; i < 5; ++i) { const int idx = tid + i * NTHR; if (idx < 132 * 16) *(u32x4*)(RAW + (idx >> 4) * 128 + (idx & 15) * 8) = pre.raw[i]; }
    { const int g = tid >> 7; gl[tid] = bf2f(pre.gt) + p.b_gate[g * 4 + h]; }
    __syncthreads();
    if (next_item >= 0) ml_stats_prefetch_raw(p, next_item, tid, pre);
    for (int rr19_ = 0; rr19_ < REPN(19); ++rr19_) {
    { const int chn = tid & 127, wofs = (chn < 64 ? 0 : 256) + h * 64 + (chn & 63);
      float cw[5];
#pragma unroll
      for (int j = 0; j < 5; ++j) cw[j] = convw[j * 512 + wofs];
      const int l0 = (tid >> 7) * 32;
      float w0 = bf2f(RAW[(l0 + 0) * 128 + chn]), w1 = bf2f(RAW[(l0 + 1) * 128 + chn]), w2 = bf2f(RAW[(l0 + 2) * 128 + chn]), w3 = bf2f(RAW[(l0 + 3) * 128 + chn]);
#pragma unroll 8
      for (int i = 0; i < 32; ++i) { const float w4 = bf2f(RAW[(l0 + i + 4) * 128 + chn]);
          const float a = cw[0] * w0 + cw[1] * w1 + cw[2] * w2 + cw[3] * w3 + cw[4] * w4;
          TMP[(l0 + i) * 129 + chn] = siluf(a); w0 = w1; w1 = w2; w2 = w3; w3 = w4; } }
    if (wave < 2) {
        const int dir = wave, l0 = dir == 0 ? 2 * lane : 127 - 2 * lane, l1 = dir == 0 ? 2 * lane + 1 : 126 - 2 * lane;
        const float* ig = gl + dir * 256; const float* fg = ig + 128;
        const float lf0 = logsigf(fg[l0]), lf1 = logsigf(fg[l1]);
        const float incl = wscan_add(lf0 + lf1, lane), bc0 = incl - lf1, bc1 = incl, blast = __shfl(incl, 63);
        const float a0 = blast - bc0 + ig[l0], a1 = blast - bc1 + ig[l1];
        const float m = wave_max(fmaxf(a0, a1));
        wgt[dir * 128 + l0] = __expf(a0 - m); wgt[dir * 128 + l1] = __expf(a1 - m);
        if (lane == 0) { BLAST[(dir * 32 + bh) * NCH + ch] = blast; MLOC[(dir * 32 + bh) * NCH + ch] = m; }
    }
    }
    __syncthreads();
    for (int rr20_ = 0; rr20_ < REPN(20); ++rr20_) {
    for (int idx = tid; idx < 128 * 16; idx += NTHR) { const int l = idx & 127, ck = idx >> 7, isk = ck >> 3, d0 = (ck & 7) * 8, t = t0 + l;
        if (is_ctx && !isk) continue;
        const float* xr = TMP + l * 129 + isk * 64;
        float o[8];
        if (is_ctx) {
#pragma unroll
            for (int e = 0; e < 8; ++e) o[e] = xr[d0 + e];
        } else {
            const int half = d0 >> 5, dd0 = d0 & 31, i0 = dd0 & 15, pos = half == 0 ? (t >> 6) : (t & 63);
            const f32x4* rp = (const f32x4*)(RT + (pos * 16 + i0) * 2);
            const f32x4 r0 = rp[0], r1 = rp[1], r2 = rp[2], r3 = rp[3];
            const float cs_[8] = {r0.x, r0.z, r1.x, r1.z, r2.x, r2.z, r3.x, r3.z}, sn[8] = {r0.y, r0.w, r1.y, r1.w, r2.y, r2.w, r3.y, r3.w};
#pragma unroll
            for (int e = 0; e < 8; ++e) { const float x1 = xr[half * 32 + i0 + e], x2 = xr[half * 32 + 16 + i0 + e]; o[e] = dd0 < 16 ? x1 * cs_[e] - x2 * sn[e] : x1 * sn[e] + x2 * cs_[e]; }
        }
        if (!isk) { u32x4 w; w.x = pk2(o[0] * 0.125f, o[1] * 0.125f); w.y = pk2(o[2] * 0.125f, o[3] * 0.125f); w.z = pk2(o[4] * 0.125f, o[5] * 0.125f); w.w = pk2(o[6] * 0.125f, o[7] * 0.125f);
            *(GAS u32x4*)(QP + ((size_t)b * 8192 + t) * 256 + h * 64 + d0) = w; }
        else { u32x4 w; w.x = pk2(o[0], o[1]); w.y = pk2(o[2], o[3]); w.z = pk2(o[4], o[5]); w.w = pk2(o[6], o[7]);
            *(GAS u32x4*)(KP + (rowbase + t) * 256 + h * 64 + d0) = w;
            KT[(d0 + 0) * 136 + l] = (bf16_t)(w.x & 0xffffu); KT[(d0 + 1) * 136 + l] = (bf16_t)(w.x >> 16); KT[(d0 + 2) * 136 + l] = (bf16_t)(w.y & 0xffffu); KT[(d0 + 3) * 136 + l] = (bf16_t)(w.y >> 16);
            KT[(d0 + 4) * 136 + l] = (bf16_t)(w.z & 0xffffu); KT[(d0 + 5) * 136 + l] = (bf16_t)(w.z >> 16); KT[(d0 + 6) * 136 + l] = (bf16_t)(w.w & 0xffffu); KT[(d0 + 7) * 136 + l] = (bf16_t)(w.w >> 16); }
    }
    }
    __syncthreads();
    for (int rr21_ = 0; rr21_ < REPN(21); ++rr21_) {
#pragma unroll
    for (int i = 0; i < 4; ++i) { const int idx = tid + i * NTHR, l = idx & 127, ck = idx >> 7;
        const u32x4 w = pre.v[i];
        const float wf = wgt[l], wb = wgt[128 + l];
        const float vv[8] = {bflo(w.x), bfhi(w.x), bflo(w.y), bfhi(w.y), bflo(w.z), bfhi(w.z), bflo(w.w), bfhi(w.w)};
#pragma unroll
        for (int e = 0; e < 8; ++e) { WV[(ck * 8 + e) * 136 + l] = (bf16_t)f2bf(wf * vv[e]); WV[(128 + ck * 8 + e) * 136 + l] = (bf16_t)f2bf(wb * vv[e]); } }
    }
    __syncthreads();
    if (next_item >= 0) ml_stats_prefetch_v(p, next_item, tid, pre);
    for (int rr22_ = 0; rr22_ < REPN(22); ++rr22_) {
    { const int dir = wave >> 2, vb0 = (wave & 3) * 2;
      GAS bf16_t* cdst = CLOC + ((size_t)(dir * 32 + bh) * NCH + ch) * 8192;
#pragma unroll
      for (int vbi = 0; vbi < 2; ++vbi) {
          const int vb = vb0 + vbi;
          bf16x8_t af[4];
#pragma unroll
          for (int ls = 0; ls < 4; ++ls) af[ls] = *(const bf16x8_t*)(WV + (dir * 128 + vb * 16 + fr) * 136 + ls * 32 + 8 * fq);
#pragma unroll
          for (int kb = 0; kb < 4; ++kb) {
              f32x4 acc = (f32x4){0.f, 0.f, 0.f, 0.f};
#pragma unroll
              for (int ls = 0; ls < 4; ++ls) { const bf16x8_t bfr = *(const bf16x8_t*)(KT + (kb * 16 + fr) * 136 + ls * 32 + 8 * fq); acc = __builtin_amdgcn_mfma_f32_16x16x32_bf16(bfr, af[ls], acc, 0, 0, 0); }
              { u32x2 o; o.x = pk2(acc[0], acc[1]); o.y = pk2(acc[2], acc[3]); *(GAS u32x2*)(cdst + (vb * 16 + fr) * 64 + kb * 16 + 4 * fq) = o; }
          }
      }
      if (tid < 128) { const int d2 = tid >> 6, k = tid & 63; float sn = 0.f;
          for (int l = 0; l < 128; ++l) sn += wgt[d2 * 128 + l] * bf2f(KT[k * 136 + l]);
          NLOC[((size_t)(d2 * 32 + bh) * NCH + ch) * 64 + k] = sn; }
    }
    }
    __syncthreads();
}
__device__ __forceinline__ void ph3(const Params& p, unsigned char* lds, int bid, int nblk) {
    for (int rep_ = 0; rep_ < REPN(14); ++rep_) for (int it = bid; it < 256; it += nblk) na_item(p, lds, (nblk == 256) ? ((it & 7) * 32 + (it >> 3)) : it);
    {
      float* RTw = (float*)((bf16_t*)lds + 64 * 136 + 132 * 128) + 128 * 129 + 512 + 256; const GAS float* ROPEg = (const GAS float*)(p.ws + WS_ROPE);
      for (int i = threadIdx.x; i < 4096; i += NTHR) RTw[i] = ROPEg[i];
      __syncthreads(); }
    for (int rep_ = 0; rep_ < REPN(15); ++rep_) { StPre pre; if (bid < 32 * NCH) ml_stats_prefetch(p, bid, (int)threadIdx.x, pre);
        for (int it = bid; it < 32 * NCH; it += nblk) ml_stats_item(p, lds, it, pre, it + nblk < 32 * NCH ? it + nblk : -1); }
}

__device__ __forceinline__ void ph4(const Params& p, int bid, int nblk) {
    GAS bf16_t* CLOC = (GAS bf16_t*)(p.ws + WS_CLOC); GAS float* NLOC = (GAS float*)(p.ws + WS_NLOC); const GAS float* MLOC = (const GAS float*)(p.ws + WS_MLOC);
    const GAS float* BLAST = (const GAS float*)(p.ws + WS_BLAST); GAS float* MIN = (GAS float*)(p.ws + WS_MIN);
    const int tid = ltid();
    for (int it = bid; it < 64 * 5; it += nblk) {
        const bool small = it >= 256; const int q = small ? it - 256 : it >> 2, seg = it & 3, dir = q >> 5;
        if (small && tid > 64) continue;
        float c0 = 0.f, c1 = 0.f, c2 = 0.f, c3 = 0.f, m_prev = 0.f;
        GAS bf16_t* cbase = CLOC + (size_t)q * NCH * 8192 + seg * 2048 + tid * 4;
        GAS float* nbase = NLOC + (size_t)q * NCH * 64 + (tid & 63);
        for (int s0 = 0; s0 < NCH; s0 += 22) {
            u32x2 cw[22]; float nv[22], bl[22], ml[22]; int ci[22];
#pragma unroll
            for (int u = 0; u < 22; ++u) { const int step = s0 + u; ci[u] = dir == 0 ? (step < 2 ? 64 + step : step - 2) : 65 - step;
                bl[u] = BLAST[q * NCH + ci[u]]; ml[u] = MLOC[q * NCH + ci[u]];
                if (!small) cw[u] = *(const GAS u32x2*)(cbase + (size_t)ci[u] * 8192); else nv[u] = tid < 64 ? nbase[ci[u] * 64] : 0.f; }
#pragma unroll
            for (int u = 0; u < 22; ++u) {
                const float m_new = fmaxf(bl[u] + m_prev, ml[u]), sp = __expf(bl[u] + m_prev - m_new), sl = __expf(ml[u] - m_new);
                if (!small) { u32x2 o; o.x = pk2(c0, c1); o.y = pk2(c2, c3); *(GAS u32x2*)(cbase + (size_t)ci[u] * 8192) = o;
                    c0 = sp * c0 + sl * bflo(cw[u].x); c1 = sp * c1 + sl * bfhi(cw[u].x); c2 = sp * c2 + sl * bflo(cw[u].y); c3 = sp * c3 + sl * bfhi(cw[u].y); }
                else if (tid < 64) { nbase[ci[u] * 64] = c0; c0 = sp * c0 + sl * nv[u]; }
                else MIN[q * NCH + ci[u]] = m_prev;
                m_prev = m_new;
            }
        }
    }
}

struct MlPre { u32x4 q[2], k[2], v[4], c[2][2]; bf16_t g[4]; float m_in, bi, bf; };
__device__ __forceinline__ void ml_out_prefetch(const Params& p, int item, int tid, MlPre& r) {
    const GAS bf16_t* U = (const GAS bf16_t*)(p.ws + WS_U); const GAS bf16_t* QP = (const GAS bf16_t*)(p.ws + WS_QP); const GAS bf16_t* KP = (const GAS bf16_t*)(p.ws + WS_KP);
    const GAS bf16_t* CLOC = (const GAS bf16_t*)(p.ws + WS_CLOC);
    const int J = item & 63, bh = item >> 6, h = bh & 3, b = bh >> 2; const size_t row0 = (size_t)b * 8192 + J * 128;
#pragma unroll
    for (int i = 0; i < 2; ++i) { const int idx = tid + i * NTHR, rr = idx >> 3, ck = idx & 7;
        r.q[i] = *(const GAS u32x4*)(QP + (row0 + rr) * 256 + h * 64 + ck * 8); r.k[i] = *(const GAS u32x4*)(KP + (row0 + rr) * 256 + h * 64 + ck * 8); }
#pragma unroll
    for (int i = 0; i < 4; ++i) { const int idx = tid + i * NTHR, l = idx & 127, ck = idx >> 7; r.v[i] = *(const GAS u32x4*)(U + (row0 + l) * DINP + C_VM + h * 128 + ck * 8); }
#pragma unroll
    for (int dir = 0; dir < 2; ++dir) { const GAS bf16_t* csrc = CLOC + ((size_t)(dir * 32 + bh) * NCH + J) * 8192;
#pragma unroll
        for (int i = 0; i < 2; ++i) { const int idx = tid + i * NTHR; r.c[dir][i] = *(const GAS u32x4*)(csrc + idx * 8); } }
    if (tid < 128) { const int dir = tid >> 6, lane = tid & 63, l0 = dir == 0 ? 2 * lane : 127 - 2 * lane, l1 = dir == 0 ? 2 * lane + 1 : 126 - 2 * lane;
        const GAS bf16_t* g0 = U + (row0 + l0) * DINP + C_GT + h; const GAS bf16_t* g1 = U + (row0 + l1) * DINP + C_GT + h;
        r.g[0] = g0[dir * 8]; r.g[1] = g0[dir * 8 + 4]; r.g[2] = g1[dir * 8]; r.g[3] = g1[dir * 8 + 4];
        r.m_in = ((const GAS float*)(p.ws + WS_MIN))[(dir * 32 + bh) * NCH + J];
        r.bi = ((const GAS float*)p.b_gate)[dir * 8 + h]; r.bf = ((const GAS float*)p.b_gate)[dir * 8 + 4 + h]; }
}
__device__ __forceinline__ void ml_out_item(const Params& p, unsigned char* lds, int item, MlPre& pre, int next_item) {
    const GAS bf16_t* U = (const GAS bf16_t*)(p.ws + WS_U); const GAS bf16_t* QP = (const GAS bf16_t*)(p.ws + WS_QP); const GAS bf16_t* KP = (const GAS bf16_t*)(p.ws + WS_KP);
    const GAS float* NLOC = (const GAS float*)(p.ws + WS_NLOC); const GAS float* MIN = (const GAS float*)(p.ws + WS_MIN);
    GAS bf16_t* MIX = (GAS bf16_t*)(p.ws + WS_MIX);
    const int tid = ltid(), lane = tid & 63, wave = __builtin_amdgcn_readfirstlane(tid >> 6), fr = lane & 15, fq = lane >> 4;
    const int J = item & 63, bh = item >> 6, h = bh & 3, b = bh >> 2, t0 = J * 128;
    const size_t row0 = (size_t)b * 8192 + t0;
    bf16_t* Qs = (bf16_t*)lds;
    bf16_t* Ks = Qs + 128 * 72;
    bf16_t* VT = Ks + 128 * 72;
    bf16_t* Cs = VT + 128 * 136;
    float* asv = (float*)(Cs + 2 * 128 * 72);
    float* btv = asv + 256;
    float* itv = btv + 256;
    float* emt = itv + 256;
    float* nin = emt + 256;
    float* OST = nin + 128 + wave * (8 * 132);
    for (int r16_ = 0; r16_ < REPN(16); ++r16_) {
    if (wave < 2) {
        const int dir = wave, l0 = dir == 0 ? 2 * lane : 127 - 2 * lane, l1 = dir == 0 ? 2 * lane + 1 : 126 - 2 * lane;
        const float bi = pre.bi, bf_ = pre.bf;
        const float i0 = bf2f(pre.g[0]) + bi, f0 = bf2f(pre.g[1]) + bf_, i1 = bf2f(pre.g[2]) + bi, f1 = bf2f(pre.g[3]) + bf_;
        const float m_in = pre.m_in;
        const float lf0 = logsigf(f0), lf1 = logsigf(f1);
        const float incl = wscan_add(lf0 + lf1, lane), bc0 = incl - lf1, bc1 = incl;
        const float as0 = i0 - bc0, as1 = i1 - bc1;
        const float inclm = wscan_max(fmaxf(as0, as1), lane); float exclm = __shfl_up(inclm, 1); if (lane == 0) exclm = -INFINITY;
        const float gm0 = fmaxf(exclm, as0), gm1 = inclm;
        const float mp0 = bc0 + m_in, mp1 = bc1 + m_in, mt0 = fmaxf(bc0 + gm0, mp0), mt1 = fmaxf(bc1 + gm1, mp1);
        asv[dir * 128 + l0] = as0; asv[dir * 128 + l1] = as1; btv[dir * 128 + l0] = bc0 - mt0; btv[dir * 128 + l1] = bc1 - mt1;
        itv[dir * 128 + l0] = __expf(mp0 - mt0); itv[dir * 128 + l1] = __expf(mp1 - mt1); emt[dir * 128 + l0] = __expf(-mt0); emt[dir * 128 + l1] = __expf(-mt1);
    }
#pragma unroll
    for (int i = 0; i < 2; ++i) { const int idx = tid + i * NTHR, r = idx >> 3, ck = idx & 7; *(u32x4*)(Qs + r * 72 + ck * 8) = pre.q[i]; *(u32x4*)(Ks + r * 72 + ck * 8) = pre.k[i]; }
#pragma unroll
    for (int i = 0; i < 4; ++i) { const int idx = tid + i * NTHR, l = idx & 127, ck = idx >> 7;
        const u32x4 w = pre.v[i]; bf16_t* d = VT + (ck * 8) * 136 + l;
        d[0 * 136] = (bf16_t)(w.x & 0xffffu); d[1 * 136] = (bf16_t)(w.x >> 16); d[2 * 136] = (bf16_t)(w.y & 0xffffu); d[3 * 136] = (bf16_t)(w.y >> 16);
        d[4 * 136] = (bf16_t)(w.z & 0xffffu); d[5 * 136] = (bf16_t)(w.z >> 16); d[6 * 136] = (bf16_t)(w.w & 0xffffu); d[7 * 136] = (bf16_t)(w.w >> 16); }
#pragma unroll
    for (int dir = 0; dir < 2; ++dir)
#pragma unroll
        for (int i = 0; i < 2; ++i) { const int idx = tid + i * NTHR, v = idx >> 3, k8 = idx & 7; *(u32x4*)(Cs + (dir * 128 + v) * 72 + k8 * 8) = pre.c[dir][i]; }
    if (tid < 128) nin[tid] = NLOC[((size_t)((tid >> 6) * 32 + bh) * NCH + J) * 64 + (tid & 63)];
    }
    __syncthreads();
    if (next_item >= 0) ml_out_prefetch(p, next_item, tid, pre);
    const int tb = wave;
    bf16x8_t qf[2];
#pragma unroll
    for (int ks = 0; ks < 2; ++ks) qf[ks] = *(const bf16x8_t*)(Qs + (16 * tb + fr) * 72 + ks * 32 + 8 * fq);
    f32x4 hs[8];
    for (int r17_ = 0; r17_ < REPN(17); ++r17_) {
#pragma unroll
    for (int vb = 0; vb < 8; ++vb) hs[vb] = (f32x4){0.f, 0.f, 0.f, 0.f};
#pragma unroll
    for (int dir = 0; dir < 2; ++dir) {
        f32x4 acc[8];
#pragma unroll
        for (int vb = 0; vb < 8; ++vb) { acc[vb] = (f32x4){0.f, 0.f, 0.f, 0.f};
#pragma unroll
            for (int ks = 0; ks < 2; ++ks) { const bf16x8_t cf = *(const bf16x8_t*)(Cs + (dir * 128 + vb * 16 + fr) * 72 + ks * 32 + 8 * fq); acc[vb] = __builtin_amdgcn_mfma_f32_16x16x32_bf16(qf[ks], cf, acc[vb], 0, 0, 0); } }
        { const f32x4 i4 = *(const f32x4*)(itv + dir * 128 + 16 * tb + 4 * fq);
#pragma unroll
          for (int vb = 0; vb < 8; ++vb) acc[vb] = acc[vb] * i4; }
        const float bt = btv[dir * 128 + 16 * tb + fr];
        float rowsum = 0.f;
#pragma unroll
        for (int pr = 0; pr < 4; ++pr) {
            const int sb0 = 2 * pr, sb1 = 2 * pr + 1;
            const bool need0 = dir == 0 ? (sb0 <= tb) : (sb0 >= tb), need1 = dir == 0 ? (sb1 <= tb) : (sb1 >= tb);
            if (!need0 && !need1) continue;
            f32x4 s0 = (f32x4){0.f, 0.f, 0.f, 0.f}, s1 = (f32x4){0.f, 0.f, 0.f, 0.f};
            if (need0) {
#pragma unroll
                for (int ks = 0; ks < 2; ++ks) { const bf16x8_t kf = *(const bf16x8_t*)(Ks + (16 * sb0 + fr) * 72 + ks * 32 + 8 * fq); s0 = __builtin_amdgcn_mfma_f32_16x16x32_bf16(kf, qf[ks], s0, 0, 0, 0); }
                const f32x4 a4 = *(const f32x4*)(asv + dir * 128 + 16 * sb0 + 4 * fq);
#pragma unroll
                for (int j = 0; j < 4; ++j) { const bool valid = (sb0 != tb) || (dir == 0 ? (4 * fq + j <= fr) : (4 * fq + j >= fr)); s0[j] = valid ? s0[j] * __expf(bt + a4[j]) : 0.f; }
            }
            if (need1) {
#pragma unroll
                for (int ks = 0; ks < 2; ++ks) { const bf16x8_t kf = *(const bf16x8_t*)(Ks + (16 * sb1 + fr) * 72 + ks * 32 + 8 * fq); s1 = __builtin_amdgcn_mfma_f32_16x16x32_bf16(kf, qf[ks], s1, 0, 0, 0); }
                const f32x4 a4 = *(const f32x4*)(asv + dir * 128 + 16 * sb1 + 4 * fq);
#pragma unroll
                for (int j = 0; j < 4; ++j) { const bool valid = (sb1 != tb) || (dir == 0 ? (4 * fq + j <= fr) : (4 * fq + j >= fr)); s1[j] = valid ? s1[j] * __expf(bt + a4[j]) : 0.f; }
            }
            rowsum += (s0[0] + s0[1]) + (s0[2] + s0[3]) + (s1[0] + s1[1]) + (s1[2] + s1[3]);
            u32x4 pw; pw.x = cvtpk(s0[0], s0[1]); pw.y = cvtpk(s0[2], s0[3]); pw.z = cvtpk(s1[0], s1[1]); pw.w = cvtpk(s1[2], s1[3]);
            const bf16x8_t pa = __builtin_bit_cast(bf16x8_t, pw);
#pragma unroll
            for (int vb = 0; vb < 8; ++vb) {
                const u32x2 v0 = *(const u32x2*)(VT + (vb * 16 + fr) * 136 + 16 * sb0 + 4 * fq), v1 = *(const u32x2*)(VT + (vb * 16 + fr) * 136 + 16 * sb1 + 4 * fq);
                const u32x4 vw = (u32x4){v0.x, v0.y, v1.x, v1.y};
                acc[vb] = __builtin_amdgcn_mfma_f32_16x16x32_bf16(pa, __builtin_bit_cast(bf16x8_t, vw), acc[vb], 0, 0, 0);
            }
        }
        rowsum += __shfl_xor(rowsum, 16); rowsum += __shfl_xor(rowsum, 32);
        float nq = 0.f;
        { const u32x4 qa = *(const u32x4*)(Qs + (16 * tb + fr) * 72 + 16 * fq), qb = *(const u32x4*)(Qs + (16 * tb + fr) * 72 + 16 * fq + 8); const float* nn = nin + dir * 64 + 16 * fq;
          nq = nn[0] * bflo(qa.x) + nn[1] * bfhi(qa.x) + nn[2] * bflo(qa.y) + nn[3] * bfhi(qa.y) + nn[4] * bflo(qa.z) + nn[5] * bfhi(qa.z) + nn[6] * bflo(qa.w) + nn[7] * bfhi(qa.w)
             + nn[8] * bflo(qb.x) + nn[9] * bfhi(qb.x) + nn[10] * bflo(qb.y) + nn[11] * bfhi(qb.y) + nn[12] * bflo(qb.z) + nn[13] * bfhi(qb.z) + nn[14] * bflo(qb.w) + nn[15] * bfhi(qb.w); }
        nq += __shfl_xor(nq, 16); nq += __shfl_xor(nq, 32);
        const float den = rowsum + itv[dir * 128 + 16 * tb + fr] * nq;
        const float rdn = 1.f / fmaxf(fabsf(den), emt[dir * 128 + 16 * tb + fr]);
#pragma unroll
        for (int j = 0; j < 4; ++j) { const float r = __shfl(rdn, 4 * fq + j);
#pragma unroll
            for (int vb = 0; vb < 8; ++vb) hs[vb][j] += acc[vb][j] * r; }
    }
    }
    float mu[4], rs[4];
#pragma unroll
    for (int j = 0; j < 4; ++j) { float sm = 0.f;
#pragma unroll
        for (int vb = 0; vb < 8; ++vb) sm += hs[vb][j];
        sm += __shfl_xor(sm, 1); sm += __shfl_xor(sm, 2); sm += __shfl_xor(sm, 4); sm += __shfl_xor(sm, 8);
        mu[j] = sm * (1.f / 128.f); float sq = 0.f;
#pragma unroll
        for (int vb = 0; vb < 8; ++vb) { const float d = hs[vb][j] - mu[j]; sq += d * d; }
        sq += __shfl_xor(sq, 1); sq += __shfl_xor(sq, 2); sq += __shfl_xor(sq, 4); sq += __shfl_xor(sq, 8);
        rs[j] = rsqrtf(sq * (1.f / 128.f) + LN_EPS); }
    const GAS float* mng = (const GAS float*)p.ml_norm_g + h * 128;
    for (int r18_ = 0; r18_ < REPN(18); ++r18_) {
#pragma unroll
    for (int ps = 0; ps < 2; ++ps) {
#pragma unroll
        for (int vb = 0; vb < 8; ++vb) { const float gg = mng[vb * 16 + fr];
#pragma unroll
            for (int jj = 0; jj < 2; ++jj) { const int j = 2 * ps + jj; OST[(2 * fq + jj) * 132 + vb * 16 + fr] = (hs[vb][j] - mu[j]) * rs[j] * gg; } }
        LDS_FENCE();
        { const int rl = lane >> 3, ck = lane & 7, t = 16 * tb + 4 * (rl >> 1) + 2 * ps + (rl & 1);
          const float* src = OST + rl * 132 + ck * 16;
          const f32x4 o0 = *(const f32x4*)src, o1 = *(const f32x4*)(src + 4), o2 = *(const f32x4*)(src + 8), o3 = *(const f32x4*)(src + 12);
          const GAS bf16_t* omp = U + (row0 + t) * DINP + C_OM + h * 128 + ck * 16;
          const u32x4 oa = *(const GAS u32x4*)omp, ob = *(const GAS u32x4*)(omp + 8);
          u32x4 wa, wb;
          wa.x = pk2(o0.x * sigmoidf_(bflo(oa.x)), o0.y * sigmoidf_(bfhi(oa.x))); wa.y = pk2(o0.z * sigmoidf_(bflo(oa.y)), o0.w * sigmoidf_(bfhi(oa.y)));
          wa.z = pk2(o1.x * sigmoidf_(bflo(oa.z)), o1.y * sigmoidf_(bfhi(oa.z))); wa.w = pk2(o1.z * sigmoidf_(bflo(oa.w)), o1.w * sigmoidf_(bfhi(oa.w)));
          wb.x = pk2(o2.x * sigmoidf_(bflo(ob.x)), o2.y * sigmoidf_(bfhi(ob.x))); wb.y = pk2(o2.z * sigmoidf_(bflo(ob.y)), o2.w * sigmoidf_(bfhi(ob.y)));
          wb.z = pk2(o3.x * sigmoidf_(bflo(ob.z)), o3.y * sigmoidf_(bfhi(ob.z))); wb.w = pk2(o3.z * sigmoidf_(bflo(ob.w)), o3.w * sigmoidf_(bfhi(ob.w)));
          GAS bf16_t* dst = MIX + (row0 + t) * 1024 + 512 + h * 128 + ck * 16;
          *(GAS u32x4*)dst = wa; *(GAS u32x4*)(dst + 8) = wb; }
        LDS_FENCE();
    }
    }
    __syncthreads();
}
__device__ __forceinline__ void ph5(const Params& p, unsigned char* lds, int bid, int nblk) {
    MlPre pre; const int tid0 = threadIdx.x;
    if (bid < 32 * 64) ml_out_prefetch(p, bid, tid0, pre);
    for (int it = bid; it < 32 * 64; it += nblk) ml_out_item(p, lds, it, pre, it + nblk < 32 * 64 ? it + nblk : -1);
}


struct TrItem { const GAS float* W; GAS unsigned char* WT; size_t orow0; int N, k0, n0, ldt; float qs; };
constexpr int CONV_ALL = NE * 3 * 704, CONV_EARLY_E = 7, CONV_EARLY = CONV_EARLY_E * 704;
__device__ __forceinline__ TrItem tr_decode(const Params& p, int it) {
    TrItem t; int e, which, q;
    if (it < CONV_EARLY) { e = it / 704; q = it % 704; which = 2; }
    else { const int i2 = it - CONV_EARLY;
        if (i2 < NE * 2 * 704) { e = i2 / (2 * 704); const int r = i2 % (2 * 704); which = r / 704; q = r % 704; }
        else { const int i3 = i2 - NE * 2 * 704; e = CONV_EARLY_E + i3 / 704; q = i3 % 704; which = 2; } }
    if (which < 2) { const int kb = q / 88, nb = q % 88; t.n0 = nb * 32; t.k0 = kb * 128; t.W = (const GAS float*)(which == 0 ? p.w_eg : p.w_eu) + (size_t)e * 1024 * DFF; t.N = DFF;
        t.WT = (GAS unsigned char*)(p.ws + WS_WGUT) + (size_t)e * 2 * DFF * 1024; t.orow0 = (size_t)((t.n0 >> 7) * 256 + which * 128 + (t.n0 & 127)); t.ldt = 1024; t.qs = 32.f; }
    else { const int kb = q / 32, nb = q % 32; t.n0 = nb * 32; t.k0 = kb * 128; t.W = (const GAS float*)p.w_ed + (size_t)e * DFF * 1024; t.N = 1024;
        t.WT = (GAS unsigned char*)(p.ws + WS_WDT) + (size_t)e * 1024 * DFF; t.orow0 = (size_t)t.n0; t.ldt = DFF; t.qs = 64.f; }
    return t;
}
__device__ __forceinline__ void tr_load(const TrItem& t, int lane, f32x4 (&v)[16]) {
    const int cq = (lane & 7) * 4, rq = lane >> 3;
#pragma unroll
    for (int i = 0; i < 16; ++i) v[i] = __builtin_nontemporal_load((const GAS f32x4*)(t.W + (size_t)(t.k0 + 8 * i + rq) * t.N + t.n0 + cq));
}
__device__ __forceinline__ void tr_to_lds(const TrItem& t, int lane, const f32x4 (&v)[16], float* scr) {
    const int cq = (lane & 7) * 4, rq = lane >> 3;
#pragma unroll
    for (int i = 0; i < 16; ++i) { float* d = scr + (8 * i + rq) * 33 + cq; d[0] = v[i].x * t.qs; d[1] = v[i].y * t.qs; d[2] = v[i].z * t.qs; d[3] = v[i].w * t.qs; }
    LDS_FENCE();
}
__device__ __forceinline__ void tr_store(const TrItem& t, int lane, const float* scr) {
    const int n = lane & 31;
#pragma unroll
    for (int j = 0; j < 4; ++j) {
        const int c = (lane >> 5) + 2 * j; const float* sp = scr + (16 * c) * 33 + n;
        u32x4 o; o.x = pk4_fp8(sp[0 * 33], sp[1 * 33], sp[2 * 33], sp[3 * 33]); o.y = pk4_fp8(sp[4 * 33], sp[5 * 33], sp[6 * 33], sp[7 * 33]);
        o.z = pk4_fp8(sp[8 * 33], sp[9 * 33], sp[10 * 33], sp[11 * 33]); o.w = pk4_fp8(sp[12 * 33], sp[13 * 33], sp[14 * 33], sp[15 * 33]);
        *(GAS u32x4*)(t.WT + (t.orow0 + n) * t.ldt + t.k0 + 16 * c) = o;
    }
    LDS_FENCE();
}
__device__ __forceinline__ float reduce16(const float (&lg)[16], int lane) {
    float a8[8], a4[4], a2[2];
    const bool h5 = lane & 32, h4 = lane & 16, h3 = lane & 8, h2 = lane & 4;
#pragma unroll
    for (int i = 0; i < 8; ++i) { const float snd = h5 ? lg[i] : lg[8 + i], kp = h5 ? lg[8 + i] : lg[i]; a8[i] = kp + __shfl_xor(snd, 32); }
#pragma unroll
    for (int i = 0; i < 4; ++i) { const float snd = h4 ? a8[i] : a8[4 + i], kp = h4 ? a8[4 + i] : a8[i]; a4[i] = kp + __shfl_xor(snd, 16); }
#pragma unroll
    for (int i = 0; i < 2; ++i) { const float snd = h3 ? a4[i] : a4[2 + i], kp = h3 ? a4[2 + i] : a4[i]; a2[i] = kp + __shfl_xor(snd, 8); }
    const float snd = h2 ? a2[0] : a2[1], kp = h2 ? a2[1] : a2[0];
    float d = kp + __shfl_xor(snd, 4);
    d += __shfl_xor(d, 2); d += __shfl_xor(d, 1);
    return d;
}
__device__ __forceinline__ void ph7(const Params& p, unsigned char* lds, int bid, int nblk) {
    const int tid = ltid(), lane = tid & 63, wave = tid >> 6;
    const GAS float* MOD = (const GAS float*)(p.ws + WS_MOD); GAS unsigned char* HMOD = (GAS unsigned char*)(p.ws + WS_HMOD); GAS float* AFF = (GAS float*)(p.ws + WS_AFF);
    const GAS bf16_t* Y = (const GAS bf16_t*)(p.ws + WS_Y); const GAS float* ln1g = (const GAS float*)p.ln1_g; const GAS float* ln1b = (const GAS float*)p.ln1_b;
    const int gw = bid * NWAVES + wave, ngw = nblk * NWAVES;
    __syncthreads();
    float* WR = (float*)lds; float* RED = WR + 16 * 1028;
    { const GAS float* wr = (const GAS float*)p.w_router; for (int idx = tid; idx < 16 * 1024; idx += NTHR) { const int k = idx >> 4, e = idx & 15; WR[e * 1028 + k] = wr[idx]; } }
    __syncthreads();
    for (int rep12_ = 0; rep12_ < REPN(12); ++rep12_) {
    u32x2 vn[2][4];
    if (2 * gw < NLAT) {
#pragma unroll
        for (int r = 0; r < 2; ++r)
#pragma unroll
            for (int j = 0; j < 4; ++j) vn[r][j] = *(const GAS u32x2*)(Y + (size_t)(2 * gw + r) * 1024 + j * 256 + lane * 4); }
    f32x4 qg[4], qb[4], qa[4], qs[4]; int bcur = -1;
#pragma unroll
    for (int j = 0; j < 4; ++j) { const int k = j * 256 + lane * 4; qg[j] = *(const GAS f32x4*)(ln1g + k); qb[j] = *(const GAS f32x4*)(ln1b + k); qa[j] = qg[j]; qs[j] = qg[j]; }
    for (int m0 = 2 * gw; m0 < NLAT; m0 += 2 * ngw) {
        asm volatile("" ::: "memory");
        const int b = m0 >> 13;
        const GAS float* sh2 = MOD + b * 6144 + 3072; const GAS float* sc2 = sh2 + 1024;
        if (b != bcur) { bcur = b;
#pragma unroll
            for (int j = 0; j < 4; ++j) { const int k = j * 256 + lane * 4; qa[j] = *(const GAS f32x4*)(sc2 + k) + 1.f; qs[j] = *(const GAS f32x4*)(sh2 + k); } }
        f32x4 v[2][4]; float mean[2], rstd[2];
#pragma unroll
        for (int r = 0; r < 2; ++r)
#pragma unroll
            for (int j = 0; j < 4; ++j) v[r][j] = (f32x4){hlo(vn[r][j].x), hhi(vn[r][j].x), hlo(vn[r][j].y), hhi(vn[r][j].y)};
        if (m0 + 2 * ngw < NLAT) {
#pragma unroll
            for (int r = 0; r < 2; ++r)
#pragma unroll
                for (int j = 0; j < 4; ++j) vn[r][j] = *(const GAS u32x2*)(Y + (size_t)(m0 + 2 * ngw + r) * 1024 + j * 256 + lane * 4); }
#pragma unroll
        for (int r = 0; r < 2; ++r) { float sm = 0.f;
#pragma unroll
            for (int j = 0; j < 4; ++j) sm += (v[r][j].x + v[r][j].y) + (v[r][j].z + v[r][j].w);
            mean[r] = wave_sum(sm) * (1.f / 1024.f); float s2 = 0.f;
#pragma unroll
            for (int j = 0; j < 4; ++j) { v[r][j] = v[r][j] - mean[r]; s2 += (v[r][j].x * v[r][j].x + v[r][j].y * v[r][j].y) + (v[r][j].z * v[r][j].z + v[r][j].w * v[r][j].w); }
            rstd[r] = rsqrtf(wave_sum(s2) * (1.f / 1024.f) + LN_EPS); }
        f32x4 hm[2][4];
#pragma unroll
        for (int j = 0; j < 4; ++j) {
            const int k = j * 256 + lane * 4;
#pragma unroll
            for (int r = 0; r < 2; ++r) { hm[r][j] = (v[r][j] * rstd[r] * qg[j] + qb[j]) * qa[j] + qs[j];
                *(GAS unsigned*)(HMOD + (size_t)(m0 + r) * 1024 + k) = pk4_fp8(hm[r][j].x, hm[r][j].y, hm[r][j].z, hm[r][j].w); }
        }
        float* red = RED + wave * (2 * 64 * 17);
#pragma unroll
        for (int e4 = 0; e4 < 4; ++e4) {
            float a[2][4];
#pragma unroll
            for (int ee = 0; ee < 4; ++ee) {
                f32x4 a0 = {0.f, 0.f, 0.f, 0.f}, a1 = {0.f, 0.f, 0.f, 0.f};
#pragma unroll
                for (int j = 0; j < 4; ++j) { const f32x4 w = *(const f32x4*)(WR + (e4 * 4 + ee) * 1028 + j * 256 + lane * 4);
                    a0 = __builtin_elementwise_fma(hm[0][j], w, a0); a1 = __builtin_elementwise_fma(hm[1][j], w, a1); }
                a[0][ee] = (a0.x + a0.y) + (a0.z + a0.w); a[1][ee] = (a1.x + a1.y) + (a1.z + a1.w);
            }
#pragma unroll
            for (int ee = 0; ee < 4; ++ee) { red[lane * 17 + e4 * 4 + ee] = a[0][ee]; red[64 * 17 + lane * 17 + e4 * 4 + ee] = a[1][ee]; }
            asm volatile("" ::: "memory");
        }
        LDS_FENCE();
        { const int e = lane & 15, r = (lane >> 4) & 1, part = lane >> 5;
          float d = 0.f; const float* src = red + r * (64 * 17) + e + part * 32 * 17;
#pragma unroll 8
          for (int l = 0; l < 32; ++l) d += src[l * 17];
          d += __shfl_xor(d, 32);
          float mx = d; mx = fmaxf(mx, __shfl_xor(mx, 1)); mx = fmaxf(mx, __shfl_xor(mx, 2)); mx = fmaxf(mx, __shfl_xor(mx, 4)); mx = fmaxf(mx, __shfl_xor(mx, 8));
          const float ex = expf(d - mx); float sm = ex; sm += __shfl_xor(sm, 1); sm += __shfl_xor(sm, 2); sm += __shfl_xor(sm, 4); sm += __shfl_xor(sm, 8);
          if (lane < 32) AFF[((size_t)b * 16 + e) * 8192 + ((m0 + r) & 8191)] = ex / sm; }
        LDS_FENCE();
    }
    }
}
__device__ __forceinline__ void ph7m(const Params& p, unsigned char* lds, int bid, int nblk) {
    const int tid = ltid(), lane = tid & 63, wave = tid >> 6, r = lane & 15, kq = lane >> 4;
    const GAS float* MOD = (const GAS float*)(p.ws + WS_MOD); GAS unsigned char* HMOD = (GAS unsigned char*)(p.ws + WS_HMOD); GAS float* AFF = (GAS float*)(p.ws + WS_AFF);
    const GAS bf16_t* Y = (const GAS bf16_t*)(p.ws + WS_Y); const GAS float* ln1g = (const GAS float*)p.ln1_g; const GAS float* ln1b = (const GAS float*)p.ln1_b;
    bf16_t* WH = (bf16_t*)lds;
    bf16_t* WL = WH + 16 * 1032;
    float* GP = (float*)(WL + 16 * 1032);
    float* BP = GP + 1024;
    __syncthreads();
    { const GAS float* wr = (const GAS float*)p.w_router;
      float wv[32];
#pragma unroll
      for (int i = 0; i < 32; ++i) wv[i] = wr[tid + i * NTHR];
#pragma unroll
      for (int i = 0; i < 32; ++i) { const int idx = tid + i * NTHR, k = idx >> 4, e = idx & 15; const float w = wv[i]; const unsigned hi = f2bf(w);
          WH[e * 1032 + k] = (bf16_t)hi; WL[e * 1032 + k] = (bf16_t)f2bf(w - __uint_as_float(hi << 16)); } }
    int bcur = -1;
    for (int row0 = bid * 128; row0 < NLAT; row0 += nblk * 128) {
        const int b = row0 >> 13;
        if (b != bcur) { bcur = b; __syncthreads();
            const GAS float* sh2 = MOD + b * 6144 + 3072; const GAS float* sc2 = sh2 + 1024;
            for (int k = tid; k < 1024; k += NTHR) { const float a = 1.f + sc2[k]; GP[k] = ln1g[k] * a; BP[k] = ln1b[k] * a + sh2[k]; }
            __syncthreads(); }
        const int R = row0 + wave * 16 + r;
        const GAS bf16_t* yrow = Y + (size_t)R * 1024 + 32 * kq;
        float sm, sq;
        { u32x4 xp[32];
#pragma unroll
          for (int i = 0; i < 32; ++i) xp[i] = *(const GAS u32x4*)(yrow + 128 * (i >> 2) + 8 * (i & 3));
          f32x2_ s2 = {0.f, 0.f}, q2 = {0.f, 0.f};
#pragma unroll
          for (int i = 0; i < 32; ++i) { const f32x2_ a = h2f(xp[i].x), b2 = h2f(xp[i].y), c2 = h2f(xp[i].z), d2 = h2f(xp[i].w);
              s2 += (a + b2) + (c2 + d2); q2 = __builtin_elementwise_fma(a, a, q2); q2 = __builtin_elementwise_fma(b2, b2, q2); q2 = __builtin_elementwise_fma(c2, c2, q2); q2 = __builtin_elementwise_fma(d2, d2, q2); }
          sm = s2.x + s2.y; sq = q2.x + q2.y; }
        asm volatile("" ::: "memory");
        u32x4 cur[4];
#pragma unroll
        for (int s2 = 0; s2 < 4; ++s2) cur[s2] = *(const GAS u32x4*)(yrow + 8 * s2);
        sm += __shfl_xor(sm, 16); sm += __shfl_xor(sm, 32); sq += __shfl_xor(sq, 16); sq += __shfl_xor(sq, 32);
        const float mean = sm * (1.f / 1024.f), rstd = rsqrtf(fmaxf(sq * (1.f / 1024.f) - mean * mean, 0.f) + LN_EPS), mr = mean * rstd;
        f32x4 acc = (f32x4){0.f, 0.f, 0.f, 0.f};
        GAS unsigned char* hrow = HMOD + (size_t)R * 1024 + 32 * kq;
#pragma unroll 1
        for (int I = 0; I < 8; ++I) {
            u32x4 nxt[4];
            { const int In = I < 7 ? I + 1 : 7;
#pragma unroll
              for (int s2 = 0; s2 < 4; ++s2) nxt[s2] = *(const GAS u32x4*)(yrow + 128 * In + 8 * s2); }
            unsigned f8[8];
#pragma unroll
            for (int s2 = 0; s2 < 4; ++s2) { const int k0 = 128 * I + 32 * kq + 8 * s2;
                const f32x4 g0 = *(const f32x4*)(GP + k0), g1 = *(const f32x4*)(GP + k0 + 4), c0 = *(const f32x4*)(BP + k0), c1 = *(const f32x4*)(BP + k0 + 4);
                const u32x4 xw = cur[s2];
                const f32x4 xa = (f32x4){hlo(xw.x), hhi(xw.x), hlo(xw.y), hhi(xw.y)}, xb = (f32x4){hlo(xw.z), hhi(xw.z), hlo(xw.w), hhi(xw.w)};
                const f32x4 ha = (xa * rstd - mr) * g0 + c0, hb = (xb * rstd - mr) * g1 + c1;
                u32x4 bh, bl;
                bh.x = cvtpk(ha[0], ha[1]); bh.y = cvtpk(ha[2], ha[3]); bh.z = cvtpk(hb[0], hb[1]); bh.w = cvtpk(hb[2], hb[3]);
                bl.x = cvtpk(ha[0] - bflo(bh.x), ha[1] - bfhi(bh.x)); bl.y = cvtpk(ha[2] - bflo(bh.y), ha[3] - bfhi(bh.y));
                bl.z = cvtpk(hb[0] - bflo(bh.z), hb[1] - bfhi(bh.z)); bl.w = cvtpk(hb[2] - bflo(bh.w), hb[3] - bfhi(bh.w));
                const bf16x8_t ah = *(const bf16x8_t*)(WH + r * 1032 + k0), al = *(const bf16x8_t*)(WL + r * 1032 + k0);
                acc = __builtin_amdgcn_mfma_f32_16x16x32_bf16(ah, __builtin_bit_cast(bf16x8_t, bh), acc, 0, 0, 0);
                acc = __builtin_amdgcn_mfma_f32_16x16x32_bf16(ah, __builtin_bit_cast(bf16x8_t, bl), acc, 0, 0, 0);
                acc = __builtin_amdgcn_mfma_f32_16x16x32_bf16(al, __builtin_bit_cast(bf16x8_t, bh), acc, 0, 0, 0);
                f8[2 * s2] = pk4_fp8(ha[0], ha[1], ha[2], ha[3]); f8[2 * s2 + 1] = pk4_fp8(hb[0], hb[1], hb[2], hb[3]); }
            *(GAS u32x4*)(hrow + 128 * I) = (u32x4){f8[0], f8[1], f8[2], f8[3]}; *(GAS u32x4*)(hrow + 128 * I + 16) = (u32x4){f8[4], f8[5], f8[6], f8[7]};
#pragma unroll
            for (int s2 = 0; s2 < 4; ++s2) cur[s2] = nxt[s2];
        }
        float mx = fmaxf(fmaxf(acc[0], acc[1]), fmaxf(acc[2], acc[3])); mx = fmaxf(mx, __shfl_xor(mx, 16)); mx = fmaxf(mx, __shfl_xor(mx, 32));
        const float e0 = expf(acc[0] - mx), e1 = expf(acc[1] - mx), e2 = expf(acc[2] - mx), e3 = expf(acc[3] - mx);
        float sx = (e0 + e1) + (e2 + e3); sx += __shfl_xor(sx, 16); sx += __shfl_xor(sx, 32);
        const float inv = 1.f / sx; GAS float* ap = AFF + ((size_t)b * 16 + 4 * kq) * 8192 + (R & 8191);
        ap[0] = e0 * inv; ap[8192] = e1 * inv; ap[2 * 8192] = e2 * inv; ap[3 * 8192] = e3 * inv;
    }
    __syncthreads();
}
__device__ __forceinline__ void ph7_conv(const Params& p, unsigned char* lds, int it0, int it1, int gw0, int ngw) {
    const int tid = ltid(), lane = tid & 63, wave = tid >> 6;
    const int gw = it0 + gw0 + wave;
    float* scr = (float*)lds + wave * (128 * 33);
    for (int rep13_ = 0; rep13_ < REPN(13); ++rep13_) {
        f32x4 ta[16], tb[16]; int it = gw;
        if (it < it1) { const TrItem c0 = tr_decode(p, it); tr_load(c0, lane, ta); }
        if (it + ngw < it1) { const TrItem c1 = tr_decode(p, it + ngw); tr_load(c1, lane, tb); }
        for (; it < it1; it += 2 * ngw) {
            { const TrItem cur = tr_decode(p, it);
              tr_to_lds(cur, lane, ta, scr);
              if (it + 2 * ngw < it1) { const TrItem nx = tr_decode(p, it + 2 * ngw); tr_load(nx, lane, ta); }
              tr_store(cur, lane, scr); }
            if (it + ngw < it1) { const TrItem cur = tr_decode(p, it + ngw);
              tr_to_lds(cur, lane, tb, scr);
              if (it + 3 * ngw < it1) { const TrItem nx = tr_decode(p, it + 3 * ngw); tr_load(nx, lane, tb); }
              tr_store(cur, lane, scr); }
        }
    }
    __syncthreads();
}

__device__ __forceinline__ void topk_item(const Params& p, unsigned char* lds, int item) {
    const float* AFF = (const float*)(p.ws + WS_AFF); int* IDX = (int*)(p.ws + WS_IDX); float* GSEL = (float*)(p.ws + WS_GSEL); int* INV = (int*)(p.ws + WS_INV);
    const int tid = ltid(), lane = tid & 63, wave = tid >> 6;
    const int b = item >> 4, e = item & 15;
    unsigned* wcnt = (unsigned*)lds;
    const float* a = AFF + ((size_t)b * 16 + e) * 8192;
    unsigned bits[16];
#pragma unroll
    for (int j = 0; j < 16; ++j) bits[j] = __float_as_uint(a[j * 512 + tid]);
    __syncthreads();
    unsigned tau = 0u;
    for (int bit = 29; bit >= 0; --bit) {
        const unsigned cand = tau | (1u << bit);
        unsigned cnt = 0;
#pragma unroll
        for (int j = 0; j < 16; ++j) cnt += (unsigned)__popcll(__ballot(bits[j] >= cand));
        unsigned* slot = wcnt + ((bit & 1) << 3);
        if (lane == 0) slot[wave] = cnt;
        __syncthreads();
        unsigned tot = 0;
#pragma unroll
        for (int w = 0; w < 8; ++w) tot += slot[w];
        if (tot >= (unsigned)CAP) tau = cand;
    }
    unsigned* ctab = wcnt + 32;
    const unsigned long long lt_mask = (1ull << lane) - 1ull;
#pragma unroll
    for (int j = 0; j < 16; ++j) { const unsigned cw = (unsigned)__popcll(__ballot(bits[j] > tau)) | ((unsigned)__popcll(__ballot(bits[j] == tau)) << 16);
        if (lane == 0) ctab[j * 8 + wave] = cw; }
    __syncthreads();
    unsigned ngt = 0;
#pragma unroll
    for (int j = 0; j < 16; ++j)
#pragma unroll
        for (int w = 0; w < 8; ++w) ngt += ctab[j * 8 + w] & 0xffffu;
    const unsigned need = (unsigned)CAP - ngt;
    unsigned base_gt = 0, base_eq = 0;
#pragma unroll
    for (int j = 0; j < 16; ++j) {
        const bool gt = bits[j] > tau, eq = bits[j] == tau;
        const unsigned long long bg = __ballot(gt), be = __ballot(eq);
        unsigned pgt = 0, peq = 0, tgt = 0, teq = 0;
#pragma unroll
        for (int w = 0; w < 8; ++w) { const unsigned cw = ctab[j * 8 + w], cg_ = cw & 0xffffu, ce = cw >> 16; if (w < wave) { pgt += cg_; peq += ce; } tgt += cg_; teq += ce; }
        const unsigned gt_before = base_gt + pgt + (unsigned)__popcll(bg & lt_mask), eq_before = base_eq + peq + (unsigned)__popcll(be & lt_mask);
        const bool sel = gt || (eq && eq_before < need);
        const unsigned slot = gt_before + (eq_before < need ? eq_before : need);
        const int i = j * 512 + tid;
        if (sel) { IDX[(e * 8 + b) * CAP + slot] = i; GSEL[(e * 8 + b) * CAP + slot] = __uint_as_float(bits[j]); }
        INV[((size_t)b * 8192 + i) * 16 + e] = sel ? (int)slot : -1;
        base_gt += tgt; base_eq += teq;
    }
    __syncthreads();
}
__device__ __forceinline__ void ph8(const Params& p, unsigned char* lds, int bid, int nblk) { for (int it = bid; it < 128; it += nblk) topk_item(p, lds, it); }


#define XB_TMO      128
#define XB_XCNT(j)  (256  + 64 * (j))
#define XB_XSUB(j)  (1280 + 64 * (j))
#define XB_XGEN(j)  (2304 + 64 * (j))
#define XB_TOP      3328
#define XB_TOPGEN   3392
#define XCD_BAR_WORDS 3456
#define XB_SPIN_CAP (1u << 18)
__device__ __forceinline__ unsigned xb_ld(unsigned* p)              { return __hip_atomic_load(p, __ATOMIC_RELAXED, __HIP_MEMORY_SCOPE_AGENT); }
__device__ __forceinline__ unsigned xb_add(unsigned* p, unsigned v) { return __hip_atomic_fetch_add(p, v, __ATOMIC_RELAXED, __HIP_MEMORY_SCOPE_AGENT); }
__device__ __forceinline__ unsigned xb_xcc_id() { return (unsigned)__builtin_amdgcn_s_getreg((3 << 11) | 20) & 0xFu; }
#define XB_SPIN(cond, bar) do { unsigned _sp = 0; while (cond) { __builtin_amdgcn_s_sleep(1); \
    if ((++_sp & 255u) == 0u) { if (xb_ld(&(bar)[XB_TMO])) break; if (_sp > XB_SPIN_CAP) { atomicAdd(&(bar)[XB_TMO], 1u); break; } } } } while (0)
struct XcdBarrier { unsigned* bar; unsigned x; volatile LAS unsigned* st; };
__device__ __forceinline__ XcdBarrier xcd_barrier_post(unsigned* bar, volatile LAS unsigned* st) {
    XcdBarrier b; b.bar = bar; b.x = xb_xcc_id(); b.st = st;
    if (threadIdx.x == 0) (void)xb_add(&bar[XB_XCNT(b.x)], 1u);
    return b;
}
__device__ __forceinline__ void xcd_barrier_complete(unsigned* bar, unsigned x, unsigned& nloc, unsigned& nx) {
    const unsigned G = gridDim.x * gridDim.y * gridDim.z;
    unsigned sum, cnt, mine, sp = 0u;
    for (;;) {
        sum = 0u; cnt = 0u; mine = 0u;
#pragma unroll
        for (unsigned j = 0; j < 16; ++j) { const unsigned c = xb_ld(&bar[XB_XCNT(j)]); sum += c; cnt += (c > 0u) ? 1u : 0u; mine = (j == x) ? c : mine; }
        if (sum == G) break;
        __builtin_amdgcn_s_sleep(1);
        if ((++sp & 255u) == 0u) { if (xb_ld(&bar[XB_TMO])) break; if (sp > XB_SPIN_CAP) { atomicAdd(&bar[XB_TMO], 1u); break; } }
    }
    nloc = mine > 0u ? mine : 1u; nx = cnt > 0u ? cnt : 1u;
}
__device__ __forceinline__ void xcd_barrier(const XcdBarrier& b) {
    asm volatile("s_waitcnt vmcnt(0)" ::: "memory");
    __syncthreads();
    if (threadIdx.x == 0) {
        unsigned* bar = b.bar;
        __builtin_amdgcn_s_waitcnt(0);
        unsigned nloc = b.st[0], nx = b.st[1];
        if (nloc == 0u) { xcd_barrier_complete(bar, b.x, nloc, nx); b.st[0] = nloc; b.st[1] = nx; }
        const unsigned old = xb_add(&bar[XB_XSUB(b.x)], 1u);
        const unsigned gen = old / nloc;
        if (old + 1u == (gen + 1u) * nloc) {
            __builtin_amdgcn_fence(__ATOMIC_RELEASE, "agent");
            asm volatile("s_waitcnt vmcnt(0)" ::: "memory");
            const unsigned og = xb_add(&bar[XB_TOP], 1u);
            const unsigned tg = og / nx;
            if (og + 1u == (tg + 1u) * nx) xb_add(&bar[XB_TOPGEN], 1u);
            else XB_SPIN(xb_ld(&bar[XB_TOPGEN]) == tg, bar);
            __builtin_amdgcn_fence(__ATOMIC_ACQUIRE, "agent");
            xb_add(&bar[XB_XGEN(b.x)], 1u);
            asm volatile("s_waitcnt vmcnt(0)" ::: "memory");
        } else {
            XB_SPIN(xb_ld(&bar[XB_XGEN(b.x)]) == gen, bar);
            __builtin_amdgcn_fence(__ATOMIC_ACQUIRE, "agent");
            asm volatile("s_waitcnt vmcnt(0)" ::: "memory");
        }
    }
    __syncthreads();
}

__device__ __forceinline__ pg8::GemmDesc make_desc(const Params& p, int gi) {
    pg8::GemmDesc g{};
    if (gi == 0) { g.A = p.ws + WS_XM; g.Bt = p.ws + WS_WINT; g.O = p.ws + WS_U; g.Kb = 2048; g.nM = MROWS / 256; g.nN = DINP / 256; g.epi = 0; g.ldc = DINP; g.qtiles = 2; g.narrow = (MROWS - NLAT) / 256; }
    else if (gi == 1) { g.A = p.ws + WS_MIX; g.Bt = p.ws + WS_WOUTG; g.bEstride = (size_t)D_ * D_ * 2; g.O = p.ws + WS_Y; g.x = p.x; g.Kb = 2048; g.nM = NLAT / 256; g.nN = 4; g.epi = 2; g.ldc = 1024; }
    else if (gi == 2) { g.A = p.ws + WS_HMOD; g.Bt = p.ws + WS_WGUT; g.IDX = (const int*)(p.ws + WS_IDX); g.O = p.ws + WS_ACT; g.bEstride = (size_t)2 * DFF * 1024; g.Kb = 1024; g.nM = NE * 32; g.nN = 22; g.epi = 1; g.ldc = DFF; }
    else { g.A = p.ws + WS_ACT; g.Bt = p.ws + WS_WDT; g.O = p.ws + WS_EO; g.bEstride = (size_t)1024 * DFF; g.Kb = DFF; g.nM = NE * 32; g.nN = 4; g.epi = 3; g.ldc = 1024; }
    return g;
}

__device__ __forceinline__ void ph_final(const Params& p, int bid, int nblk) {
    const int tid = ltid(), lane = tid & 63, wave = tid >> 6;
    const GAS float* MOD = (const GAS float*)(p.ws + WS_MOD); const GAS bf16_t* EO = (const GAS bf16_t*)(p.ws + WS_EO); const GAS float* GSEL = (const GAS float*)(p.ws + WS_GSEL); const GAS int* INV = (const GAS int*)(p.ws + WS_INV);
    const GAS bf16_t* Y = (const GAS bf16_t*)(p.ws + WS_Y); GAS float* OUT = (GAS float*)p.out; const GAS float* ln1g = (const GAS float*)p.ln1_g; const GAS float* ln1b = (const GAS float*)p.ln1_b; const GAS float* ln2g = (const GAS float*)p.ln2_g; const GAS float* ln2b = (const GAS float*)p.ln2_b;
    constexpr int NPF = 4;
    const int mstride = nblk * NWAVES;
    int m = bid * NWAVES + wave;
    u32x2 vn[4]; int inv1 = -1, inv2 = -1;
    u32x2 pe[NPF][4]; float pg[NPF];
#define FIN_PREFETCH(row_, inv_) do { unsigned _em = (unsigned)__ballot((inv_) >= 0); const int _bb = (row_) >> 13; \
        _Pragma("unroll") for (int _t = 0; _t < NPF; ++_t) { \
            if (_em) { const int _e = __builtin_ctz(_em); _em &= _em - 1u; const int _slot = __builtin_amdgcn_readlane((inv_), _e); \
                pg[_t] = GSEL[(_e * 8 + _bb) * CAP + _slot]; const GAS bf16_t* _rp = EO + ((size_t)_e * 8192 + _bb * 1024 + _slot) * 1024; \
                _Pragma("unroll") for (int j = 0; j < 4; ++j) pe[_t][j] = *(const GAS u32x2*)(_rp + j * 256 + lane * 4); } \
            else { pg[_t] = 0.f; _Pragma("unroll") for (int j = 0; j < 4; ++j) pe[_t][j] = (u32x2){0u, 0u}; } } } while (0)
    f32x4 pg1[4], pb1[4], pg2[4], pb2[4], pgg[4]; int bcur = -1;
#pragma unroll
    for (int j = 0; j < 4; ++j) { const int k = j * 256 + lane * 4; pg1[j] = *(const GAS f32x4*)(ln1g + k); pb1[j] = *(const GAS f32x4*)(ln1b + k); pg2[j] = *(const GAS f32x4*)(ln2g + k); pb2[j] = *(const GAS f32x4*)(ln2b + k); pgg[j] = pg1[j]; }
    if (m < NLAT) { inv1 = lane < 16 ? INV[(size_t)m * 16 + lane] : -1;
#pragma unroll
        for (int j = 0; j < 4; ++j) vn[j] = *(const GAS u32x2*)(Y + (size_t)m * 1024 + j * 256 + lane * 4);
        if (m + mstride < NLAT) inv2 = lane < 16 ? INV[(size_t)(m + mstride) * 16 + lane] : -1;
        FIN_PREFETCH(m, inv1); }
    for (; m < NLAT; m += mstride) {
        const int b = m >> 13;
        GAS float* y = OUT + (size_t)m * 1024; const GAS float* g2 = MOD + b * 6144 + 5120;
        if (b != bcur) { bcur = b;
#pragma unroll
            for (int j = 0; j < 4; ++j) pgg[j] = *(const GAS f32x4*)(g2 + j * 256 + lane * 4); }
        const int myinv = inv1;
        f32x4 v[4]; float s = 0.f;
#pragma unroll
        for (int j = 0; j < 4; ++j) { v[j] = (f32x4){hlo(vn[j].x), hhi(vn[j].x), hlo(vn[j].y), hhi(vn[j].y)}; s += (v[j].x + v[j].y) + (v[j].z + v[j].w); }
        f32x4 moe[4];
#pragma unroll
        for (int j = 0; j < 4; ++j) moe[j] = (f32x4){0.f, 0.f, 0.f, 0.f};
        unsigned emask = (unsigned)__ballot(myinv >= 0);
#pragma unroll
        for (int t = 0; t < NPF; ++t) { if (emask) { emask &= emask - 1u; const float g = pg[t];
#pragma unroll
            for (int j = 0; j < 4; ++j) { const u32x2 w = pe[t][j]; moe[j].x += g * bflo(w.x); moe[j].y += g * bfhi(w.x); moe[j].z += g * bflo(w.y); moe[j].w += g * bfhi(w.y); } } }
        { const int mn = m + mstride; inv1 = inv2;
          if (mn < NLAT) {
#pragma unroll
              for (int j = 0; j < 4; ++j) vn[j] = *(const GAS u32x2*)(Y + (size_t)mn * 1024 + j * 256 + lane * 4);
              inv2 = (mn + mstride < NLAT && lane < 16) ? INV[(size_t)(mn + mstride) * 16 + lane] : -1;
              FIN_PREFETCH(mn, inv1); } }
        while (emask) {
            const int e = __builtin_ctz(emask); emask &= emask - 1u;
            const int slot = __builtin_amdgcn_readlane(myinv, e);
            const float g = GSEL[(e * 8 + b) * CAP + slot];
            const GAS bf16_t* row = EO + ((size_t)e * 8192 + b * 1024 + slot) * 1024;
#pragma unroll
            for (int j = 0; j < 4; ++j) { const u32x2 w = *(const GAS u32x2*)(row + j * 256 + lane * 4); moe[j].x += g * bflo(w.x); moe[j].y += g * bfhi(w.x); moe[j].z += g * bflo(w.y); moe[j].w += g * bfhi(w.y); }
        }
        const float mean = wave_sum(s) * (1.f / 1024.f); float s2 = 0.f;
#pragma unroll
        for (int j = 0; j < 4; ++j) { v[j] = v[j] - mean; s2 += (v[j].x * v[j].x + v[j].y * v[j].y) + (v[j].z * v[j].z + v[j].w * v[j].w); }
        const float rstd = rsqrtf(wave_sum(s2) * (1.f / 1024.f) + LN_EPS);
        float s3 = 0.f;
#pragma unroll
        for (int j = 0; j < 4; ++j) { v[j] = ALPHA * (v[j] * rstd * pg1[j] + pb1[j]) + pgg[j] * moe[j]; s3 += (v[j].x + v[j].y) + (v[j].z + v[j].w); }
        const float mean2 = wave_sum(s3) * (1.f / 1024.f); float s4 = 0.f;
#pragma unroll
        for (int j = 0; j < 4; ++j) { v[j] = v[j] - mean2; s4 += (v[j].x * v[j].x + v[j].y * v[j].y) + (v[j].z * v[j].z + v[j].w * v[j].w); }
        const float rstd2 = rsqrtf(wave_sum(s4) * (1.f / 1024.f) + LN_EPS);
#pragma unroll
        for (int j = 0; j < 4; ++j) { const int k = j * 256 + lane * 4; __builtin_nontemporal_store(v[j] * rstd2 * pg2[j] + pb2[j], (GAS f32x4*)(y + k)); }
    }
}

constexpr int NPHASE = 12;
#ifndef ONLY_PH
#define ONLY_PH -1
#endif
#define PH_EN(n) (ONLY_PH < 0 || ONLY_PH == (n))
__global__ void __launch_bounds__(NTHR, 2) mk_fwd(Params p) {
    extern __shared__ __attribute__((aligned(16))) unsigned char lds[];
    const int bid = blockIdx.x, nblk = gridDim.x;
    volatile LAS unsigned* MISC = (volatile LAS unsigned*)((LAS unsigned char*)lds + (LDS_BYTES - 16));
    if (threadIdx.x < 4) MISC[threadIdx.x] = 0u;
    __syncthreads();
    const XcdBarrier xbar = xcd_barrier_post((unsigned*)(p.ws + WS_CTL) + 4096, MISC);
#ifndef PHMASK
#define PHMASK 0xffff
#endif
#define IN(k) ((((PHMASK) >> (k)) & 1) && p.ph_lo <= (k) && (k) < p.ph_hi)
#define LOADP() load_params()
#define LAUNDER() const int bid_ = bid, nblk_ = nblk; unsigned char* const lds_ = lds
#define SEAM(k) do { if (IN(k) && IN((k) + 1)) xcd_barrier(xbar); } while (0)
    if (IN(0)) for (int rep_ = 0; rep_ < REPN(0); ++rep_) { const Params q = LOADP(); LAUNDER(); ph0(q, lds_, bid_, nblk_); }
    SEAM(0);
    if (IN(1)) for (int rep_ = 0; rep_ < REPN(1); ++rep_) { const Params q = LOADP(); LAUNDER(); ph1(q, lds_, bid_, nblk_); }
    SEAM(1);
    if (IN(2)) for (int rep_ = 0; rep_ < REPN(2); ++rep_) { const Params q = load_params_s(); LAUNDER(); const pg8::GemmDesc g = make_desc(q, 0); pg8::gemm_phase<false, false>((LAS unsigned char*)lds, g, nblk_, bid_);
        if (nblk_ == 256 && bid_ >= 104) { const Params q2 = LOADP(); ph7_conv(q2, lds_, 0, CONV_EARLY, (bid_ - 104) * NWAVES, 152 * NWAVES); } }
    SEAM(2);
    if (IN(3)) for (int rep_ = 0; rep_ < REPN(3); ++rep_) { const Params q = LOADP(); LAUNDER(); ph3(q, lds_, bid_, nblk_); }
    SEAM(3);
    if (IN(4)) for (int rep_ = 0; rep_ < REPN(4); ++rep_) { const Params q = LOADP(); LAUNDER(); ph4(q, bid_, nblk_); }
    SEAM(4);
    if (IN(5)) for (int rep_ = 0; rep_ < REPN(5); ++rep_) { const Params q = LOADP(); LAUNDER(); ph5(q, lds_, bid_, nblk_); }
    SEAM(5);
    if (IN(6)) for (int rep_ = 0; rep_ < REPN(6); ++rep_) { const Params q = load_params_s(); LAUNDER(); const int grp_ = (bid_ >> 5) & 1;
        const int cst_ = nblk_ == 256 ? CONV_EARLY : 0;
        if (grp_ == 0) ph7_conv(q, lds_, cst_, CONV_ALL, bid_ * NWAVES, nblk_ * NWAVES);
        { const pg8::GemmDesc g = make_desc(q, 1); pg8::gemm_phase<false, false>((LAS unsigned char*)lds, g, nblk_, bid_); }
        if (grp_ != 0) { const Params q2 = LOADP(); ph7_conv(q2, lds_, cst_, CONV_ALL, bid_ * NWAVES, nblk_ * NWAVES); } }
    SEAM(6);
    if (IN(7)) for (int rep_ = 0; rep_ < REPN(7); ++rep_) { const Params q = LOADP(); LAUNDER(); ph7m(q, lds_, bid_, nblk_); }
    SEAM(7);
    if (IN(8)) for (int rep_ = 0; rep_ < REPN(8); ++rep_) { const Params q = LOADP(); LAUNDER(); ph8(q, lds_, bid_, nblk_); }
    SEAM(8);
#pragma unroll 1
    for (int st = 2; st < 4; ++st) {
        if (IN(7 + st)) for (int rep_ = 0; rep_ < REPN(9); ++rep_) { const Params q = load_params_s(); LAUNDER(); const pg8::GemmDesc g = make_desc(q, st); pg8::gemm_phase<true, true>((LAS unsigned char*)lds, g, nblk_, bid_); }
        SEAM(7 + st);
    }
    if (IN(11)) for (int rep_ = 0; rep_ < REPN(11); ++rep_) { const Params q = LOADP(); LAUNDER(); ph_final(q, bid_, nblk_); }
#undef IN
#undef SEAM
}

extern "C" void kernel_launch(void* const* d_in, const int* in_sizes, int n_in, void* d_out, int out_size, void* d_ws, size_t ws_size, hipStream_t stream) {
    static int grid_blocks = 0;
    if (grid_blocks == 0) {
        if (n_in != 20 || out_size != NLAT * D_ || ws_size < WS_WDT + (size_t)NE * D_ * DFF || ws_size < WS_END) { fprintf(stderr, "kernel_launch: unexpected shapes (n_in %d out %d ws %zu need %zu)\n", n_in, out_size, ws_size, (size_t)WS_END); grid_blocks = -1; return; }
        int dev = 0, cus = 0, per_cu = 0;
        if (hipGetDevice(&dev) != hipSuccess || hipDeviceGetAttribute(&cus, hipDeviceAttributeMultiprocessorCount, dev) != hipSuccess) { grid_blocks = -1; return; }
        if (hipFuncSetAttribute((const void*)mk_fwd, hipFuncAttributeMaxDynamicSharedMemorySize, LDS_BYTES) != hipSuccess) { fprintf(stderr, "kernel_launch: hipFuncSetAttribute failed\n"); grid_blocks = -1; return; }
        if (hipOccupancyMaxActiveBlocksPerMultiprocessor(&per_cu, (const void*)mk_fwd, NTHR, LDS_BYTES) != hipSuccess || per_cu < 1) { fprintf(stderr, "kernel_launch: occupancy query failed (%d)\n", per_cu); grid_blocks = -1; return; }
        grid_blocks = cus * per_cu;
    }
    if (grid_blocks < 0) return;
    if (hipMemsetAsync((char*)d_ws + WS_CTL, 0, 65536, stream) != hipSuccess) { fprintf(stderr, "kernel_launch: hipMemsetAsync failed\n"); return; }
    Params p{};
    const float** pp = (const float**)&p;
    for (int i = 0; i < 20; ++i) pp[i] = (const float*)d_in[i];
    p.out = (float*)d_out; p.ws = (unsigned char*)d_ws;
    p.ph_lo = 0; p.ph_hi = NPHASE;
    void* args[] = {&p};
    hipError_t e = hipLaunchCooperativeKernel((const void*)mk_fwd, dim3(grid_blocks), dim3(NTHR), args, LDS_BYTES, stream);
    if (e != hipSuccess) fprintf(stderr, "cooperative launch failed: %s (grid %d)\n", hipGetErrorString(e), grid_blocks);
}
```
